# Optimizing an MI355X kernel written in HIP

```python
import math
import jax
import jax.numpy as jnp
from jax import lax
import numpy as np

D_MODEL = 1024
BATCH = 16
SEQ = 2048
DEPTH = 2

HEAD_DIM = 64
GRID_W = 64
Q_BLOCK = 128
ROPE_THETA = 10000.0
NORM_EPS = 1e-6
NEG_INF = -1e30

NUM_BUCKETS = 32
REL_MAX_DISTANCE = 1024

MLA_HEADS = 4
MLA_NOPE_DIM = 64
MLA_ROPE_DIM = 32
MLA_QK_DIM = MLA_NOPE_DIM + MLA_ROPE_DIM
MLA_V_DIM = 64
MLA_Q_RANK = 256
MLA_KV_RANK = 128

DIL_HEADS = 4
DIL_PATTERNS = ((128, 1), (512, 4), (2048, 16))
DIL_BLOCK = max(w // (2 * d) for w, d in DIL_PATTERNS)

GQA_HEADS = 4
GQA_KV_HEADS = 2
GQA_GROUP = GQA_HEADS // GQA_KV_HEADS
AXIAL_DIM = HEAD_DIM // 2

DIFF_HEADS = 4
DIFF_QK_DIM = HEAD_DIM // 2
DIFF_V_DIM = HEAD_DIM

NUM_BIAS_HEADS = DIL_HEADS + DIFF_HEADS

D_MIX = MLA_HEADS * MLA_V_DIM + DIL_HEADS * HEAD_DIM + GQA_HEADS * HEAD_DIM + DIFF_HEADS * DIFF_V_DIM

IN_SIZES = (
    MLA_Q_RANK, MLA_KV_RANK, MLA_ROPE_DIM,
    DIL_HEADS * HEAD_DIM, DIL_HEADS * HEAD_DIM, DIL_HEADS * HEAD_DIM,
    GQA_HEADS * HEAD_DIM, GQA_KV_HEADS * HEAD_DIM, GQA_KV_HEADS * HEAD_DIM,
    DIFF_HEADS * 2 * DIFF_QK_DIM, DIFF_HEADS * 2 * DIFF_QK_DIM, DIFF_HEADS * DIFF_V_DIM,
)
IN_COLS = sum(IN_SIZES)

N_GROUPS = 4
EXPERTS_PER_GROUP = 4
N_EXPERTS = N_GROUPS * EXPERTS_PER_GROUP
TOP_K = 2
D_FF_EXPERT = 512

kernel_name = 'hybrid_parallel_head_encoder'


def rms_norm(x, gain=None):
    xf = x.astype(jnp.float32)
    y = xf * lax.rsqrt(jnp.mean(xf * xf, axis=-1, keepdims=True) + NORM_EPS)
    if gain is not None:
        y = y * gain.astype(jnp.float32)
    return y.astype(x.dtype)


def rope_cos_sin(pos, dim):
    inv = 1.0 / (ROPE_THETA ** (jnp.arange(0, dim, 2, dtype=jnp.float32) / dim))
    ang = pos.astype(jnp.float32)[:, None] * inv[None, :]
    ang = jnp.concatenate([ang, ang], axis=-1)
    return jnp.cos(ang), jnp.sin(ang)


def apply_rope(x, cos, sin):
    half = x.shape[-1] // 2
    xf = x.astype(jnp.float32)
    rot = jnp.concatenate([-xf[..., half:], xf[..., :half]], axis=-1)
    return (xf * cos[None, :, None, :] + rot * sin[None, :, None, :]).astype(x.dtype)


def axial_rope(x, row_cos, row_sin, col_cos, col_sin):
    return jnp.concatenate([apply_rope(x[..., :AXIAL_DIM], row_cos, row_sin),
                            apply_rope(x[..., AXIAL_DIM:], col_cos, col_sin)], axis=-1)


def rel_bucket(rel):
    half = NUM_BUCKETS // 2
    max_exact = half // 2
    n = jnp.abs(rel)
    nf = jnp.maximum(n, 1).astype(jnp.float32)
    log_ratio = jnp.log(nf / max_exact) / math.log(REL_MAX_DISTANCE / max_exact)
    large = jnp.minimum(max_exact + (log_ratio * (half - max_exact)).astype(jnp.int32), half - 1)
    return jnp.where(rel > 0, half, 0) + jnp.where(n < max_exact, n, large)


def sweep_query_blocks(block_fn, q):
    b, s = q.shape[:2]
    nb = s // Q_BLOCK
    qb = jnp.moveaxis(q.reshape((b, nb, Q_BLOCK) + q.shape[2:]), 1, 0)
    starts = jnp.arange(nb, dtype=jnp.int32) * Q_BLOCK
    out = lax.map(lambda a: block_fn(a[0], a[1]), (starts, qb))
    out = jnp.moveaxis(out, 0, 1)
    return out.reshape((b, s) + out.shape[3:])


def mla_mixer(c_q, c_kv, k_rope, q_norm_g, kv_norm_g, w_uq, w_ukv, qk_g, cos, sin):
    b, s, _ = c_q.shape
    q = jnp.einsum('bsr,rc->bsc', rms_norm(c_q, q_norm_g), w_uq).reshape(b, s, MLA_HEADS, MLA_QK_DIM)
    kv = jnp.einsum('bsr,rc->bsc', rms_norm(c_kv, kv_norm_g), w_ukv)
    kv = kv.reshape(b, s, MLA_HEADS, MLA_NOPE_DIM + MLA_V_DIM)
    k_nope, v = kv[..., :MLA_NOPE_DIM], kv[..., MLA_NOPE_DIM:]
    k_pe = jnp.broadcast_to(k_rope[:, :, None, :], (b, s, MLA_HEADS, MLA_ROPE_DIM))
    k = jnp.concatenate([k_nope, k_pe], axis=-1)
    q = rms_norm(q, qk_g[0])
    k = rms_norm(k, qk_g[1])
    q = jnp.concatenate([q[..., :MLA_NOPE_DIM], apply_rope(q[..., MLA_NOPE_DIM:], cos, sin)], axis=-1)
    k = jnp.concatenate([k[..., :MLA_NOPE_DIM], apply_rope(k[..., MLA_NOPE_DIM:], cos, sin)], axis=-1)
    scale = MLA_QK_DIM ** -0.5

    def block(start, qb):
        sc = jnp.einsum('bqhe,bkhe->bhqk', qb, k).astype(jnp.float32) * scale
        p = jax.nn.softmax(sc, axis=-1).astype(v.dtype)
        return jnp.einsum('bhqk,bkhe->bqhe', p, v)

    return sweep_query_blocks(block, q).reshape(b, s, MLA_HEADS * MLA_V_DIM)


def dilated_branch(q, k, v, bias_table, dilation, half_steps):
    b, s, h, e = q.shape
    n_sub = s // dilation
    nb = -(-n_sub // DIL_BLOCK)
    lp = nb * DIL_BLOCK

    def to_sub(a):
        a = a.reshape(b, n_sub, dilation, h, e).transpose(0, 2, 3, 1, 4)
        return jnp.pad(a, ((0, 0), (0, 0), (0, 0), (0, lp - n_sub), (0, 0)))

    def band(a):
        a = jnp.pad(a, ((0, 0), (0, 0), (0, 0), (DIL_BLOCK, DIL_BLOCK), (0, 0)))
        a = a.reshape(b, dilation, h, nb + 2, DIL_BLOCK, e)
        return jnp.concatenate([a[:, :, :, :-2], a[:, :, :, 1:-1], a[:, :, :, 2:]], axis=4)

    qb = to_sub(q).reshape(b, dilation, h, nb, DIL_BLOCK, e)
    kb = band(to_sub(k))
    vb = band(to_sub(v))
    scores = jnp.einsum('brhnqe,brhnke->brhnqk', qb, kb).astype(jnp.float32) * (e ** -0.5)
    qi = jnp.arange(DIL_BLOCK, dtype=jnp.int32)
    kj = jnp.arange(3 * DIL_BLOCK, dtype=jnp.int32) - DIL_BLOCK
    rel = kj[None, :] - qi[:, None]
    k_sub = (jnp.arange(nb, dtype=jnp.int32) * DIL_BLOCK)[:, None] + kj[None, :]
    valid = (jnp.abs(rel) <= half_steps)[None] & ((k_sub >= 0) & (k_sub < n_sub))[:, None, :]
    bias = jnp.transpose(bias_table[rel_bucket(rel * dilation)], (2, 0, 1))
    scores = jnp.where(valid, scores + bias[:, None], NEG_INF)
    lse = jax.nn.logsumexp(scores, axis=-1)
    p = jnp.exp(scores - lse[..., None])
    o = jnp.einsum('brhnqk,brhnke->brhnqe', p.astype(v.dtype), vb)
    o = o.reshape(b, dilation, h, lp, e)[:, :, :, :n_sub].transpose(0, 3, 1, 2, 4).reshape(b, s, h, e)
    lse = lse.reshape(b, dilation, h, lp)[..., :n_sub].transpose(0, 3, 1, 2).reshape(b, s, h)
    return o, lse


def dilated_mixer(q, k, v, qk_g, bias_table):
    b, s, _ = q.shape
    q = rms_norm(q.reshape(b, s, DIL_HEADS, HEAD_DIM), qk_g[0])
    k = rms_norm(k.reshape(b, s, DIL_HEADS, HEAD_DIM), qk_g[1])
    v = v.reshape(b, s, DIL_HEADS, HEAD_DIM)
    outs, lses = [], []
    for window, dilation in DIL_PATTERNS:
        o, l = dilated_branch(q, k, v, bias_table, dilation, window // (2 * dilation))
        outs.append(o)
        lses.append(l)
    wts = jax.nn.softmax(jnp.stack(lses, axis=0), axis=0).astype(q.dtype)
    o = jnp.sum(wts[..., None] * jnp.stack(outs, axis=0), axis=0)
    return o.reshape(b, s, DIL_HEADS * HEAD_DIM)


def gqa_mixer(q, k, v, qk_g, row_cos, row_sin, col_cos, col_sin):
    b, s, _ = q.shape
    q = rms_norm(q.reshape(b, s, GQA_HEADS, HEAD_DIM), qk_g[0])
    k = rms_norm(k.reshape(b, s, GQA_KV_HEADS, HEAD_DIM), qk_g[1])
    v = v.reshape(b, s, GQA_KV_HEADS, HEAD_DIM)
    q = axial_rope(q, row_cos, row_sin, col_cos, col_sin).reshape(b, s, GQA_KV_HEADS, GQA_GROUP, HEAD_DIM)
    k = axial_rope(k, row_cos, row_sin, col_cos, col_sin)
    scale = HEAD_DIM ** -0.5

    def block(start, qb):
        sc = jnp.einsum('bqhge,bkhe->bhgqk', qb, k).astype(jnp.float32) * scale
        p = jax.nn.softmax(sc, axis=-1).astype(v.dtype)
        return jnp.einsum('bhgqk,bkhe->bqhge', p, v)

    return sweep_query_blocks(block, q).reshape(b, s, GQA_HEADS * HEAD_DIM)


def diff_mixer(q, k, v, qk_g, lam_vecs, subln_g, bias_table, lambda_init):
    b, s, _ = q.shape
    q = rms_norm(q.reshape(b, s, DIFF_HEADS, 2, DIFF_QK_DIM), qk_g[0])
    k = rms_norm(k.reshape(b, s, DIFF_HEADS, 2, DIFF_QK_DIM), qk_g[1])
    v = v.reshape(b, s, DIFF_HEADS, DIFF_V_DIM)
    lv = lam_vecs.astype(jnp.float32)
    lam = jnp.exp(jnp.sum(lv[0] * lv[1])) - jnp.exp(jnp.sum(lv[2] * lv[3])) + lambda_init
    kpos = jnp.arange(s, dtype=jnp.int32)
    scale = DIFF_QK_DIM ** -0.5

    def block(start, qb):
        sc = jnp.einsum('bqhce,bkhce->bchqk', qb, k).astype(jnp.float32) * scale
        qpos = start + jnp.arange(Q_BLOCK, dtype=jnp.int32)
        bias = jnp.transpose(bias_table[rel_bucket(kpos[None, :] - qpos[:, None])], (2, 0, 1))
        p = jax.nn.softmax(sc + bias[None, None], axis=-1)
        attn = p[:, 0] - lam * p[:, 1]
        return jnp.einsum('bhqk,bkhe->bqhe', attn.astype(v.dtype), v)

    o = sweep_query_blocks(block, q)
    o = rms_norm(o, subln_g) * (1.0 - lambda_init)
    return o.reshape(b, s, DIFF_HEADS * DIFF_V_DIM)


def hier_moe(h, wg, bg, we, be, w_gate, w_up, w_down):
    b, s, d = h.shape
    t = h.reshape(b * s, d)
    n_tok = t.shape[0]
    g_prob = jax.nn.softmax(jnp.einsum('td,dg->tg', t, wg).astype(jnp.float32) + bg.astype(jnp.float32), axis=-1)
    g_w, g_idx = lax.top_k(g_prob, 1)
    e_logits = jnp.einsum('td,de->te', t, we).astype(jnp.float32) + be.astype(jnp.float32)
    e_logits = e_logits.reshape(n_tok, N_GROUPS, EXPERTS_PER_GROUP)
    sel = jnp.broadcast_to(g_idx[:, :, None], (n_tok, 1, EXPERTS_PER_GROUP))
    e_logits = jnp.take_along_axis(e_logits, sel, axis=1)[:, 0]
    e_w, e_idx = lax.top_k(jax.nn.softmax(e_logits, axis=-1), TOP_K)
    e_w = e_w / jnp.sum(e_w, axis=-1, keepdims=True)
    expert_id = g_idx * EXPERTS_PER_GROUP + e_idx
    gate = jnp.sum(jax.nn.one_hot(expert_id, N_EXPERTS, dtype=jnp.float32) * (g_w * e_w)[..., None], axis=1)
    y = jnp.zeros_like(t)
    for e in range(N_EXPERTS):
        hid = jax.nn.silu(t @ w_gate[e]) * (t @ w_up[e])
        y = y + gate[:, e:e + 1].astype(t.dtype) * (hid @ w_down[e])
    return y.reshape(b, s, d)


def setup_inputs(seed: int = 0) -> dict:
    key = jax.random.key(seed)
    ks = jax.random.split(key, 24)
    f32 = jnp.float32

    def nrm(k, shape, scale):
        return jax.random.normal(k, shape, f32) * scale

    def gain(k, shape):
        return 1.0 + 0.02 * jax.random.normal(k, shape, f32)

    return {
        'x': nrm(ks[0], (BATCH, SEQ, D_MODEL), 1.0),
        'rel_bias': nrm(ks[1], (NUM_BUCKETS, NUM_BIAS_HEADS), 0.5),
        'norm1_g': gain(ks[2], (DEPTH, D_MODEL)),
        'w_in': nrm(ks[3], (DEPTH, D_MODEL, IN_COLS), D_MODEL ** -0.5),
        'mla_q_norm_g': gain(ks[4], (DEPTH, MLA_Q_RANK)),
        'mla_kv_norm_g': gain(ks[5], (DEPTH, MLA_KV_RANK)),
        'mla_w_uq': nrm(ks[6], (DEPTH, MLA_Q_RANK, MLA_HEADS * MLA_QK_DIM), MLA_Q_RANK ** -0.5),
        'mla_w_ukv': nrm(ks[7], (DEPTH, MLA_KV_RANK, MLA_HEADS * (MLA_NOPE_DIM + MLA_V_DIM)), MLA_KV_RANK ** -0.5),
        'mla_qk_g': gain(ks[8], (DEPTH, 2, MLA_QK_DIM)),
        'dil_qk_g': gain(ks[9], (DEPTH, 2, HEAD_DIM)),
        'gqa_qk_g': gain(ks[10], (DEPTH, 2, HEAD_DIM)),
        'diff_qk_g': gain(ks[11], (DEPTH, 2, DIFF_QK_DIM)),
        'diff_lambda': nrm(ks[12], (DEPTH, 4, DIFF_QK_DIM), 0.1),
        'diff_subln_g': gain(ks[13], (DEPTH, DIFF_V_DIM)),
        'mix_beta': gain(ks[14], (DEPTH, D_MIX)),
        'w_out': nrm(ks[15], (DEPTH, D_MIX, D_MODEL), D_MIX ** -0.5),
        'norm2_g': gain(ks[16], (DEPTH, D_MODEL)),
        'router_group_w': nrm(ks[17], (DEPTH, D_MODEL, N_GROUPS), D_MODEL ** -0.5),
        'router_group_b': nrm(ks[18], (DEPTH, N_GROUPS), 0.01),
        'router_expert_w': nrm(ks[19], (DEPTH, D_MODEL, N_EXPERTS), D_MODEL ** -0.5),
        'router_expert_b': nrm(ks[20], (DEPTH, N_EXPERTS), 0.01),
        'expert_w_gate': nrm(ks[21], (DEPTH, N_EXPERTS, D_MODEL, D_FF_EXPERT), D_MODEL ** -0.5),
        'expert_w_up': nrm(ks[22], (DEPTH, N_EXPERTS, D_MODEL, D_FF_EXPERT), D_MODEL ** -0.5),
        'expert_w_down': nrm(ks[23], (DEPTH, N_EXPERTS, D_FF_EXPERT, D_MODEL), D_FF_EXPERT ** -0.5),
    }


def reference(x, rel_bias, norm1_g, w_in, mla_q_norm_g, mla_kv_norm_g, mla_w_uq, mla_w_ukv, mla_qk_g,
              dil_qk_g, gqa_qk_g, diff_qk_g, diff_lambda, diff_subln_g, mix_beta, w_out, norm2_g,
              router_group_w, router_group_b, router_expert_w, router_expert_b,
              expert_w_gate, expert_w_up, expert_w_down):
    b, s, _ = x.shape
    rows = s // GRID_W
    pos = jnp.arange(s, dtype=jnp.int32)
    row_pos = jnp.repeat(jnp.arange(rows, dtype=jnp.int32), GRID_W)
    col_pos = pos - row_pos * GRID_W
    mla_cos, mla_sin = rope_cos_sin(pos, MLA_ROPE_DIM)
    row_cos, row_sin = rope_cos_sin(row_pos, AXIAL_DIM)
    col_cos, col_sin = rope_cos_sin(col_pos, AXIAL_DIM)
    split_points = np.cumsum(IN_SIZES)[:-1].tolist()
    bias_b = rel_bias[:, :DIL_HEADS]
    bias_d = rel_bias[:, DIL_HEADS:]

    for layer in range(DEPTH):
        h = rms_norm(x, norm1_g[layer])
        proj = jnp.einsum('bsd,dc->bsc', h, w_in[layer])
        (a_cq, a_ckv, a_kr, b_q, b_k, b_v, c_q, c_k, c_v, d_q, d_k, d_v) = jnp.split(proj, split_points, axis=-1)
        y_a = mla_mixer(a_cq, a_ckv, a_kr, mla_q_norm_g[layer], mla_kv_norm_g[layer], mla_w_uq[layer],
                        mla_w_ukv[layer], mla_qk_g[layer], mla_cos, mla_sin)
        y_b = dilated_mixer(b_q, b_k, b_v, dil_qk_g[layer], bias_b)
        y_c = gqa_mixer(c_q, c_k, c_v, gqa_qk_g[layer], row_cos, row_sin, col_cos, col_sin)
        lambda_init = 0.8 - 0.6 * math.exp(-0.3 * layer)
        y_d = diff_mixer(d_q, d_k, d_v, diff_qk_g[layer], diff_lambda[layer], diff_subln_g[layer], bias_d, lambda_init)
        mixed = jnp.concatenate([rms_norm(y_a), rms_norm(y_b), rms_norm(y_c), y_d], axis=-1) * mix_beta[layer]
        x = x + jnp.einsum('bsm,md->bsd', mixed, w_out[layer])
        x = x + hier_moe(rms_norm(x, norm2_g[layer]), router_group_w[layer], router_group_b[layer],
                         router_expert_w[layer], router_expert_b[layer], expert_w_gate[layer],
                         expert_w_up[layer], expert_w_down[layer])
    return x
```

```cpp
#include <hip/hip_runtime.h>
#include <stdint.h>

typedef unsigned short bf16_t;
#ifndef ATT_DUP_KINDS
#define ATT_DUP_KINDS 15
#endif

constexpr int NB = 16, S = 2048, T = NB * S, DM = 1024, NL = 2;
constexpr int NPROJ = 2560;
constexpr int NIN = 2464;
constexpr float LOG2E = 1.4426950408889634f;
constexpr float EPS = 1e-6f;

constexpr size_t MiB = 1024ull * 1024ull;
constexpr size_t OFF_BAR   = 0;
constexpr size_t OFF_BIAS  = 64 * 1024;
constexpr size_t OFF_CS    = OFF_BIAS + 8 * 4096 * 4;
constexpr size_t OFF_WIN   = 1 * MiB;
constexpr size_t SZ_WIN    = (size_t)NL * NPROJ * 1024 * 2;
constexpr size_t OFF_WUP   = OFF_WIN + SZ_WIN;
constexpr size_t SZ_WUP    = (size_t)NL * 1024 * 384 * 2;
constexpr size_t OFF_WUPKV = OFF_WUP + (size_t)NL * 384 * 256 * 2;
constexpr size_t OFF_WOUT  = OFF_WUP + SZ_WUP;
constexpr size_t SZ_WOUT   = (size_t)NL * 1024 * 1024 * 2;
constexpr size_t OFF_WGU   = OFF_WOUT + SZ_WOUT;
constexpr size_t SZ_WGU    = (size_t)NL * 16 * 1024 * 1024 * 2;
constexpr size_t OFF_WDT   = OFF_WGU + SZ_WGU;
constexpr size_t SZ_WDT    = (size_t)NL * 16 * 1024 * 512 * 2;
constexpr size_t OFF_R1    = OFF_WDT + SZ_WDT;
constexpr size_t SZ_R1     = (size_t)T * 1024 * 2;
constexpr size_t OFF_R2    = OFF_R1 + SZ_R1;
constexpr size_t SZ_R2     = (size_t)T * NPROJ * 2;
constexpr size_t OFF_R5    = OFF_R2 + SZ_R2;
constexpr size_t SZ_H256   = (size_t)T * 256 * 2;
constexpr size_t OFF_QB = OFF_R5, OFF_KB = OFF_QB + SZ_H256, OFF_VB = OFF_KB + SZ_H256;
constexpr size_t OFF_QC = OFF_VB + SZ_H256, OFF_KC = OFF_QC + SZ_H256, OFF_VC = OFF_KC + SZ_H256 / 2;
constexpr size_t OFF_QD = OFF_VC + SZ_H256 / 2, OFF_KD = OFF_QD + SZ_H256, OFF_VD = OFF_KD + SZ_H256;
constexpr size_t OFF_KR    = OFF_VD + SZ_H256;
constexpr size_t OFF_ROUTE = OFF_KR + (size_t)T * 32 * 2;
constexpr size_t OFF_LB    = OFF_ROUTE + (size_t)T * 16;
constexpr size_t OFF_PERM  = OFF_LB + (size_t)3 * T * 4 * 4;
constexpr size_t OFF_SSX   = OFF_PERM + (size_t)24 * T * 16;
constexpr size_t OFF_SSQ   = OFF_SSX + (size_t)T * 16 * 4;
constexpr size_t OFF_SSKV  = OFF_SSQ + (size_t)T * 4 * 4;
constexpr size_t OFF_END   = OFF_SSKV + (size_t)T * 4 * 4;
constexpr size_t OFF_PREPQ = OFF_BAR + 24 * 1024;
constexpr size_t OFF_DUMMY = OFF_BAR + 32 * 1024;
constexpr size_t OFF_CNT   = OFF_BAR + 16 * 1024;
static_assert(OFF_END <= 512 * MiB, "workspace overflow");
constexpr size_t OFF_HN = OFF_R1;
constexpr size_t OFF_YA = OFF_R2 + 48 * MiB, OFF_YC = OFF_YA + SZ_H256, OFF_YD = OFF_YA + 2 * SZ_H256;
constexpr size_t OFF_AMLA = OFF_R2;
constexpr size_t OFF_QA = OFF_R2 + 96 * MiB;
constexpr size_t OFF_KA = OFF_QA + (size_t)T * 4 * 96 * 2;
constexpr size_t OFF_VA = OFF_KA + (size_t)T * 4 * 96 * 2;
constexpr size_t OFF_YBP = OFF_R2;
constexpr size_t OFF_MIX = OFF_R2 + 96 * MiB;
constexpr size_t OFF_HID = OFF_R2;

struct Params {
    const float* x; const float* rel_bias; const float* norm1_g; const float* w_in; const float* mla_q_norm_g; const float* mla_kv_norm_g;
    const float* mla_w_uq; const float* mla_w_ukv; const float* mla_qk_g; const float* dil_qk_g; const float* gqa_qk_g; const float* diff_qk_g;
    const float* diff_lambda; const float* diff_subln_g; const float* mix_beta; const float* w_out; const float* norm2_g;
    const float* rg_w; const float* rg_b; const float* re_w; const float* re_b; const float* w_gate; const float* w_up; const float* w_down;
    float* out; unsigned char* ws;
};

__device__ __forceinline__ float bf2f(bf16_t v) { return __uint_as_float(((unsigned)v) << 16); }
__device__ __forceinline__ bf16_t f2bf(float f) { unsigned u = __float_as_uint(f); u += 0x7fffu + ((u >> 16) & 1u); return (bf16_t)(u >> 16); }
__device__ __forceinline__ unsigned pack2(float lo, float hi) { unsigned r; asm("v_cvt_pk_bf16_f32 %0, %1, %2" : "=v"(r) : "v"(lo), "v"(hi)); return r; }
__device__ __forceinline__ void load8(const bf16_t* p, float (&x)[8]) {
    const uint4 v = *(const uint4*)p;
    x[0] = __uint_as_float(v.x << 16); x[1] = __uint_as_float(v.x & 0xffff0000u);
    x[2] = __uint_as_float(v.y << 16); x[3] = __uint_as_float(v.y & 0xffff0000u);
    x[4] = __uint_as_float(v.z << 16); x[5] = __uint_as_float(v.z & 0xffff0000u);
    x[6] = __uint_as_float(v.w << 16); x[7] = __uint_as_float(v.w & 0xffff0000u);
}
__device__ __forceinline__ void store8(bf16_t* p, const float (&x)[8]) {
    uint4 v; v.x = pack2(x[0], x[1]); v.y = pack2(x[2], x[3]); v.z = pack2(x[4], x[5]); v.w = pack2(x[6], x[7]);
    *(uint4*)p = v;
}
__device__ __forceinline__ float wave_sum(float v) {
#pragma unroll
    for (int o = 32; o >= 1; o >>= 1) v += __shfl_xor(v, o);
    return v;
}
__device__ __forceinline__ int opaque_s(int v) { asm volatile("" : "+s"(v)); return v; }
__device__ __forceinline__ int opaque_tid() { int t = threadIdx.x; asm volatile("" : "+v"(t)); return t; }
__device__ __forceinline__ float lambda_init_of(int layer) { return layer == 0 ? 0.2f : (0.8f - 0.6f * 0.7408182206817179f); }

#define LAS __attribute__((address_space(3)))
typedef short bf16x8 __attribute__((ext_vector_type(8)));
typedef float f32x4 __attribute__((ext_vector_type(4)));
typedef float f32x16 __attribute__((ext_vector_type(16)));
typedef unsigned u32x4 __attribute__((ext_vector_type(4)));
typedef float f32x2 __attribute__((ext_vector_type(2)));

#define XB_TMO      128
#define XB_XCNT(j)  (256  + 64 * (j))
#define XB_XSUB(j)  (1280 + 64 * (j))
#define XB_XGEN(j)  (2304 + 64 * (j))
#define XB_TOP      3328
#define XB_TOPGEN   3392
#define XCD_BAR_WORDS 3456
#define XB_SPIN_CAP (1u << 18)

__device__ __forceinline__ unsigned xb_ld(unsigned* p)              { return __hip_atomic_load(p, __ATOMIC_RELAXED, __HIP_MEMORY_SCOPE_AGENT); }
__device__ __forceinline__ unsigned xb_add(unsigned* p, unsigned v) { return __hip_atomic_fetch_add(p, v, __ATOMIC_RELAXED, __HIP_MEMORY_SCOPE_AGENT); }
__device__ __forceinline__ unsigned xb_xcc_id() { return (unsigned)__builtin_amdgcn_s_getreg((3 << 11) | 20) & 0xFu; }
#define XB_SPIN(cond, bar) do { unsigned _sp = 0; while (cond) { __builtin_amdgcn_s_sleep(1); \
    if ((++_sp & 255u) == 0u) { if (xb_ld(&(bar)[XB_TMO])) break; if (_sp > XB_SPIN_CAP) { atomicAdd(&(bar)[XB_TMO], 1u); break; } } } } while (0)

struct XcdBarrier {
    unsigned* bar; unsigned x;
    volatile LAS unsigned* st;
};

__device__ __forceinline__ XcdBarrier xcd_barrier_post(unsigned* bar, volatile LAS unsigned* st) {
    XcdBarrier b; b.bar = bar; b.x = xb_xcc_id(); b.st = st;
    if (threadIdx.x == 0) (void)xb_add(&bar[XB_XCNT(b.x)], 1u);
    return b;
}
__device__ __forceinline__ void xcd_barrier_complete(unsigned* bar, unsigned x, unsigned& nloc, unsigned& nx) {
    const unsigned G = gridDim.x * gridDim.y * gridDim.z;
    unsigned sum, cnt, mine, sp = 0u;
    for (;;) {
        sum = 0u; cnt = 0u; mine = 0u;
#pragma unroll
        for (unsigned j = 0; j < 16; ++j) { const unsigned c = xb_ld(&bar[XB_XCNT(j)]); sum += c; cnt += (c > 0u) ? 1u : 0u; mine = (j == x) ? c : mine; }
        if (sum == G) break;
        __builtin_amdgcn_s_sleep(1);
        if ((++sp & 255u) == 0u) { if (xb_ld(&bar[XB_TMO])) break; if (sp > XB_SPIN_CAP) { atomicAdd(&bar[XB_TMO], 1u); break; } }
    }
    nloc = mine > 0u ? mine : 1u; nx = cnt > 0u ? cnt : 1u;
}

__device__ __forceinline__ void xcd_barrier(const XcdBarrier& b) {
    asm volatile("s_waitcnt vmcnt(0)" ::: "memory");
    __syncthreads();
    if (threadIdx.x == 0) {
        unsigned* bar = b.bar;
        __builtin_amdgcn_s_waitcnt(0);
        unsigned nloc = b.st[0], nx = b.st[1];
        if (nloc == 0u) { xcd_barrier_complete(bar, b.x, nloc, nx); b.st[0] = nloc; b.st[1] = nx; }
        const unsigned old = xb_add(&bar[XB_XSUB(b.x)], 1u);
        const unsigned gen = old / nloc;
        if (old + 1u == (gen + 1u) * nloc) {
            __builtin_amdgcn_fence(__ATOMIC_RELEASE, "agent");
            asm volatile("s_waitcnt vmcnt(0)" ::: "memory");
            const unsigned og = xb_add(&bar[XB_TOP], 1u);
            const unsigned tg = og / nx;
            if (og + 1u == (tg + 1u) * nx) xb_add(&bar[XB_TOPGEN], 1u);
            else XB_SPIN(xb_ld(&bar[XB_TOPGEN]) == tg, bar);
            __builtin_amdgcn_fence(__ATOMIC_ACQUIRE, "agent");
            xb_add(&bar[XB_XGEN(b.x)], 1u);
            asm volatile("s_waitcnt vmcnt(0)" ::: "memory");
        } else {
            XB_SPIN(xb_ld(&bar[XB_XGEN(b.x)]) == gen, bar);
            __builtin_amdgcn_fence(__ATOMIC_ACQUIRE, "agent");
            asm volatile("s_waitcnt vmcnt(0)" ::: "memory");
        }
    }
    __syncthreads();
}


__device__ __forceinline__ void ph_prep_tables(const Params& p) {
    const int tidx = opaque_tid(); const int bidx = opaque_s((int)blockIdx.x), gdim = opaque_s((int)gridDim.x); (void)bidx; (void)gdim;
    float* bias = (float*)(p.ws + OFF_BIAS);
    float2* cs = (float2*)(p.ws + OFF_CS);
    for (int gid = bidx * blockDim.x + tidx; gid < 8 * 4096; gid += gdim * blockDim.x) {
        const int hh = gid >> 12, rel = (gid & 4095) - 2048;
        const int n = rel < 0 ? -rel : rel;
        int bucket;
        if (n < 8) bucket = n;
        else { const double lr = log((double)n / 8.0) / log(128.0); int large = 8 + (int)(lr * 8.0); bucket = large < 15 ? large : 15; }
        if (rel > 0) bucket += 16;
        bias[gid] = p.rel_bias[bucket * 8 + hh] * LOG2E;
        { const int pos = gid >> 4, i = gid & 15;
          const double inv = pow(10000.0, -(double)i / 16.0), ang = (double)pos * inv;
          cs[gid] = make_float2((float)cos(ang), (float)sin(ang)); }
    }
}

__device__ __forceinline__ int inproj_col(int n) {
    const int pn = n >> 8, phi = n & 255, bj = phi >> 7, wc = (phi >> 5) & 3, fq = (phi >> 3) & 3, nn = (phi >> 2) & 1, jj = phi & 3;
    const int e = 32 * bj + 8 * fq + 4 * nn + jj, L = 32 * bj + 16 * nn + 4 * fq + jj;
    switch (pn) {
        case 0: return phi;
        case 1: return phi < 128 ? 256 + phi : (phi < 160 ? 384 + (phi - 128) : -1);
        case 2: return 416 + 64 * wc + e;
        case 3: return 672 + 64 * wc + e;
        case 4: return 928 + 64 * wc + e;
        case 5: return 1184 + 64 * wc + L;
        case 6: return wc < 2 ? 1440 + 64 * wc + L : 1568 + 64 * (wc - 2) + e;
        case 7: return 1696 + 64 * wc + e;
        case 8: return 1952 + 64 * wc + e;
        default: return 2208 + 64 * wc + e;
    }
}
template <int KIND> __device__ __forceinline__ float prep_src(const Params& p, int batch, int n, int k) {
    if (KIND == 0) {
        const int oc = inproj_col(n);
        return oc < 0 ? 0.f : p.w_in[((size_t)batch * 1024 + k) * NIN + oc] * p.norm1_g[batch * 1024 + k];
    } else if (KIND == 1) {
        return p.mla_w_uq[((size_t)batch * 256 + k) * 384 + n] * p.mla_q_norm_g[batch * 256 + k];
    } else if (KIND == 2) {
        return p.w_out[((size_t)batch * 1024 + k) * 1024 + n];
    } else if (KIND == 3) {
        const int c = n >> 8, r = n & 255;
        return r < 128 ? p.w_gate[((size_t)batch * 1024 + k) * 512 + c * 128 + r] : p.w_up[((size_t)batch * 1024 + k) * 512 + c * 128 + (r - 128)];
    } else {
        return p.w_down[((size_t)batch * 512 + k) * 1024 + n];
    }
}
template <int KIND> __device__ __forceinline__ f32x4 prep_src4(const Params& p, int batch, int n, int k) {
    const f32x4 z = (f32x4){0.f, 0.f, 0.f, 0.f};
    if (KIND == 0) {
        const int oc = inproj_col(n);
        return oc < 0 ? z : *(const f32x4*)(p.w_in + ((size_t)batch * 1024 + k) * NIN + oc) * p.norm1_g[batch * 1024 + k];
    } else if (KIND == 1) {
        return *(const f32x4*)(p.mla_w_uq + ((size_t)batch * 256 + k) * 384 + n) * p.mla_q_norm_g[batch * 256 + k];
    } else if (KIND == 5) {
        return *(const f32x4*)(p.mla_w_ukv + ((size_t)batch * 128 + k) * 512 + n) * p.mla_kv_norm_g[batch * 128 + k];
    } else if (KIND == 2) {
        return *(const f32x4*)(p.w_out + ((size_t)batch * 1024 + k) * 1024 + n);
    } else if (KIND == 3) {
        const int c = n >> 8, r = n & 255;
        const float g2 = p.norm2_g[(batch >> 4) * 1024 + k];
        return (r < 128 ? *(const f32x4*)(p.w_gate + ((size_t)batch * 1024 + k) * 512 + c * 128 + r) : *(const f32x4*)(p.w_up + ((size_t)batch * 1024 + k) * 512 + c * 128 + (r - 128))) * g2;
    } else {
        return *(const f32x4*)(p.w_down + ((size_t)batch * 512 + k) * 1024 + n);
    }
}
template <int KIND> __device__ __forceinline__ void prep_tile(const Params& p, const int tidx, const int N, const int K, const int batch, const int rem, const size_t dst_off, LAS float* tile) {
    const int rn = (tidx & 31) * 4, rk = tidx >> 5;
    const int ntn = N / 128, k0 = (rem / ntn) * 64, n0 = (rem % ntn) * 128;
    f32x4 v[4];
#pragma unroll
    for (int i = 0; i < 4; ++i) v[i] = prep_src4<KIND>(p, batch, n0 + rn, k0 + rk + 16 * i);
    __syncthreads();
#pragma unroll
    for (int i = 0; i < 4; ++i)
#pragma unroll
        for (int e = 0; e < 4; ++e) tile[(rk + 16 * i) * 129 + rn + e] = v[i][e];
    __syncthreads();
    bf16_t* dst = (bf16_t*)(p.ws + dst_off) + (size_t)batch * N * K;
#pragma unroll
    for (int q = 0; q < 2; ++q) { const int c = tidx + 512 * q, wn = c >> 3, wkc = c & 7;
        float o[8];
#pragma unroll
        for (int jx = 0; jx < 8; ++jx) o[jx] = tile[(wkc * 8 + jx) * 129 + wn];
        store8(dst + (size_t)(n0 + wn) * K + k0 + wkc * 8, o); }
}
constexpr int PREP_TILES = 3540;
__device__ __forceinline__ void prep_layer_tile(const Params& p, const int tidx, const int layer, const int q, LAS float* tile) {
    if (q < 320) prep_tile<0>(p, tidx, NPROJ, 1024, layer, q, OFF_WIN, tile);
    else if (q < 332) prep_tile<1>(p, tidx, 384, 256, layer, q - 320, OFF_WUP, tile);
    else if (q < 340) prep_tile<5>(p, tidx, 512, 128, layer, q - 332, OFF_WUPKV, tile);
    else if (q < 468) prep_tile<2>(p, tidx, 1024, 1024, layer, q - 340, OFF_WOUT, tile);
    else if (q < 2516) prep_tile<3>(p, tidx, 1024, 1024, layer * 16 + ((q - 468) >> 7), (q - 468) & 127, OFF_WGU, tile);
    else prep_tile<4>(p, tidx, 1024, 512, layer * 16 + ((q - 2516) >> 6), (q - 2516) & 63, OFF_WDT, tile);
}
__device__ __forceinline__ void ph_prep_layer0(const Params& p, LAS float* tile) {
    const int tidx = opaque_tid(); const int bidx = opaque_s((int)blockIdx.x), gdim = opaque_s((int)gridDim.x);
    for (int q = bidx; q < PREP_TILES; q += gdim) prep_layer_tile(p, tidx, 0, q, tile);
}
__device__ __forceinline__ void prep_queue(const Params& p, const int budget, LAS float* tile, LAS int* slot) {
    const int tidx = opaque_tid();
    int* head = (int*)(p.ws + OFF_PREPQ);
    for (int n = 0; budget < 0 || n < budget; ++n) {
        __syncthreads();
        if (tidx == 0) *slot = atomicAdd(head, 1);
        __syncthreads();
        const int q = *slot;
        if (q >= PREP_TILES) break;
        prep_layer_tile(p, tidx, 1, q, tile);
    }
}

__device__ __forceinline__ void ph_xcast(const Params& p) {
    const int tidx = opaque_tid(); const int bidx = opaque_s((int)blockIdx.x), gdim = opaque_s((int)gridDim.x);
    const int lane = tidx & 63, wv = (bidx * blockDim.x + tidx) >> 6, nw = (gdim * blockDim.x) >> 6;
    bf16_t* xb = (bf16_t*)(p.ws + OFF_HN); float* ssx = (float*)(p.ws + OFF_SSX);
    for (int t0 = wv; t0 < T; t0 += 2 * nw) {
        float4 v[2][4];
#pragma unroll
        for (int k = 0; k < 2; ++k) { const int t = t0 + k * nw < T ? t0 + k * nw : t0;
#pragma unroll
            for (int i = 0; i < 4; ++i) v[k][i] = *(const float4*)(p.x + (size_t)t * 1024 + i * 256 + lane * 4); }
#pragma unroll
        for (int k = 0; k < 2; ++k) { const int t = t0 + k * nw; if (t < T) {
            float ss = 0.f;
#pragma unroll
            for (int i = 0; i < 4; ++i) ss += v[k][i].x * v[k][i].x + v[k][i].y * v[k][i].y + v[k][i].z * v[k][i].z + v[k][i].w * v[k][i].w;
            ss = wave_sum(ss);
#pragma unroll
            for (int i = 0; i < 4; ++i) { uint2 o; o.x = pack2(v[k][i].x, v[k][i].y); o.y = pack2(v[k][i].z, v[k][i].w); *(uint2*)(xb + (size_t)t * 1024 + i * 256 + lane * 4) = o; }
            if (lane < 16) ssx[(size_t)t * 16 + lane] = lane == 0 ? ss : 0.f; } }
    }
}

typedef float f32x4m __attribute__((ext_vector_type(4)));
__device__ __forceinline__ void ph_mla_up(const Params& p, int layer, LAS unsigned char* lds) {
    const int tidx = opaque_tid(); const int bidx = opaque_s((int)blockIdx.x), gdim = opaque_s((int)gridDim.x);
    const int wid = __builtin_amdgcn_readfirstlane(tidx >> 6), lane = tidx & 63, tk = lane & 15, kg = lane >> 4;
    unsigned char* ws = p.ws;
    const bf16_t* AMLA = (const bf16_t*)(ws + OFF_AMLA); const bf16_t* KR = (const bf16_t*)(ws + OFF_KR);
    const float* ssq = (const float*)(ws + OFF_SSQ); const float* sskv = (const float*)(ws + OFF_SSKV);
    const bf16_t* Wq = (const bf16_t*)(ws + OFF_WUP) + (size_t)layer * 384 * 256; const bf16_t* Wkv = (const bf16_t*)(ws + OFF_WUPKV) + (size_t)layer * 512 * 128;
    bf16_t* qA = (bf16_t*)(ws + OFF_QA); bf16_t* kA = (bf16_t*)(ws + OFF_KA); bf16_t* vA = (bf16_t*)(ws + OFF_VA);
    const float2* CS = (const float2*)(ws + OFF_CS);
    const float* gq = p.mla_qk_g + layer * 192; const float* gk = gq + 96;
    constexpr int QPB = 256 * 2 + 16, KPB = 128 * 2 + 16, KV_OFF = 96 * QPB;
    const float qscale = 0.10206207261596577f * LOG2E;
    LAS float* gl = (LAS float*)(lds + 88 * 1024);
    __syncthreads();
    if (tidx < 192) gl[tidx] = gq[tidx];
    __syncthreads();
    for (int grp = bidx; grp < T / 128; grp += gdim) {
        const int t = grp * 128 + wid * 16 + tk, b = t >> 11, sq = t & 2047;
        bf16x8 bq[8], bk[4];
        { const bf16_t* ap = AMLA + (size_t)t * 384 + 8 * kg;
#pragma unroll
          for (int s8 = 0; s8 < 8; ++s8) bq[s8] = *(const bf16x8*)(ap + 32 * s8);
#pragma unroll
          for (int s4 = 0; s4 < 4; ++s4) bk[s4] = *(const bf16x8*)(ap + 256 + 32 * s4); }
        const f32x4m a4 = *(const f32x4m*)(ssq + (size_t)t * 4), c4 = *(const f32x4m*)(sskv + (size_t)t * 4);
        const float rq = rsqrtf(((a4[0] + a4[1]) + (a4[2] + a4[3])) * (1.0f / 256.0f) + EPS), rk = rsqrtf(((c4[0] + c4[1]) + (c4[2] + c4[3])) * (1.0f / 128.0f) + EPS);
        float kr[2][4];
#pragma unroll
        for (int u = 0; u < 2; ++u) { const uint2 w = *(const uint2*)(KR + (size_t)t * 32 + 16 * u + 4 * kg);
            kr[u][0] = __uint_as_float(w.x << 16); kr[u][1] = __uint_as_float(w.x & 0xffff0000u); kr[u][2] = __uint_as_float(w.y << 16); kr[u][3] = __uint_as_float(w.y & 0xffff0000u); }
        float krss = 0.f;
#pragma unroll
        for (int u = 0; u < 2; ++u)
#pragma unroll
            for (int e = 0; e < 4; ++e) krss += kr[u][e] * kr[u][e];
        float2 cs[4];
#pragma unroll
        for (int e = 0; e < 4; ++e) cs[e] = CS[sq * 16 + 4 * kg + e];
        u32x4 wst[10];
#pragma unroll
        for (int i = 0; i < 6; ++i) { const int c = tidx + 512 * i; wst[i] = *(const u32x4*)(Wq + (size_t)(c >> 5) * 256 + (c & 31) * 8); }
#pragma unroll
        for (int i = 0; i < 4; ++i) { const int c = tidx + 512 * i; wst[6 + i] = *(const u32x4*)(Wkv + (size_t)(c >> 4) * 128 + (c & 15) * 8); }
#pragma unroll 1
        for (int h = 0; h < 4; ++h) {
            __syncthreads();
#pragma unroll
            for (int i = 0; i < 6; ++i) { const int c = tidx + 512 * i; *(LAS u32x4*)(lds + (c >> 5) * QPB + (c & 31) * 16) = wst[i]; }
#pragma unroll
            for (int i = 0; i < 4; ++i) { const int c = tidx + 512 * i; *(LAS u32x4*)(lds + KV_OFF + (c >> 4) * KPB + (c & 15) * 16) = wst[6 + i]; }
            __syncthreads();
            if (h < 3) {
#pragma unroll
                for (int i = 0; i < 6; ++i) { const int c = tidx + 512 * i; wst[i] = *(const u32x4*)(Wq + (size_t)(96 * (h + 1) + (c >> 5)) * 256 + (c & 31) * 8); }
#pragma unroll
                for (int i = 0; i < 4; ++i) { const int c = tidx + 512 * i; wst[6 + i] = *(const u32x4*)(Wkv + (size_t)(128 * (h + 1) + (c >> 4)) * 128 + (c & 15) * 8); } }
            const size_t orow = (size_t)(b * 4 + h) * S + sq;
            float qv[6][4]; float ss = 0.f;
#pragma unroll
            for (int mt = 0; mt < 6; ++mt) { f32x4 acc = (f32x4){0.f, 0.f, 0.f, 0.f};
#pragma unroll
                for (int s8 = 0; s8 < 8; ++s8) { const bf16x8 af = *(const LAS bf16x8*)(lds + (16 * mt + tk) * QPB + (32 * s8 + 8 * kg) * 2); acc = __builtin_amdgcn_mfma_f32_16x16x32_bf16(af, bq[s8], acc, 0, 0, 0); }
#pragma unroll
                for (int e = 0; e < 4; ++e) { qv[mt][e] = acc[e] * rq; ss += qv[mt][e] * qv[mt][e]; } }
            ss += __shfl_xor(ss, 16); ss += __shfl_xor(ss, 32);
            { const float rn = rsqrtf(ss * (1.0f / 96.0f) + EPS);
#pragma unroll
              for (int mt = 0; mt < 6; ++mt)
#pragma unroll
                  for (int e = 0; e < 4; ++e) qv[mt][e] *= rn * gl[16 * mt + 4 * kg + e];
#pragma unroll
              for (int e = 0; e < 4; ++e) { const float lo = qv[4][e], hi = qv[5][e]; qv[4][e] = lo * cs[e].x - hi * cs[e].y; qv[5][e] = hi * cs[e].x + lo * cs[e].y; }
#pragma unroll
              for (int mt = 0; mt < 6; ++mt) { uint2 w; w.x = pack2(qv[mt][0] * qscale, qv[mt][1] * qscale); w.y = pack2(qv[mt][2] * qscale, qv[mt][3] * qscale);
                  *(uint2*)(qA + orow * 96 + 16 * mt + 4 * kg) = w; } }
            float kv[8][4]; float sk = krss;
#pragma unroll
            for (int mt = 0; mt < 8; ++mt) { f32x4 acc = (f32x4){0.f, 0.f, 0.f, 0.f};
#pragma unroll
                for (int s4 = 0; s4 < 4; ++s4) { const bf16x8 af = *(const LAS bf16x8*)(lds + KV_OFF + (16 * mt + tk) * KPB + (32 * s4 + 8 * kg) * 2); acc = __builtin_amdgcn_mfma_f32_16x16x32_bf16(af, bk[s4], acc, 0, 0, 0); }
#pragma unroll
                for (int e = 0; e < 4; ++e) { kv[mt][e] = acc[e] * rk; if (mt < 4) sk += kv[mt][e] * kv[mt][e]; } }
            sk += __shfl_xor(sk, 16); sk += __shfl_xor(sk, 32);
            { const float rn = rsqrtf(sk * (1.0f / 96.0f) + EPS);
#pragma unroll
              for (int mt = 0; mt < 4; ++mt) { uint2 w;
                  w.x = pack2(kv[mt][0] * rn * gl[96 + 16 * mt + 4 * kg + 0], kv[mt][1] * rn * gl[96 + 16 * mt + 4 * kg + 1]); w.y = pack2(kv[mt][2] * rn * gl[96 + 16 * mt + 4 * kg + 2], kv[mt][3] * rn * gl[96 + 16 * mt + 4 * kg + 3]);
                  *(uint2*)(kA + orow * 96 + 16 * mt + 4 * kg) = w; }
              float lo[4], hi[4];
#pragma unroll
              for (int e = 0; e < 4; ++e) { const float a = kr[0][e] * rn * gl[96 + 64 + 4 * kg + e], bb = kr[1][e] * rn * gl[96 + 80 + 4 * kg + e]; lo[e] = a * cs[e].x - bb * cs[e].y; hi[e] = bb * cs[e].x + a * cs[e].y; }
              uint2 w; w.x = pack2(lo[0], lo[1]); w.y = pack2(lo[2], lo[3]); *(uint2*)(kA + orow * 96 + 64 + 4 * kg) = w;
              w.x = pack2(hi[0], hi[1]); w.y = pack2(hi[2], hi[3]); *(uint2*)(kA + orow * 96 + 80 + 4 * kg) = w;
#pragma unroll
              for (int mt = 4; mt < 8; ++mt) { uint2 wv; wv.x = pack2(kv[mt][0], kv[mt][1]); wv.y = pack2(kv[mt][2], kv[mt][3]); *(uint2*)(vA + orow * 64 + 16 * (mt - 4) + 4 * kg) = wv; } }
        }
    }
}

__device__ __forceinline__ void ph_mix(const Params& p, int layer) {
    const int tidx = opaque_tid(); const int bidx = opaque_s((int)blockIdx.x), gdim = opaque_s((int)gridDim.x);
    const int lane = tidx & 63, wv = (bidx * blockDim.x + tidx) >> 6, nw = (gdim * blockDim.x) >> 6;
    unsigned char* ws = p.ws;
    const bf16_t* YA = (const bf16_t*)(ws + OFF_YA); const bf16_t* YC = (const bf16_t*)(ws + OFF_YC); const bf16_t* YD = (const bf16_t*)(ws + OFF_YD);
    const bf16_t* YBP = (const bf16_t*)(ws + OFF_YBP); const float* LB = (const float*)(ws + OFF_LB);
    bf16_t* MIX = (bf16_t*)(ws + OFF_MIX);
    const float* beta = p.mix_beta + layer * 1024;
    const bool hiH = lane >= 32; const int cc = (lane & 31) * 8, hB = cc >> 6;
    float bt[2][8];
#pragma unroll
    for (int ps = 0; ps < 2; ++ps)
#pragma unroll
        for (int e = 0; e < 8; ++e) bt[ps][e] = beta[(ps * 64 + lane) * 8 + e];
    for (int t0 = wv; t0 < T; t0 += 2 * nw) {
        u32x4 v[2][2][3]; float lw[2][3];
#pragma unroll
        for (int k = 0; k < 2; ++k) { const int t = t0 + k * nw < T ? t0 + k * nw : t0;
            const bf16_t* p0a = (hiH ? YBP : YA) + (size_t)t * 256 + cc;
            const bf16_t* p0b = hiH ? YBP + (size_t)T * 256 + (size_t)t * 256 + cc : p0a; const bf16_t* p0c = hiH ? YBP + (size_t)2 * T * 256 + (size_t)t * 256 + cc : p0a;
            const bf16_t* p1a = (hiH ? YD : YC) + (size_t)t * 256 + cc;
            v[k][0][0] = *(const u32x4*)p0a; v[k][0][1] = *(const u32x4*)p0b; v[k][0][2] = *(const u32x4*)p0c; v[k][1][0] = *(const u32x4*)p1a;
#pragma unroll
            for (int br = 0; br < 3; ++br) lw[k][br] = LB[(size_t)br * T * 4 + (size_t)t * 4 + hB]; }
#pragma unroll
        for (int k = 0; k < 2; ++k) {
            const int t = t0 + k * nw; const bool ok = t < T;
#pragma unroll
            for (int ps = 0; ps < 2; ++ps) {
                float x[8];
                if (ps == 0) { const float l0 = hiH ? lw[k][0] : 1.0f, l1 = hiH ? lw[k][1] : 0.0f, l2 = hiH ? lw[k][2] : 0.0f; const float inv = 1.0f / (l0 + l1 + l2);
#pragma unroll
                    for (int w2 = 0; w2 < 4; ++w2) { const unsigned a = v[k][0][0][w2], b2 = v[k][0][1][w2], c2 = v[k][0][2][w2];
                        x[2 * w2] = (l0 * __uint_as_float(a << 16) + l1 * __uint_as_float(b2 << 16) + l2 * __uint_as_float(c2 << 16)) * inv;
                        x[2 * w2 + 1] = (l0 * __uint_as_float(a & 0xffff0000u) + l1 * __uint_as_float(b2 & 0xffff0000u) + l2 * __uint_as_float(c2 & 0xffff0000u)) * inv; }
                } else {
#pragma unroll
                    for (int w2 = 0; w2 < 4; ++w2) { const unsigned a = v[k][1][0][w2]; x[2 * w2] = __uint_as_float(a << 16); x[2 * w2 + 1] = __uint_as_float(a & 0xffff0000u); } }
                float ss = 0.f;
#pragma unroll
                for (int e = 0; e < 8; ++e) ss += x[e] * x[e];
#pragma unroll
                for (int off = 1; off <= 16; off <<= 1) ss += __shfl_xor(ss, off);
                const float rs = (ps == 1 && hiH) ? 1.0f : rsqrtf(ss * (1.0f / 256.0f) + EPS);
#pragma unroll
                for (int e = 0; e < 8; ++e) x[e] = x[e] * rs * bt[ps][e];
                if (ok) store8(MIX + (size_t)t * 1024 + (ps * 64 + lane) * 8, x);
            } }
    }
}

struct SortRec { int tok; float wlo, whi, rs; };
__device__ __forceinline__ float reduce20(const float (&v)[20], int lane) {
    float a[16];
#pragma unroll
    for (int i = 0; i < 16; ++i) { const bool up = lane & 32; const float hi = i < 4 ? v[16 + i] : 0.f; const float send = up ? v[i] : hi; const float keep = up ? hi : v[i]; a[i] = keep + __shfl_xor(send, 32); }
#pragma unroll
    for (int i = 0; i < 8; ++i) { const bool up = lane & 16; const float send = up ? a[i] : a[8 + i]; const float keep = up ? a[8 + i] : a[i]; a[i] = keep + __shfl_xor(send, 16); }
#pragma unroll
    for (int i = 0; i < 4; ++i) { const bool up = lane & 8; const float send = up ? a[i] : a[4 + i]; const float keep = up ? a[4 + i] : a[i]; a[i] = keep + __shfl_xor(send, 8); }
#pragma unroll
    for (int i = 0; i < 2; ++i) { const bool up = lane & 4; const float send = up ? a[i] : a[2 + i]; const float keep = up ? a[2 + i] : a[i]; a[i] = keep + __shfl_xor(send, 4); }
    { const bool up = lane & 2; const float send = up ? a[0] : a[1]; const float keep = up ? a[1] : a[0]; a[0] = keep + __shfl_xor(send, 2); }
    return a[0] + __shfl_xor(a[0], 1);
}
__device__ __forceinline__ void route_decide(const float (&lg)[20], const float* bg, const float* be, int& bucket, float& wlo, float& whi) {
    float gl[4]; int gi = 0;
#pragma unroll
    for (int i = 0; i < 4; ++i) gl[i] = lg[i] + bg[i];
    float gm = gl[0];
#pragma unroll
    for (int i = 1; i < 4; ++i) if (gl[i] > gm) { gm = gl[i]; gi = i; }
    float gs = 0.f;
#pragma unroll
    for (int i = 0; i < 4; ++i) gs += expf(gl[i] - gm);
    const float gw = 1.0f / gs;
    float el[4];
#pragma unroll
    for (int i = 0; i < 4; ++i) { const float v0 = lg[4 + i] + be[i], v1 = lg[8 + i] + be[4 + i], v2 = lg[12 + i] + be[8 + i], v3 = lg[16 + i] + be[12 + i];
        el[i] = gi == 0 ? v0 : (gi == 1 ? v1 : (gi == 2 ? v2 : v3)); }
    int i0 = 0; float m0 = el[0];
#pragma unroll
    for (int i = 1; i < 4; ++i) if (el[i] > m0) { m0 = el[i]; i0 = i; }
    int i1 = -1; float m1 = -3.0e38f;
#pragma unroll
    for (int i = 0; i < 4; ++i) if (i != i0 && el[i] > m1) { m1 = el[i]; i1 = i; }
    const float r = expf(m1 - m0); const float w0 = gw / (1.0f + r), w1 = gw * r / (1.0f + r);
    const int a = i0 < i1 ? i0 : i1, bq = i0 < i1 ? i1 : i0; const int pidx = a == 0 ? bq - 1 : (a == 1 ? bq + 1 : 5);
    bucket = gi * 6 + pidx; wlo = i0 < i1 ? w0 : w1; whi = i0 < i1 ? w1 : w0;
}
__device__ __forceinline__ void ph_norm2_route(const Params& p, int layer, LAS float* wl, const bool dup = false) {
    const int tidx = opaque_tid(); const int bidx = opaque_s((int)blockIdx.x), gdim = opaque_s((int)gridDim.x);
    const int wid = __builtin_amdgcn_readfirstlane(tidx >> 6), lane = tidx & 63, tk = lane & 15, kg = lane >> 4;
    const float* g = p.norm2_g + layer * 1024;
    const float* wg = p.rg_w + (size_t)layer * 1024 * 4; const float* we = p.re_w + (size_t)layer * 1024 * 16;
    const float* bg = p.rg_b + layer * 4; const float* be = p.re_b + layer * 16;
    const bf16_t* xs = (const bf16_t*)(p.ws + OFF_HN);
    LAS unsigned char* lb = (LAS unsigned char*)wl;
    constexpr int RP = 1024 * 2 + 16, WL_OFF = 20 * RP, Z_OFF = 40 * RP, AUX_OFF = 96 * 1024;
    __syncthreads();
    { f32x4 wv4[2][5]; float gd[2];
#pragma unroll
      for (int k = 0; k < 2; ++k) { const int d = tidx + 512 * k; gd[k] = g[d]; wv4[k][0] = *(const f32x4*)(wg + d * 4);
#pragma unroll
          for (int q = 0; q < 4; ++q) wv4[k][1 + q] = *(const f32x4*)(we + d * 16 + 4 * q); }
#pragma unroll
      for (int k = 0; k < 2; ++k) { const int d = tidx + 512 * k;
#pragma unroll
          for (int q = 0; q < 5; ++q)
#pragma unroll
              for (int e = 0; e < 4; ++e) { const float w = wv4[k][q][e] * gd[k]; const bf16_t hi = f2bf(w); const bf16_t lo = f2bf(w - bf2f(hi));
                  *(LAS bf16_t*)(lb + (q * 4 + e) * RP + d * 2) = hi; *(LAS bf16_t*)(lb + WL_OFF + (q * 4 + e) * RP + d * 2) = lo; } }
      if (tidx < RP / 16) { unsigned z = 0u; asm volatile("" : "+v"(z)); *(LAS u32x4*)(lb + Z_OFF + tidx * 16) = (u32x4){z, z, z, z}; } }
    __syncthreads();
    const unsigned a0h = tk * RP + kg * 16, a0l = WL_OFF + a0h;
    const unsigned a1h = (tk < 4 ? (16 + tk) * RP : Z_OFF) + kg * 16, a1l = (tk < 4 ? WL_OFF + (16 + tk) * RP : Z_OFF) + kg * 16;
    LAS int* rq = (LAS int*)(lb + AUX_OFF + 256) + wid * (64 * 5);
    int* cnt = (int*)(p.ws + OFF_CNT) + layer * 32 + (dup ? 4096 : 0); SortRec* recs = (SortRec*)(p.ws + OFF_PERM);
    int it = 0;
    for (int grp = bidx; grp < T / 128; grp += gdim, it += 16) {
        const int t = grp * 128 + wid * 16 + tk;
        const bf16_t* xp = xs + (size_t)t * 1024 + 8 * kg;
        f32x4 acc0 = (f32x4){0.f, 0.f, 0.f, 0.f}, acc1 = acc0; float ss = 0.f;
#pragma unroll 1
        for (int c8 = 0; c8 < 4; ++c8) {
            bf16x8 bf[8];
#pragma unroll
            for (int i = 0; i < 8; ++i) bf[i] = *(const bf16x8*)(xp + 32 * (8 * c8 + i));
#pragma unroll
            for (int i = 0; i < 8; ++i) { const int so = (8 * c8 + i) * 64;
                const u32x4 raw = __builtin_bit_cast(u32x4, bf[i]);
#pragma unroll
                for (int w2 = 0; w2 < 4; ++w2) { const float lo = __uint_as_float(raw[w2] << 16), hi = __uint_as_float(raw[w2] & 0xffff0000u); ss += lo * lo + hi * hi; }
                const bf16x8 ah0 = *(const LAS bf16x8*)(lb + a0h + so), al0 = *(const LAS bf16x8*)(lb + a0l + so), ah1 = *(const LAS bf16x8*)(lb + a1h + so), al1 = *(const LAS bf16x8*)(lb + a1l + so);
                acc0 = __builtin_amdgcn_mfma_f32_16x16x32_bf16(ah0, bf[i], acc0, 0, 0, 0); acc0 = __builtin_amdgcn_mfma_f32_16x16x32_bf16(al0, bf[i], acc0, 0, 0, 0);
                acc1 = __builtin_amdgcn_mfma_f32_16x16x32_bf16(ah1, bf[i], acc1, 0, 0, 0); acc1 = __builtin_amdgcn_mfma_f32_16x16x32_bf16(al1, bf[i], acc1, 0, 0, 0); }
        }
        ss += __shfl_xor(ss, 16); ss += __shfl_xor(ss, 32);
        const float rs = rsqrtf(ss * (1.0f / 1024.0f) + EPS);
        float lg[20];
#pragma unroll
        for (int r4 = 0; r4 < 4; ++r4) {
#pragma unroll
            for (int q = 0; q < 4; ++q) lg[4 * q + r4] = __shfl(acc0[r4], tk + 16 * q) * rs;
            lg[16 + r4] = __shfl(acc1[r4], tk) * rs; }
        int bk_; float wlo, whi;
        route_decide(lg, bg, be, bk_, wlo, whi);
        if (kg == 0) { LAS int* r0 = rq + ((it + tk) & 63) * 5; r0[0] = bk_; r0[1] = t; r0[2] = __float_as_int(wlo); r0[3] = __float_as_int(whi); r0[4] = __float_as_int(rs); }
        if (((it + 16) & 63) == 0) {
            const LAS int* rr = rq + lane * 5; const int b2 = rr[0]; const int slot = atomicAdd(cnt + b2, 1);
            SortRec sr; sr.tok = rr[1]; sr.wlo = __int_as_float(rr[2]); sr.whi = __int_as_float(rr[3]); sr.rs = __int_as_float(rr[4]); recs[(size_t)b2 * T + slot] = sr; }
    }
    const int npend = it & 63;
    int my_bucket = -1, my_tok = 0; float my_wlo = 0.f, my_whi = 0.f, my_rs = 0.f;
    if (lane < npend) { const LAS int* rr = rq + lane * 5; my_bucket = rr[0]; my_tok = rr[1]; my_wlo = __int_as_float(rr[2]); my_whi = __int_as_float(rr[3]); my_rs = __int_as_float(rr[4]); }
    { LAS int* hist = (LAS int*)(lb + AUX_OFF); LAS int* base = hist + 32;
      if (tidx < 32) hist[tidx] = 0;
      __syncthreads();
      int rank = 0;
      if (my_bucket >= 0) rank = __hip_atomic_fetch_add(hist + my_bucket, 1, __ATOMIC_RELAXED, __HIP_MEMORY_SCOPE_WORKGROUP);
      __syncthreads();
      if (tidx < 24) { const int c = hist[tidx]; base[tidx] = c > 0 ? atomicAdd(cnt + tidx, c) : 0; }
      __syncthreads();
      if (my_bucket >= 0) { const int slot = base[my_bucket] + rank; SortRec sr; sr.tok = my_tok; sr.wlo = my_wlo; sr.whi = my_whi; sr.rs = my_rs; recs[(size_t)my_bucket * T + slot] = sr; } }
}

namespace g8 {
constexpr int BM = 256, BK = 64, HALF = 128, HTB = HALF * BK * 2, STAGE_BYTES = 8 * HTB, NXCD = 8, WGM = 8;
__device__ __forceinline__ int lds_byte(int r, int c) { const int st = (r >> 4) * 2 + (c >> 5), rr = r & 15, cc = c & 31, ob = rr * 64 + cc * 2; return st * 1024 + (ob ^ (((ob >> 9) & 1) << 5)); }
__device__ __forceinline__ void stage_rc(int b, int& R, int& C) { const int st = b / 1024, sb = b % 1024, swz = sb ^ (((sb >> 9) & 1) << 5); R = (st >> 1) * 16 + swz / 64; C = (st & 1) * 32 + (swz % 64) / 2; }
__device__ __forceinline__ int perm32(int rho) { const int n = rho >> 4, i = rho & 15; return 8 * (i >> 2) + 4 * n + (i & 3); }
__device__ __forceinline__ unsigned cvt_pk_bf16(float lo, float hi) { unsigned r; asm volatile("v_cvt_pk_bf16_f32 %0, %1, %2" : "=v"(r) : "v"(lo), "v"(hi)); return r; }

struct GUnit { const char* A; const char* B; const char* B2; int pm, pn, k, s0, cnt, ord; };

struct DenseOrder {
    const bf16_t* A; const bf16_t* Bt; int lda, ldb, nM, nN, nwg, G, c;
    __device__ void init(const bf16_t* A_, int lda_, const bf16_t* Bt_, int ldb_, int M, int N, int G_, int c_) { A = A_; Bt = Bt_; lda = lda_; ldb = ldb_; nM = M / BM; nN = N / BM; nwg = nM * nN; G = G_; c = c_; }
    __device__ bool next(int i, GUnit& u) const {
        const long L = (long)i * G + c; if (L >= nwg) return false;
        int wgid = (int)L; { const int q = nwg / NXCD, r = nwg % NXCD, xcd = wgid % NXCD, off = wgid / NXCD; wgid = (xcd < r ? xcd * (q + 1) : r * (q + 1) + (xcd - r) * q) + off; }
        const int nig = WGM * nN, gid = wgid / nig, fm = gid * WGM, gsz = (nM - fm) < WGM ? (nM - fm) : WGM;
        u.pm = fm + ((wgid % nig) % gsz); u.pn = (wgid % nig) / gsz;
        u.A = (const char*)(A + (size_t)u.pm * BM * lda); u.B = (const char*)(Bt + (size_t)u.pn * BM * ldb); u.B2 = u.B; u.k = 0; u.s0 = 0; u.cnt = 0; u.ord = i;
        return true;
    }
    __device__ __forceinline__ void aoff(const GUnit&, const int (&R)[2], const int (&C)[2], unsigned (&vo)[2][2]) const {
#pragma unroll
        for (int h = 0; h < 2; ++h)
#pragma unroll
            for (int i = 0; i < 2; ++i) vo[h][i] = (unsigned)((h * HALF + R[i]) * lda + C[i]) * 2u;
    }
};

struct EpiResidBf16 {
    static constexpr bool PERM = true;
    bf16_t* X; int ldc; float accscale;
    __device__ __forceinline__ void operator()(const f32x4 (&acc)[2][2][4][2], const GUnit& u, int wr, int wc, int fr, int fq) const {
        const int row0 = u.pm * BM + wr * 64 + fr, col0 = u.pn * BM + wc * 32 + 8 * fq;
#pragma unroll
        for (int ai = 0; ai < 2; ++ai) {
            u32x4 r[4][2];
#pragma unroll
            for (int m = 0; m < 4; ++m)
#pragma unroll
                for (int bj = 0; bj < 2; ++bj) r[m][bj] = *(const u32x4*)(X + (size_t)(row0 + ai * HALF + m * 16) * ldc + col0 + bj * HALF);
#pragma unroll
            for (int m = 0; m < 4; ++m)
#pragma unroll
                for (int bj = 0; bj < 2; ++bj) asm volatile("" : "+v"(r[m][bj]));
#pragma unroll
            for (int m = 0; m < 4; ++m) { bf16_t* xp = X + (size_t)(row0 + ai * HALF + m * 16) * ldc + col0;
#pragma unroll
                for (int bj = 0; bj < 2; ++bj) { const u32x4 rr = r[m][bj];
                    const f32x4 a0 = acc[ai][bj][m][0] * accscale, a1 = acc[ai][bj][m][1] * accscale;
                    u32x4 w;
                    w.x = cvt_pk_bf16(__uint_as_float(rr.x << 16) + a0[0], __uint_as_float(rr.x & 0xffff0000u) + a0[1]);
                    w.y = cvt_pk_bf16(__uint_as_float(rr.y << 16) + a0[2], __uint_as_float(rr.y & 0xffff0000u) + a0[3]);
                    w.z = cvt_pk_bf16(__uint_as_float(rr.z << 16) + a1[0], __uint_as_float(rr.z & 0xffff0000u) + a1[1]);
                    w.w = cvt_pk_bf16(__uint_as_float(rr.w << 16) + a1[2], __uint_as_float(rr.w & 0xffff0000u) + a1[3]);
                    *(u32x4*)(xp + bj * HALF) = w; } } }
    }
};
struct EpiInProj {
    static constexpr bool PERM = true;
    const LAS float* rstab; const LAS f32x2* cstab;
    float* ssq; float* sskv; bf16_t* AMLA; bf16_t* KR;
    bf16_t* qB; bf16_t* kB; bf16_t* vB; bf16_t* qC; bf16_t* kC; bf16_t* vC; bf16_t* qD; bf16_t* kD; bf16_t* vD;
    const float* g_dil; const float* g_gqa; const float* g_diff;
    __device__ __forceinline__ void operator()(const f32x4 (&acc)[2][2][4][2], const GUnit& u, int wr, int wc, int fr, int fq) const {
        const int pn = u.pn;
        int kind = 0, hh = wc, nh = 4; bf16_t* base = vB; const float* g = g_dil; float scale = 1.f;
        if (pn == 0) kind = 4; else if (pn == 1) kind = 5;
        else if (pn == 2) { kind = 1; base = qB; g = g_dil; scale = 0.125f * LOG2E; }
        else if (pn == 3) { kind = 1; base = kB; g = g_dil + 64; }
        else if (pn == 4) { kind = 0; base = vB; }
        else if (pn == 5) { kind = 2; base = qC; g = g_gqa; scale = 0.125f * LOG2E; }
        else if (pn == 6) { nh = 2; if (wc < 2) { kind = 2; base = kC; g = g_gqa + 64; } else { kind = 0; hh = wc - 2; base = vC; } }
        else if (pn == 7) { kind = 3; base = qD; g = g_diff; scale = 0.17677669529663687f * LOG2E; }
        else if (pn == 8) { kind = 3; base = kD; g = g_diff + 32; }
        else { kind = 0; base = vD; }
        float gn[2][8];
#pragma unroll
        for (int bj = 0; bj < 2; ++bj)
#pragma unroll
            for (int e = 0; e < 8; ++e) gn[bj][e] = kind == 1 ? g[32 * bj + 8 * fq + e] : (kind == 2 ? g[32 * bj + 16 * (e >> 2) + 4 * fq + (e & 3)] : (kind == 3 ? g[8 * fq + e] : 1.0f));
        const LAS float* rsp = rstab + u.ord * 256 + wr * 64 + fr;
#pragma unroll
        for (int ai = 0; ai < 2; ++ai)
#pragma unroll
            for (int m = 0; m < 4; ++m) {
                const int lrow = ai * HALF + wr * 64 + m * 16 + fr, row = u.pm * BM + lrow, b = row >> 11, sq = row & 2047;
                const float rs = rsp[ai * HALF + m * 16];
                float v[2][8];
#pragma unroll
                for (int bj = 0; bj < 2; ++bj)
#pragma unroll
                    for (int n = 0; n < 2; ++n)
#pragma unroll
                        for (int jj = 0; jj < 4; ++jj) v[bj][4 * n + jj] = acc[ai][bj][m][n][jj] * rs;
                float q0 = 0.f, q1 = 0.f;
#pragma unroll
                for (int e = 0; e < 8; ++e) { q0 += v[0][e] * v[0][e]; q1 += v[1][e] * v[1][e]; }
                q0 += __shfl_xor(q0, 16); q0 += __shfl_xor(q0, 32); q1 += __shfl_xor(q1, 16); q1 += __shfl_xor(q1, 32);
                if (kind == 4) {
                    store8(AMLA + (size_t)row * 384 + 32 * wc + 8 * fq, v[0]); store8(AMLA + (size_t)row * 384 + 128 + 32 * wc + 8 * fq, v[1]);
                    if (fq == 0) ssq[(size_t)row * 4 + wc] = q0 + q1;
                } else if (kind == 5) {
                    store8(AMLA + (size_t)row * 384 + 256 + 32 * wc + 8 * fq, v[0]);
                    if (fq == 0) sskv[(size_t)row * 4 + wc] = q0;
                    if (wc == 0) store8(KR + (size_t)row * 32 + 8 * fq, v[1]);
                } else {
                    bf16_t* dst = base + ((size_t)(b * nh + hh) * S + sq) * 64;
                    if (kind == 1) { const float r64 = rsqrtf((q0 + q1) * (1.0f / 64.0f) + EPS) * scale;
#pragma unroll
                        for (int bj = 0; bj < 2; ++bj)
#pragma unroll
                            for (int e = 0; e < 8; ++e) v[bj][e] *= r64 * gn[bj][e];
                    } else if (kind == 3) { const float r0 = rsqrtf(q0 * (1.0f / 32.0f) + EPS) * scale, r1 = rsqrtf(q1 * (1.0f / 32.0f) + EPS) * scale;
#pragma unroll
                        for (int e = 0; e < 8; ++e) { v[0][e] *= r0 * gn[0][e]; v[1][e] *= r1 * gn[1][e]; }
                    } else if (kind == 2) { const float r64 = rsqrtf((q0 + q1) * (1.0f / 64.0f) + EPS);
#pragma unroll
                        for (int bj = 0; bj < 2; ++bj) { const int pos = bj == 0 ? (sq >> 6) : (sq & 63);
#pragma unroll
                            for (int jj = 0; jj < 4; ++jj) { const f32x2 c = cstab[pos * 16 + 4 * fq + jj];
                                const float lo = v[bj][jj] * r64 * gn[bj][jj], hi = v[bj][4 + jj] * r64 * gn[bj][4 + jj];
                                v[bj][jj] = (lo * c[0] - hi * c[1]) * scale; v[bj][4 + jj] = (hi * c[0] + lo * c[1]) * scale; } }
                    }
                    store8(dst + 8 * fq, v[0]); store8(dst + 32 + 8 * fq, v[1]);
                }
            }
    }
};
template <class Epi, class Sched>
__device__ __forceinline__ void gemm_phase(LAS unsigned char* lds, const Sched& S, const Epi& E, const int K, const int ks, const int ldb) {
    const int tid = opaque_tid(), wid = __builtin_amdgcn_readfirstlane(tid >> 6), lane = tid & 63, wr = wid >> 2, wc = wid & 3, fr = lane & 15, fq = lane >> 4;
    const int nt = K / BK;
    int Rs[2], Cs[2]; unsigned voffB[2];
#pragma unroll
    for (int i = 0; i < 2; ++i) { int R, C; stage_rc(tid * 16 + i * 8192, R, C); Rs[i] = R; Cs[i] = C; const int Rb = Epi::PERM ? ((R & ~31) + perm32(R & 31)) : R; voffB[i] = (unsigned)(Rb * ldb + C) * 2u; }
    const size_t kstep = (size_t)(BK * 2);
    const size_t hstepB = (size_t)HALF * ldb * 2;
    const unsigned ldsw = (unsigned)wid * 1024u;
    const int aoff = lds_byte(wr * 64 + fr, fq * 8), boff = lds_byte(wc * 32 + fr, fq * 8);
#define G8_SA(b, h) (((b) * 2 + (h)) * HTB)
#define G8_SB(b, h) ((4 + (b) * 2 + (h)) * HTB)
#define G8_STAGEB(bufoff, gbase) do { _Pragma("unroll") for (int _i = 0; _i < 2; ++_i) \
        __builtin_amdgcn_global_load_lds((const unsigned*)((const char*)(gbase) + voffB[_i]), (LAS unsigned*)(lds + (bufoff) + ldsw + _i * 8192), 16, 0, 0); } while (0)
#define G8_STAGEA(bufoff, gbase, v0, v1) do { \
        __builtin_amdgcn_global_load_lds((const unsigned*)((const char*)(gbase) + (v0)), (LAS unsigned*)(lds + (bufoff) + ldsw), 16, 0, 0); \
        __builtin_amdgcn_global_load_lds((const unsigned*)((const char*)(gbase) + (v1)), (LAS unsigned*)(lds + (bufoff) + ldsw + 8192), 16, 0, 0); } while (0)
#define G8_LDA(dst, b, h) do { _Pragma("unroll") for (int m = 0; m < 4; ++m) _Pragma("unroll") for (int k = 0; k < 2; ++k) dst[m][k] = *(const LAS bf16x8*)(lds + G8_SA(b, h) + aoff + m * 2048 + k * 1024); } while (0)
#define G8_LDB(dst, b, h) do { _Pragma("unroll") for (int n = 0; n < 2; ++n) _Pragma("unroll") for (int k = 0; k < 2; ++k) dst[n][k] = *(const LAS bf16x8*)(lds + G8_SB(b, h) + boff + n * 2048 + k * 1024); } while (0)
#define G8_MMA(ai, bj, At, Bt) do { __builtin_amdgcn_s_setprio(1); _Pragma("unroll") for (int m = 0; m < 4; ++m) _Pragma("unroll") for (int n = 0; n < 2; ++n) _Pragma("unroll") for (int k = 0; k < 2; ++k) \
        acc[ai][bj][m][n] = __builtin_amdgcn_mfma_f32_16x16x32_bf16(Bt[n][k], At[m][k], acc[ai][bj][m][n], 0, 0, 0); __builtin_amdgcn_s_setprio(0); } while (0)
#define G8_WAIT_V(n) asm volatile("s_waitcnt vmcnt(" #n ")" ::: "memory")
#define G8_WAIT_L(n) asm volatile("s_waitcnt lgkmcnt(" #n ")" ::: "memory")
#define G8_BAR __builtin_amdgcn_s_barrier()
#define G8_SCHED __builtin_amdgcn_sched_barrier(0)
#define G8_BK(u, t) ((t) < ks ? (u).B + (size_t)(t) * kstep : (u).B2 + (size_t)((t) - ks) * kstep)
    GUnit cur, nxt; int ui = 0;
    if (!S.next(0, cur)) return;
    f32x4 acc[2][2][4][2];
#pragma unroll
    for (int a = 0; a < 2; ++a)
#pragma unroll
        for (int b = 0; b < 2; ++b)
#pragma unroll
            for (int m = 0; m < 4; ++m)
#pragma unroll
                for (int n = 0; n < 2; ++n) acc[a][b][m][n] = (f32x4){0.f, 0.f, 0.f, 0.f};
    bf16x8 At[4][2], B0[2][2], B1[2][2];
    unsigned ca[2][2], na[2][2];
    S.aoff(cur, Rs, Cs, ca);
    { const char* b0 = G8_BK(cur, 0); const char* b1 = G8_BK(cur, 1);
      G8_STAGEB(G8_SB(0, 0), b0); G8_STAGEA(G8_SA(0, 0), cur.A, ca[0][0], ca[0][1]); G8_STAGEB(G8_SB(0, 1), b0 + hstepB); G8_STAGEA(G8_SA(0, 1), cur.A, ca[1][0], ca[1][1]);
      if (wr == 1) G8_BAR;
      G8_WAIT_V(4); G8_BAR;
      G8_STAGEB(G8_SB(1, 0), b1); G8_STAGEA(G8_SA(1, 0), cur.A + kstep, ca[0][0], ca[0][1]); G8_STAGEB(G8_SB(1, 1), b1 + hstepB);
      G8_WAIT_V(6); G8_BAR; }
    for (;;) {
        const bool has_next = S.next(ui + 1, nxt);
        if (has_next) S.aoff(nxt, Rs, Cs, na);
        else {
#pragma unroll
            for (int h = 0; h < 2; ++h)
#pragma unroll
                for (int i = 0; i < 2; ++i) na[h][i] = ca[h][i];
            nxt = cur; }
#pragma unroll 1
        for (int t = 0; t < nt; t += 2) {
            const bool last = (t == nt - 2);
            const char* a1 = cur.A + (size_t)(t + 1) * kstep;
            const char* a2 = last ? nxt.A : cur.A + (size_t)(t + 2) * kstep;
            const char* a3 = a2 + kstep;
            const char* b2 = last ? G8_BK(nxt, 0) : G8_BK(cur, t + 2);
            const char* b3 = last ? G8_BK(nxt, 1) : G8_BK(cur, t + 3);
            const unsigned x00 = last ? na[0][0] : ca[0][0], x01 = last ? na[0][1] : ca[0][1], x10 = last ? na[1][0] : ca[1][0], x11 = last ? na[1][1] : ca[1][1];
            G8_LDB(B0, 0, 0); G8_SCHED; G8_LDA(At, 0, 0); G8_STAGEA(G8_SA(1, 1), a1, ca[1][0], ca[1][1]);
            G8_WAIT_L(8); G8_BAR; G8_WAIT_L(0); G8_MMA(0, 0, At, B0); G8_BAR; G8_SCHED;
            G8_LDB(B1, 0, 1); G8_STAGEB(G8_SB(0, 0), b2);
            G8_BAR; G8_WAIT_L(0); G8_MMA(0, 1, At, B1); G8_BAR;
            G8_LDA(At, 0, 1); G8_STAGEA(G8_SA(0, 0), a2, x00, x01);
            G8_BAR; G8_WAIT_L(0); G8_MMA(1, 0, At, B0); G8_BAR; G8_SCHED;
            G8_STAGEB(G8_SB(0, 1), b2 + hstepB);
            G8_WAIT_V(6); G8_BAR; G8_MMA(1, 1, At, B1); G8_BAR;
            G8_LDB(B0, 1, 0); G8_SCHED; G8_LDA(At, 1, 0); G8_STAGEA(G8_SA(0, 1), a2, x10, x11);
            G8_WAIT_L(8); G8_BAR; G8_WAIT_L(0); G8_MMA(0, 0, At, B0); G8_BAR; G8_SCHED;
            G8_LDB(B1, 1, 1); G8_STAGEB(G8_SB(1, 0), b3);
            G8_BAR; G8_WAIT_L(0); G8_MMA(0, 1, At, B1); G8_BAR;
            G8_LDA(At, 1, 1); G8_STAGEA(G8_SA(1, 0), a3, x00, x01);
            G8_BAR; G8_WAIT_L(0); G8_MMA(1, 0, At, B0); G8_BAR; G8_SCHED;
            G8_STAGEB(G8_SB(1, 1), b3 + hstepB);
            G8_WAIT_V(6); G8_BAR; G8_MMA(1, 1, At, B1); G8_BAR;
        }
        E(acc, cur, wr, wc, fr, fq);
        if (!has_next) break;
#pragma unroll
        for (int a = 0; a < 2; ++a)
#pragma unroll
            for (int b = 0; b < 2; ++b)
#pragma unroll
                for (int m = 0; m < 4; ++m)
#pragma unroll
                    for (int n = 0; n < 2; ++n) acc[a][b][m][n] = (f32x4){0.f, 0.f, 0.f, 0.f};
        cur = nxt; ++ui;
#pragma unroll
        for (int h = 0; h < 2; ++h)
#pragma unroll
            for (int i = 0; i < 2; ++i) ca[h][i] = na[h][i];
    }
    G8_WAIT_V(0);
    if (wr == 0) G8_BAR;
    G8_BAR;
#undef G8_SA
#undef G8_SB
#undef G8_STAGEA
#undef G8_STAGEB
#undef G8_LDA
#undef G8_LDB
#undef G8_MMA
#undef G8_WAIT_V
#undef G8_WAIT_L
#undef G8_BAR
#undef G8_SCHED
#undef G8_BK
}

template <int MODE> struct MoeOrder {
    static constexpr int NPN = MODE == 1 ? 8 : 4;
    const LAS int* tab; const SortRec* recs; const bf16_t* A; const bf16_t* W; int G, c, layer;
    __device__ bool next(int i, GUnit& u) const {
        const int MT = __builtin_amdgcn_readfirstlane(tab[24]);
        int rt, pn;
        if ((G & 7) == 0) { const int x = c & 7, j = c >> 3, Gx = G >> 3, rt0 = (x * MT) >> 3, rt1 = ((x + 1) * MT) >> 3, q = i * Gx + j;
            rt = rt0 + q / NPN; pn = q % NPN; if (rt >= rt1) return false; }
        else { const int L = i * G + c; rt = L / NPN; pn = L % NPN; if (rt >= MT) return false; }
        int k = 0;
        for (int j = 1; j < 24; ++j) if (rt >= tab[j]) k = j;
        k = __builtin_amdgcn_readfirstlane(k);
        const int g = k / 6, pi = k % 6;
        const int a = pi < 3 ? 0 : (pi < 5 ? 1 : 2), b = pi < 3 ? pi + 1 : (pi < 5 ? pi - 1 : 3);
        const int lo = g * 4 + a, hi = g * 4 + b;
        u.ord = i; u.pm = rt; u.pn = pn; u.k = k; u.s0 = (rt - __builtin_amdgcn_readfirstlane(tab[k])) * BM; u.cnt = __builtin_amdgcn_readfirstlane(tab[32 + k]);
        if (MODE == 1) { u.A = (const char*)A; u.B = (const char*)(W + ((size_t)((layer * 16 + (pn < 4 ? lo : hi)) * 4 + (pn & 3))) * 256 * 1024); u.B2 = u.B; }
        else { u.A = (const char*)(A + (size_t)rt * BM * 1024); u.B = (const char*)(W + ((size_t)(layer * 16 + lo) * 1024 + pn * 256) * 512); u.B2 = (const char*)(W + ((size_t)(layer * 16 + hi) * 1024 + pn * 256) * 512); }
        return true;
    }
    __device__ __forceinline__ void aoff(const GUnit& u, const int (&R)[2], const int (&C)[2], unsigned (&vo)[2][2]) const {
#pragma unroll
        for (int h = 0; h < 2; ++h)
#pragma unroll
            for (int i = 0; i < 2; ++i) {
                if (MODE == 1) { const int slot = u.s0 + h * HALF + R[i]; int tok = recs[(size_t)u.k * T + slot].tok; tok = slot < u.cnt ? tok : 0; vo[h][i] = (unsigned)(tok * 1024 + C[i]) * 2u; }
                else vo[h][i] = (unsigned)((h * HALF + R[i]) * 1024 + C[i]) * 2u; }
    }
};
struct EpiGateUp {
    static constexpr bool PERM = true;
    bf16_t* HID; const SortRec* recs;
    __device__ __forceinline__ void operator()(const f32x4 (&acc)[2][2][4][2], const GUnit& u, int wr, int wc, int fr, int fq) const {
        const SortRec* rb = recs + (size_t)u.k * T;
        float wq[2][4], rsq[2][4];
#pragma unroll
        for (int ai = 0; ai < 2; ++ai)
#pragma unroll
            for (int m = 0; m < 4; ++m) { const float* rp = (const float*)(rb + (u.s0 + ai * HALF + wr * 64 + m * 16 + fr)); wq[ai][m] = rp[u.pn < 4 ? 1 : 2]; rsq[ai][m] = rp[3]; }
#pragma unroll
        for (int ai = 0; ai < 2; ++ai)
#pragma unroll
            for (int m = 0; m < 4; ++m) asm volatile("" : "+v"(wq[ai][m]), "+v"(rsq[ai][m]));
#pragma unroll
        for (int ai = 0; ai < 2; ++ai) {
#pragma unroll
            for (int m = 0; m < 4; ++m) { const int row = ai * HALF + wr * 64 + m * 16 + fr, slot = u.s0 + row;
                const float msk = slot < u.cnt ? 1.0f : 0.0f;
                const float w = wq[ai][m] * msk, rs = rsq[ai][m] * msk;
                float v[8];
#pragma unroll
                for (int n = 0; n < 2; ++n)
#pragma unroll
                    for (int j = 0; j < 4; ++j) { const float g = acc[ai][0][m][n][j] * rs, up = acc[ai][1][m][n][j] * rs;
                        v[n * 4 + j] = g * __builtin_amdgcn_rcpf(1.0f + __expf(-g)) * up * w; }
                u32x4 o; o.x = cvt_pk_bf16(v[0], v[1]); o.y = cvt_pk_bf16(v[2], v[3]); o.z = cvt_pk_bf16(v[4], v[5]); o.w = cvt_pk_bf16(v[6], v[7]);
                *(u32x4*)(HID + (size_t)(u.pm * BM + row) * 1024 + u.pn * 128 + wc * 32 + 8 * fq) = o; } }
    }
};
struct EpiScatterAdd {
    static constexpr bool PERM = true;
    bf16_t* xs; float* out; const SortRec* recs; bf16_t* dummy; float* ssx; int emit; float accscale;
    __device__ __forceinline__ void operator()(const f32x4 (&acc)[2][2][4][2], const GUnit& u, int wr, int wc, int fr, int fq) const {
        const int col0 = u.pn * BM + wc * 32 + 8 * fq;
        int tk[2][4];
#pragma unroll
        for (int ai = 0; ai < 2; ++ai)
#pragma unroll
            for (int m = 0; m < 4; ++m) tk[ai][m] = recs[(size_t)u.k * T + (u.s0 + ai * HALF + wr * 64 + m * 16 + fr)].tok;
#pragma unroll
        for (int ai = 0; ai < 2; ++ai)
#pragma unroll
            for (int m = 0; m < 4; ++m) asm volatile("" : "+v"(tk[ai][m]));
#pragma unroll
        for (int ai = 0; ai < 2; ++ai) {
            u32x4 rr8[4][2];
#pragma unroll
            for (int m = 0; m < 4; ++m) { const int slot = u.s0 + ai * HALF + wr * 64 + m * 16 + fr; const bf16_t* xp = (slot < u.cnt ? xs + (size_t)tk[ai][m] * 1024 : dummy) + col0;
#pragma unroll
                for (int bj = 0; bj < 2; ++bj) rr8[m][bj] = *(const u32x4*)(xp + bj * HALF); }
#pragma unroll
            for (int m = 0; m < 4; ++m)
#pragma unroll
                for (int bj = 0; bj < 2; ++bj) asm volatile("" : "+v"(rr8[m][bj]));
#pragma unroll
            for (int m = 0; m < 4; ++m) { const int row = ai * HALF + wr * 64 + m * 16 + fr, slot = u.s0 + row; const bool real = slot < u.cnt;
                bf16_t* xp = (real ? xs + (size_t)tk[ai][m] * 1024 : dummy) + col0;
                float ss = 0.f;
#pragma unroll
                for (int bj = 0; bj < 2; ++bj) { const u32x4 r = rr8[m][bj];
                    const f32x4 a0 = acc[ai][bj][m][0] * accscale, a1 = acc[ai][bj][m][1] * accscale;
                    const f32x4 x0 = (f32x4){__uint_as_float(r.x << 16) + a0[0], __uint_as_float(r.x & 0xffff0000u) + a0[1], __uint_as_float(r.y << 16) + a0[2], __uint_as_float(r.y & 0xffff0000u) + a0[3]};
                    const f32x4 x1 = (f32x4){__uint_as_float(r.z << 16) + a1[0], __uint_as_float(r.z & 0xffff0000u) + a1[1], __uint_as_float(r.w << 16) + a1[2], __uint_as_float(r.w & 0xffff0000u) + a1[3]};
                    if (emit) {
                        u32x4 w; w.x = cvt_pk_bf16(x0[0], x0[1]); w.y = cvt_pk_bf16(x0[2], x0[3]); w.z = cvt_pk_bf16(x1[0], x1[1]); w.w = cvt_pk_bf16(x1[2], x1[3]);
                        *(u32x4*)(xp + bj * HALF) = w;
                        const float b0 = __uint_as_float(w.x << 16), b1 = __uint_as_float(w.x & 0xffff0000u), b2 = __uint_as_float(w.y << 16), b3 = __uint_as_float(w.y & 0xffff0000u);
                        const float b4 = __uint_as_float(w.z << 16), b5 = __uint_as_float(w.z & 0xffff0000u), b6 = __uint_as_float(w.w << 16), b7 = __uint_as_float(w.w & 0xffff0000u);
                        ss += ((b0 * b0 + b1 * b1) + (b2 * b2 + b3 * b3)) + ((b4 * b4 + b5 * b5) + (b6 * b6 + b7 * b7));
                    } else if (real) { float* o = out + (size_t)tk[ai][m] * 1024 + col0 + bj * HALF; *(f32x4*)o = x0; *(f32x4*)(o + 4) = x1; } }
                if (emit) { ss += __shfl_xor(ss, 16); ss += __shfl_xor(ss, 32); if (real && fq == 0) ssx[(size_t)tk[ai][m] * 16 + u.pn * 4 + wc] = ss; } } }
    }
};
__device__ __forceinline__ void moe_build_tab(LAS int* tab, const int* cnt) {
    const int tidx = opaque_tid(); const int bidx = opaque_s((int)blockIdx.x), gdim = opaque_s((int)gridDim.x); (void)bidx; (void)gdim;
    if (tidx < 24) tab[32 + tidx] = __hip_atomic_load(cnt + tidx, __ATOMIC_RELAXED, __HIP_MEMORY_SCOPE_AGENT);
    __syncthreads();
    if (tidx == 0) { int acc = 0; for (int k = 0; k < 24; ++k) { tab[k] = acc; acc += (tab[32 + k] + BM - 1) / BM; } tab[24] = acc; }
    __syncthreads();
}
}

namespace at {
typedef __bf16 bf16x8b __attribute__((ext_vector_type(8)));
typedef float f32x8 __attribute__((ext_vector_type(8)));
typedef short s16x4 __attribute__((ext_vector_type(4)));
constexpr int VROWB = 192;
template <int DQK> struct Geo { static constexpr int KROWB = DQK * 2 + 16, KTB = 64 * KROWB, VTB = 64 * VROWB, BUF = KTB + VTB; };
constexpr int BIAS_OFF = 3 * (64 * (96 * 2 + 16) + 64 * VROWB);
constexpr int LDS_BYTES = BIAS_OFF + 4096 * 4;

struct Args { const bf16_t* Q; const bf16_t* K; const bf16_t* V; bf16_t* Y; const float* bias; const float* lamvec; const float* subln_g; const float* gq; const float* gk; const float* relb; int HQ, HKV, ng; float lam_init; };

__device__ __forceinline__ bf16x8 pack8(const f32x16& p, int s2) {
    f32x8 v;
    if (s2 == 0) v = __builtin_shufflevector(p, p, 0, 1, 2, 3, 4, 5, 6, 7); else v = __builtin_shufflevector(p, p, 8, 9, 10, 11, 12, 13, 14, 15);
    return __builtin_bit_cast(bf16x8, __builtin_convertvector(v, bf16x8b));
}
__device__ __forceinline__ bf16x8 tr_pair(const LAS unsigned char* p) {
    const s16x4 lo = __builtin_amdgcn_ds_read_tr16_b64_v4i16((LAS s16x4*)p);
    const s16x4 hi = __builtin_amdgcn_ds_read_tr16_b64_v4i16((LAS s16x4*)(p + 8 * VROWB));
    return __builtin_shufflevector(lo, hi, 0, 1, 2, 3, 4, 5, 6, 7);
}

template <int KIND>
__device__ __forceinline__ void attn_unit(LAS unsigned char* lds, const Args& a, const int b, const int h, const int qblk) {
    constexpr int DQK = KIND == 0 ? 96 : 64, NS = DQK / 16, CPR = DQK / 8;
    typedef Geo<DQK> G;
    const int tid = opaque_tid(), wid = __builtin_amdgcn_readfirstlane(tid >> 6), lane = tid & 63, r = lane & 31, hh = lane >> 5;
    const int hk = h / (a.HQ / a.HKV);
    const int q0w = qblk * 256 + wid * 32;
    const bf16_t* Kg = a.K + (size_t)(b * a.HKV + hk) * S * DQK;
    const bf16_t* Vg = a.V + (size_t)(b * a.HKV + hk) * S * 64;
    bf16x8 qf[NS];
    { const bf16_t* qp = a.Q + ((size_t)(b * a.HQ + h) * S + q0w + r) * DQK + 8 * hh;
#pragma unroll
      for (int s = 0; s < NS; ++s) qf[s] = *(const bf16x8*)(qp + 16 * s); }
    const int kkey0 = tid / CPR, kcc0 = tid % CPR, kkey1 = (tid + 512) / CPR, kcc1 = (tid + 512) % CPR;
    const bool k2 = (CPR == 12) && (tid < 256);
    const int vkey = tid >> 3, vcc = tid & 7;
    const unsigned kl0 = kkey0 * G::KROWB + kcc0 * 16, kl1 = kkey1 * G::KROWB + kcc1 * 16, vl = G::KTB + vkey * VROWB + vcc * 16;
    const bf16_t* kg0 = Kg + (size_t)kkey0 * DQK + kcc0 * 8; const bf16_t* kg1 = Kg + (size_t)kkey1 * DQK + kcc1 * 8; const bf16_t* vg = Vg + (size_t)vkey * 64 + vcc * 8;
    const unsigned ka = r * G::KROWB + hh * 16;
    const unsigned va = G::KTB + (4 * hh + ((lane & 15) >> 2)) * VROWB + (16 * ((lane >> 4) & 1) + 4 * (lane & 3)) * 2;
    LAS float* bl = (LAS float*)(lds + BIAS_OFF);
    float shift;
    { float mq = 0.f, mk = 0.f;
      for (int i = lane; i < a.ng; i += 64) { mq = fmaxf(mq, fabsf(a.gq[i])); mk = fmaxf(mk, fabsf(a.gk[i])); }
      float bm = (KIND == 2 && lane < 32) ? a.relb[lane * 8 + 4 + h] * LOG2E : 0.f;
#pragma unroll
      for (int o = 32; o >= 1; o >>= 1) { mq = fmaxf(mq, __shfl_xor(mq, o)); mk = fmaxf(mk, __shfl_xor(mk, o)); bm = fmaxf(bm, __shfl_xor(bm, o)); }
      shift = mq * mk * sqrtf((float)a.ng) * LOG2E * 1.02f + bm; }
    const float ninit = -shift;
    __syncthreads();
    if (KIND == 2) {
#pragma unroll
        for (int i = 0; i < 8; ++i) bl[tid + 512 * i] = a.bias[(size_t)h * 4096 + tid + 512 * i] - shift;
    }
    u32x4 t0, t1 = (u32x4){0u, 0u, 0u, 0u}, t2;
    { t0 = *(const u32x4*)kg0; if (k2) t1 = *(const u32x4*)kg1; t2 = *(const u32x4*)vg;
      *(LAS u32x4*)(lds + kl0) = t0; if (k2) *(LAS u32x4*)(lds + kl1) = t1; *(LAS u32x4*)(lds + vl) = t2; }
    constexpr int NT = S / 64;
    { const size_t go = 64; t0 = *(const u32x4*)(kg0 + go * DQK); if (k2) t1 = *(const u32x4*)(kg1 + go * DQK); t2 = *(const u32x4*)(vg + go * 64); }
    __syncthreads();
    f32x16 o0[2], o1[2]; float l0[4] = {0.f, 0.f, 0.f, 0.f}, l1[4] = {0.f, 0.f, 0.f, 0.f};
#pragma unroll
    for (int m = 0; m < 2; ++m)
#pragma unroll
        for (int i = 0; i < 16; ++i) { o0[m][i] = 0.f; o1[m][i] = 0.f; }
    bf16x8 kfr[NS], vfr[2][2];
    f32x16 sa0, sb0, sa1, sb1;
    auto ld_frags = [&](const bool has_next, const LAS unsigned char* kb, const int key0, f32x16& sa, f32x16& sb, const LAS unsigned char* vb) __attribute__((always_inline)) {
        if (has_next) {
#pragma unroll
            for (int s = 0; s < NS; ++s) kfr[s] = *(const LAS bf16x8*)(kb + ka + s * 32);
            if (KIND == 2) { const LAS float* bp = bl + ((key0 + 4 * hh) - (q0w + r) + 2048);
#pragma unroll
                for (int i = 0; i < 16; ++i) { const float bv = bp[(i & 3) + 8 * (i >> 2)]; sa[i] = bv; sb[i] = bv; } }
        }
#pragma unroll
        for (int s2 = 0; s2 < 2; ++s2)
#pragma unroll
            for (int m = 0; m < 2; ++m) vfr[s2][m] = tr_pair(vb + va + s2 * 16 * VROWB + m * 64);
    };
    auto qk_mma = [&](f32x16& sa, f32x16& sb) __attribute__((always_inline)) {
        if (KIND != 2) {
#pragma unroll
            for (int i = 0; i < 16; ++i) sa[i] = ninit; }
#pragma unroll
        for (int s = 0; s < NS; ++s) {
            if (KIND == 2 && s >= 2) sb = __builtin_amdgcn_mfma_f32_32x32x16_bf16(kfr[s], qf[s], sb, 0, 0, 0);
            else sa = __builtin_amdgcn_mfma_f32_32x32x16_bf16(kfr[s], qf[s], sa, 0, 0, 0);
        }
    };
    bf16x8 pa[2], pb[2];
    auto smx = [&](f32x16& sa, f32x16& sb) __attribute__((always_inline)) {
#pragma unroll
        for (int i = 0; i < 16; ++i) { sa[i] = __builtin_amdgcn_exp2f(sa[i]); l0[i & 3] += sa[i]; asm volatile("" : "+v"(l0[i & 3])); }
        pa[0] = pack8(sa, 0); pa[1] = pack8(sa, 1);
        if (KIND == 2) {
#pragma unroll
            for (int i = 0; i < 16; ++i) { sb[i] = __builtin_amdgcn_exp2f(sb[i]); l1[i & 3] += sb[i]; asm volatile("" : "+v"(l1[i & 3])); }
            pb[0] = pack8(sb, 0); pb[1] = pack8(sb, 1); }
    };
    auto pv_mma = [&]() __attribute__((always_inline)) {
#pragma unroll
        for (int s2 = 0; s2 < 2; ++s2)
#pragma unroll
            for (int m = 0; m < 2; ++m) {
                o0[m] = __builtin_amdgcn_mfma_f32_32x32x16_bf16(vfr[s2][m], pa[s2], o0[m], 0, 0, 0);
                if (KIND == 2) o1[m] = __builtin_amdgcn_mfma_f32_32x32x16_bf16(vfr[s2][m], pb[s2], o1[m], 0, 0, 0);
            }
    };
    {
#pragma unroll
      for (int s = 0; s < NS; ++s) kfr[s] = *(const LAS bf16x8*)(lds + ka + s * 32);
      if (KIND == 2) { const LAS float* bp = bl + ((4 * hh) - (q0w + r) + 2048);
#pragma unroll
          for (int i = 0; i < 16; ++i) { const float bv = bp[(i & 3) + 8 * (i >> 2)]; sa0[i] = bv; sb0[i] = bv; } }
      qk_mma(sa0, sb0); }
    unsigned cbo = 0, nbo = G::BUF;
    const bool stag = wid >= 4;
    if (stag) __builtin_amdgcn_s_setprio(1);
    auto tile_seam = [&](const int kt, LAS unsigned char* nb) __attribute__((always_inline)) {
        if (kt + 1 < NT) { *(LAS u32x4*)(nb + kl0) = t0; if (k2) *(LAS u32x4*)(nb + kl1) = t1; *(LAS u32x4*)(nb + vl) = t2; }
        __syncthreads();
        if (kt + 2 < NT) { const size_t go = (size_t)(kt + 2) * 64; t0 = *(const u32x4*)(kg0 + go * DQK); if (k2) t1 = *(const u32x4*)(kg1 + go * DQK); t2 = *(const u32x4*)(vg + go * 64); }
    };
#pragma unroll 1
    for (int kt = 0; kt < NT; ++kt) {
        const LAS unsigned char* cb = lds + cbo; LAS unsigned char* nb = lds + nbo;
        const bool more = kt + 1 < NT;
        ld_frags(true, cb + 32 * G::KROWB, kt * 64 + 32, sa1, sb1, cb);
        __builtin_amdgcn_sched_barrier(0);
        smx(sa0, sb0);
        __builtin_amdgcn_sched_barrier(0);
        if (stag) tile_seam(kt, nb);
        __builtin_amdgcn_sched_barrier(0);
        qk_mma(sa1, sb1); pv_mma();
        __builtin_amdgcn_sched_barrier(0);
        if (!stag) tile_seam(kt, nb);
        __builtin_amdgcn_sched_barrier(0);
        ld_frags(true, more ? (const LAS unsigned char*)nb : cb, (more ? kt + 1 : kt) * 64, sa0, sb0, cb + 32 * VROWB);
        __builtin_amdgcn_sched_barrier(0);
        smx(sa1, sb1);
        __builtin_amdgcn_sched_barrier(0);
        qk_mma(sa0, sb0); pv_mma();
        __builtin_amdgcn_sched_barrier(0);
        cbo = nbo; nbo = nbo + G::BUF; if (nbo >= 3 * G::BUF) nbo = 0;
    }
    if (stag) __builtin_amdgcn_s_setprio(0);
    float lt0 = (l0[0] + l0[1]) + (l0[2] + l0[3]); lt0 += __shfl_xor(lt0, 32);
    bf16_t* yp = a.Y + (size_t)(b * S + q0w + r) * 256 + h * 64 + 4 * hh;
    if (KIND != 2) {
        const float inv = 1.0f / lt0;
#pragma unroll
        for (int m = 0; m < 2; ++m)
#pragma unroll
            for (int g4 = 0; g4 < 4; ++g4) { uint2 w; w.x = pack2(o0[m][4 * g4] * inv, o0[m][4 * g4 + 1] * inv); w.y = pack2(o0[m][4 * g4 + 2] * inv, o0[m][4 * g4 + 3] * inv);
                *(uint2*)(yp + 32 * m + 8 * g4) = w; }
    } else {
        float lt1 = (l1[0] + l1[1]) + (l1[2] + l1[3]); lt1 += __shfl_xor(lt1, 32);
        float d01 = 0.f, d23 = 0.f;
#pragma unroll
        for (int e = 0; e < 32; ++e) { d01 += a.lamvec[e] * a.lamvec[32 + e]; d23 += a.lamvec[64 + e] * a.lamvec[96 + e]; }
        const float lam = expf(d01) - expf(d23) + a.lam_init;
        const float i0 = 1.0f / lt0, i1 = lam / lt1; float ss = 0.f;
#pragma unroll
        for (int m = 0; m < 2; ++m)
#pragma unroll
            for (int i = 0; i < 16; ++i) { const float v = o0[m][i] * i0 - o1[m][i] * i1; o0[m][i] = v; ss += v * v; }
        ss += __shfl_xor(ss, 32);
        const float rs = rsqrtf(ss * (1.0f / 64.0f) + EPS) * (1.0f - a.lam_init);
#pragma unroll
        for (int m = 0; m < 2; ++m)
#pragma unroll
            for (int g4 = 0; g4 < 4; ++g4) { const float4 gg = *(const float4*)(a.subln_g + 32 * m + 8 * g4 + 4 * hh);
                uint2 w; w.x = pack2(o0[m][4 * g4] * rs * gg.x, o0[m][4 * g4 + 1] * rs * gg.y); w.y = pack2(o0[m][4 * g4 + 2] * rs * gg.z, o0[m][4 * g4 + 3] * rs * gg.w);
                *(uint2*)(yp + 32 * m + 8 * g4) = w; }
    }
}
}


namespace at {
struct DilArgs { const bf16_t* Q; const bf16_t* K; const bf16_t* V; bf16_t* YBP; float* LB; const float* bias; const float* gq; const float* gk; const float* relb; };
constexpr int DKROWB = 144, DK_BYTES = 384 * DKROWB, DV_OFF = DK_BYTES, DBT_OFF = DK_BYTES + 384 * VROWB;
static_assert(DBT_OFF + 1024 <= 128 * 1024 + 1024, "dilated LDS layout");
struct DilStage { u32x4 kv[6], vv[6]; };
__device__ __forceinline__ void dil_fetch(DilStage& st, const DilArgs& a, const int tid, const int b, const int h, const int br, const int ublk) {
    const int lgd = br * 2, nsub = S >> lgd, bh = b * 4 + h, pbase = 256 * ublk - 64;
#pragma unroll
    for (int i = 0; i < 6; ++i) { const int c = tid + 512 * i, row = c >> 3, cc = c & 7; int pk = pbase + row; pk = pk < 0 ? 0 : (pk >= S ? S - 1 : pk);
        const int rho = pk >> (11 - lgd), lk = pk & (nsub - 1), t = (lk << lgd) + rho;
        st.kv[i] = *(const u32x4*)(a.K + ((size_t)bh * S + t) * 64 + cc * 8); st.vv[i] = *(const u32x4*)(a.V + ((size_t)bh * S + t) * 64 + cc * 8); }
}
__device__ __forceinline__ void dil_unit(LAS unsigned char* lds, const DilArgs& a, DilStage& st, const int b, const int h, const int br, const int ublk,
                                         const bool has_next, const int nb_, const int nh_, const int nbr_, const int nublk_) {
    const int tid = opaque_tid(), wid = __builtin_amdgcn_readfirstlane(tid >> 6), lane = tid & 63, r = lane & 31, hh = lane >> 5;
    const int lgd = br * 2, d = 1 << lgd, nsub = S >> lgd;
    const int bh = b * 4 + h;
    float shift;
    { float mq = 0.f, mk = 0.f;
      { mq = fabsf(a.gq[lane]); mk = fabsf(a.gk[lane]); }
      float bm = lane < 32 ? a.relb[lane * 8 + h] * LOG2E : 0.f;
#pragma unroll
      for (int o = 32; o >= 1; o >>= 1) { mq = fmaxf(mq, __shfl_xor(mq, o)); mk = fmaxf(mk, __shfl_xor(mk, o)); bm = fmaxf(bm, __shfl_xor(bm, o)); }
      shift = mq * mk * 8.0f * LOG2E * 1.02f + bm; }
    LAS float* bt = (LAS float*)(lds + DBT_OFF);
    __syncthreads();
    if (tid < 256) { const int jj = tid - 128; bt[tid] = (jj >= -64 && jj <= 64) ? a.bias[(size_t)h * 4096 + jj * d + 2048] - shift : -1.0e30f; }
#pragma unroll
    for (int i = 0; i < 6; ++i) { const int c = tid + 512 * i, row = c >> 3, cc = c & 7;
        *(LAS u32x4*)(lds + row * DKROWB + cc * 16) = st.kv[i]; *(LAS u32x4*)(lds + DV_OFF + row * VROWB + cc * 16) = st.vv[i]; }
    const int pi0 = 256 * ublk + 32 * wid, rho = pi0 >> (11 - lgd), l0 = pi0 & (nsub - 1);
    const int tq = ((l0 + r) << lgd) + rho;
    bf16x8 qf[4];
    { const bf16_t* qp = a.Q + ((size_t)bh * S + tq) * 64 + 8 * hh;
#pragma unroll
      for (int s = 0; s < 4; ++s) qf[s] = *(const bf16x8*)(qp + 16 * s); }
    __syncthreads();
    if (has_next) dil_fetch(st, a, tid, nb_, nh_, nbr_, nublk_);
    f32x16 o[2]; float l4[4] = {0.f, 0.f, 0.f, 0.f};
#pragma unroll
    for (int m = 0; m < 2; ++m)
#pragma unroll
        for (int i = 0; i < 16; ++i) o[m][i] = 0.f;
    const unsigned ka = (32 * wid + r) * DKROWB + hh * 16;
    const unsigned va = DV_OFF + (32 * wid + 4 * hh + ((lane & 15) >> 2)) * VROWB + (16 * ((lane >> 4) & 1) + 4 * (lane & 3)) * 2;
#pragma unroll
    for (int c = 0; c < 5; ++c) {
        const int lt = l0 + 32 * (c - 2);
        if (lt >= 0 && lt < nsub) {
            f32x16 sa;
            const LAS float* bp = bt + (32 * (c - 2) + 4 * hh - r + 128);
#pragma unroll
            for (int i = 0; i < 16; ++i) sa[i] = bp[(i & 3) + 8 * (i >> 2)];
#pragma unroll
            for (int s = 0; s < 4; ++s) { const bf16x8 kf = *(const LAS bf16x8*)(lds + ka + c * 32 * DKROWB + s * 32); sa = __builtin_amdgcn_mfma_f32_32x32x16_bf16(kf, qf[s], sa, 0, 0, 0); }
#pragma unroll
            for (int i = 0; i < 16; ++i) { sa[i] = __builtin_amdgcn_exp2f(sa[i]); l4[i & 3] += sa[i]; asm volatile("" : "+v"(l4[i & 3])); }
#pragma unroll
            for (int s2 = 0; s2 < 2; ++s2) { const bf16x8 pa = pack8(sa, s2);
#pragma unroll
                for (int m = 0; m < 2; ++m) { const bf16x8 vf = tr_pair(lds + va + c * 32 * VROWB + s2 * 16 * VROWB + m * 64); o[m] = __builtin_amdgcn_mfma_f32_32x32x16_bf16(vf, pa, o[m], 0, 0, 0); } }
        }
    }
    float lt0 = (l4[0] + l4[1]) + (l4[2] + l4[3]); lt0 += __shfl_xor(lt0, 32);
    const float inv = 1.0f / lt0;
    const int t = b * S + tq;
    bf16_t* yp = a.YBP + (size_t)br * T * 256 + (size_t)t * 256 + h * 64 + 4 * hh;
#pragma unroll
    for (int m = 0; m < 2; ++m)
#pragma unroll
        for (int g4 = 0; g4 < 4; ++g4) { uint2 w; w.x = pack2(o[m][4 * g4] * inv, o[m][4 * g4 + 1] * inv); w.y = pack2(o[m][4 * g4 + 2] * inv, o[m][4 * g4 + 3] * inv);
            *(uint2*)(yp + 32 * m + 8 * g4) = w; }
    if (hh == 0) a.LB[(size_t)br * T * 4 + (size_t)t * 4 + h] = lt0;
}
}

typedef const __attribute__((address_space(4))) Params* KParams;
__device__ __forceinline__ KParams kparams() { KParams k = (KParams)__builtin_amdgcn_kernarg_segment_ptr(); asm volatile("" : "+s"(k)); return k; }
constexpr int RSTAB_OFF = 128 * 1024 + 2048, CSTAB_OFF = RSTAB_OFF + 8192;
constexpr int LDS_TOTAL = CSTAB_OFF + 8192;
constexpr int NPHASE_LAYER = 11;
__device__ __forceinline__ Params load_params(KParams k) { Params p; p.x = k->x; p.rel_bias = k->rel_bias; p.norm1_g = k->norm1_g; p.w_in = k->w_in; p.mla_q_norm_g = k->mla_q_norm_g; p.mla_kv_norm_g = k->mla_kv_norm_g; p.mla_w_uq = k->mla_w_uq; p.mla_w_ukv = k->mla_w_ukv; p.mla_qk_g = k->mla_qk_g; p.dil_qk_g = k->dil_qk_g; p.gqa_qk_g = k->gqa_qk_g; p.diff_qk_g = k->diff_qk_g; p.diff_lambda = k->diff_lambda; p.diff_subln_g = k->diff_subln_g; p.mix_beta = k->mix_beta; p.w_out = k->w_out; p.norm2_g = k->norm2_g; p.rg_w = k->rg_w; p.rg_b = k->rg_b; p.re_w = k->re_w; p.re_b = k->re_b; p.w_gate = k->w_gate; p.w_up = k->w_up; p.w_down = k->w_down; p.out = k->out; p.ws = k->ws; return p; }
template <int PH> __device__ __forceinline__ void run_phase(const int layer, LAS unsigned char* lds, const bool dup = false) {
    const Params p = load_params(kparams());
    const int bidx = opaque_s((int)blockIdx.x), gdim = opaque_s((int)gridDim.x); (void)bidx; (void)gdim;
    unsigned char* ws = p.ws;
    const float* xin = layer == 0 ? p.x : p.out;
    if constexpr (PH == 0) {
        ph_prep_tables(p);
        ph_xcast(p);
        ph_prep_layer0(p, (LAS float*)lds);
    } else if constexpr (PH == 2) {
        g8::DenseOrder Sd; Sd.init((const bf16_t*)(ws + OFF_HN), 1024, (const bf16_t*)(ws + OFF_WIN) + (size_t)layer * NPROJ * 1024, 1024, T, NPROJ, gdim, bidx);
        LAS float* rstab = (LAS float*)(lds + RSTAB_OFF); LAS f32x2* cstab = (LAS f32x2*)(lds + CSTAB_OFF);
        { const int tidx = opaque_tid(); const float* ssx = (const float*)(ws + OFF_SSX); const float2* CS = (const float2*)(ws + OFF_CS);
          for (int i = tidx; i < 1024; i += 512) { const float2 c = CS[i]; cstab[i] = (f32x2){c.x, c.y}; }
          { const int half = tidx >> 8, rl = tidx & 255; f32x4 sv[4][4]; int okm = 0;
#pragma unroll
            for (int k = 0; k < 4; ++k) { g8::GUnit u; const bool ok = Sd.next(2 * k + half, u); const int pm = ok ? u.pm : 0; okm |= ok ? (1 << k) : 0;
                const f32x4* sp = (const f32x4*)(ssx + (size_t)(pm * 256 + rl) * 16); sv[k][0] = sp[0]; sv[k][1] = sp[1]; sv[k][2] = sp[2]; sv[k][3] = sp[3]; }
#pragma unroll
            for (int k = 0; k < 4; ++k) if (okm & (1 << k)) { const f32x4 s0 = sv[k][0], s1 = sv[k][1], s2 = sv[k][2], s3 = sv[k][3];
                const float tot = ((s0[0] + s0[1]) + (s0[2] + s0[3])) + ((s1[0] + s1[1]) + (s1[2] + s1[3])) + ((s2[0] + s2[1]) + (s2[2] + s2[3])) + ((s3[0] + s3[1]) + (s3[2] + s3[3]));
                rstab[(2 * k + half) * 256 + rl] = rsqrtf(tot * (1.0f / 1024.0f) + EPS); } }
          __syncthreads(); }
        g8::EpiInProj E; E.rstab = rstab; E.cstab = cstab; E.ssq = (float*)(ws + OFF_SSQ); E.sskv = (float*)(ws + OFF_SSKV); E.AMLA = (bf16_t*)(ws + OFF_AMLA); E.KR = (bf16_t*)(ws + OFF_KR);
        E.qB = (bf16_t*)(ws + OFF_QB); E.kB = (bf16_t*)(ws + OFF_KB); E.vB = (bf16_t*)(ws + OFF_VB); E.qC = (bf16_t*)(ws + OFF_QC); E.kC = (bf16_t*)(ws + OFF_KC); E.vC = (bf16_t*)(ws + OFF_VC);
        E.qD = (bf16_t*)(ws + OFF_QD); E.kD = (bf16_t*)(ws + OFF_KD); E.vD = (bf16_t*)(ws + OFF_VD);
        E.g_dil = p.dil_qk_g + layer * 128; E.g_gqa = p.gqa_qk_g + layer * 128; E.g_diff = p.diff_qk_g + layer * 64;
        g8::gemm_phase<g8::EpiInProj, g8::DenseOrder>(lds, Sd, E, 1024, 16, 1024);
    } else if constexpr (PH == 4) {
        ph_mla_up(p, layer, lds);
    } else if constexpr (PH == 6) {
        const float* bias = (const float*)(ws + OFF_BIAS);
        at::Args aD{}; aD.Q = (const bf16_t*)(ws + OFF_QD); aD.K = (const bf16_t*)(ws + OFF_KD); aD.V = (const bf16_t*)(ws + OFF_VD); aD.Y = (bf16_t*)(ws + OFF_YD);
        aD.gq = p.diff_qk_g + layer * 64; aD.gk = aD.gq + 32; aD.ng = 32; aD.HQ = 4; aD.HKV = 4; aD.bias = bias + 4 * 4096; aD.relb = p.rel_bias;
        aD.lamvec = p.diff_lambda + layer * 128; aD.lam_init = lambda_init_of(layer); aD.subln_g = p.diff_subln_g + layer * 64;
        at::Args aA{}; aA.Q = (const bf16_t*)(ws + OFF_QA); aA.K = (const bf16_t*)(ws + OFF_KA); aA.V = (const bf16_t*)(ws + OFF_VA); aA.Y = (bf16_t*)(ws + OFF_YA);
        aA.gq = p.mla_qk_g + layer * 192; aA.gk = aA.gq + 96; aA.ng = 96; aA.HQ = 4; aA.HKV = 4;
        at::Args aC{}; aC.Q = (const bf16_t*)(ws + OFF_QC); aC.K = (const bf16_t*)(ws + OFF_KC); aC.V = (const bf16_t*)(ws + OFF_VC); aC.Y = (bf16_t*)(ws + OFF_YC);
        aC.gq = p.gqa_qk_g + layer * 128; aC.gk = aC.gq + 64; aC.ng = 64; aC.HQ = 4; aC.HKV = 2;
        at::DilArgs aB{}; aB.Q = (const bf16_t*)(ws + OFF_QB); aB.K = (const bf16_t*)(ws + OFF_KB); aB.V = (const bf16_t*)(ws + OFF_VB); aB.YBP = (bf16_t*)(ws + OFF_YBP); aB.LB = (float*)(ws + OFF_LB);
        aB.bias = bias; aB.gq = p.dil_qk_g + layer * 128; aB.gk = aB.gq + 64; aB.relb = p.rel_bias;
        const int kinds = dup ? ATT_DUP_KINDS : 15;
        auto remap = [&](const int u) { if (gdim != 256) return u; const int i = u >> 8, c = u & 255, x = c & 7, sl = c >> 3; return ((x * 8 + i * 4 + (sl >> 3)) << 3) | (sl & 7); };
        if (kinds & 1) for (int u0 = bidx; u0 < 512; u0 += gdim) { const int u = remap(u0); at::attn_unit<2>(lds, aD, u >> 5, (u >> 3) & 3, u & 7); }
        if (kinds & 2) for (int u0 = bidx; u0 < 512; u0 += gdim) { const int u = remap(u0); at::attn_unit<0>(lds, aA, u >> 5, (u >> 3) & 3, u & 7); }
        if (kinds & 4) for (int u0 = bidx; u0 < 512; u0 += gdim) { const int u = remap(u0); at::attn_unit<1>(lds, aC, u >> 5, (u >> 3) & 3, u & 7); }
        if (kinds & 8) { at::DilStage st; const int tid0 = opaque_tid();
            if (bidx < 1536) at::dil_fetch(st, aB, tid0, bidx / 96, (bidx / 24) & 3, (bidx >> 3) % 3, bidx & 7);
            for (int u = bidx; u < 1536; u += gdim) { const int un = u + gdim; const bool hn = un < 1536;
                at::dil_unit(lds, aB, st, u / 96, (u / 24) & 3, (u >> 3) % 3, u & 7, hn, un / 96, (un / 24) & 3, (un >> 3) % 3, un & 7); } }
    } else if constexpr (PH == 7) {
        ph_mix(p, layer);
    } else if constexpr (PH == 8) {
        g8::EpiResidBf16 E; E.X = (bf16_t*)(ws + OFF_HN); E.ldc = 1024; E.accscale = dup ? 0.f : 1.f;
        g8::DenseOrder Sd; Sd.init((const bf16_t*)(ws + OFF_MIX), 1024, (const bf16_t*)(ws + OFF_WOUT) + (size_t)layer * 1024 * 1024, 1024, T, 1024, gdim, bidx);
        g8::gemm_phase<g8::EpiResidBf16, g8::DenseOrder>(lds, Sd, E, 1024, 16, 1024);
    } else if constexpr (PH == 9) {
        ph_norm2_route(p, layer, (LAS float*)lds, dup);
    } else if constexpr (PH == 10 || PH == 11) {
        constexpr int MODE = PH == 10 ? 1 : 2;
        LAS int* tab = (LAS int*)(lds + g8::STAGE_BYTES);
        g8::moe_build_tab(tab, (const int*)(ws + OFF_CNT) + layer * 32);
        g8::MoeOrder<MODE> Sm; Sm.tab = tab; Sm.recs = (const SortRec*)(ws + OFF_PERM); Sm.G = gdim; Sm.c = bidx; Sm.layer = layer;
        if constexpr (MODE == 1) { Sm.A = (const bf16_t*)(ws + OFF_HN); Sm.W = (const bf16_t*)(ws + OFF_WGU);
            g8::EpiGateUp E; E.HID = (bf16_t*)(ws + OFF_HID); E.recs = Sm.recs;
            g8::gemm_phase<g8::EpiGateUp, g8::MoeOrder<MODE>>(lds, Sm, E, 1024, 16, 1024);
            if (layer == 0 && !dup) {
                int mine = 0, most = 0; { g8::GUnit uu; while (Sm.next(mine, uu)) ++mine; const int MT = tab[24]; for (int x = 0; x < 8; ++x) { const int nu = ((((x + 1) * MT) >> 3) - ((x * MT) >> 3)) * 8; const int per = (nu + (gdim >> 3) - 1) / (gdim >> 3); most = per > most ? per : most; } }
                if (mine < most) prep_queue(p, 14 * (most - mine), (LAS float*)lds, (LAS int*)(lds + 64 * 1024)); }
        } else { Sm.A = (const bf16_t*)(ws + OFF_HID); Sm.W = (const bf16_t*)(ws + OFF_WDT);
            g8::EpiScatterAdd E; E.xs = (bf16_t*)(ws + OFF_HN); E.out = p.out; E.recs = Sm.recs; E.dummy = (bf16_t*)(ws + OFF_DUMMY); E.ssx = (float*)(ws + OFF_SSX); E.emit = layer + 1 < NL ? 1 : 0; E.accscale = dup ? 0.f : 1.f;
            g8::gemm_phase<g8::EpiScatterAdd, g8::MoeOrder<MODE>>(lds, Sm, E, 1024, 8, 512);
            if (layer == 0 && !dup) prep_queue(p, -1, (LAS float*)lds, (LAS int*)(lds + 64 * 1024));
        }
    }
}

#ifndef MK_FUSED
#define MK_FUSED 1
#endif
#ifndef DUP_MASK
#define DUP_MASK 0
#endif
#if MK_FUSED
__device__ __forceinline__ void grid_sync(const XcdBarrier& b0) { XcdBarrier b = b0; asm volatile("" : "+s"(b.bar), "+s"(b.x)); xcd_barrier(b); }
__global__ __launch_bounds__(512, 2) void k_mega(Params p) {
    extern __shared__ __attribute__((aligned(16))) unsigned char shm[];
    LAS unsigned char* lds = (LAS unsigned char*)shm;
    volatile LAS unsigned* xbw = (volatile LAS unsigned*)(lds + 128 * 1024 + 1024);
    if (threadIdx.x == 0) { xbw[0] = 0u; xbw[1] = 0u; }
    __syncthreads();
    XcdBarrier bar = xcd_barrier_post((unsigned*)(kparams()->ws + OFF_BAR), xbw);
    run_phase<0>(0, lds); grid_sync(bar); if constexpr ((DUP_MASK >> 0) & 1) { run_phase<0>(0, lds, true); grid_sync(bar); }
#pragma unroll 1
    for (int layer = 0; layer < NL; ++layer) {
        run_phase<2>(layer, lds); grid_sync(bar); if constexpr ((DUP_MASK >> 2) & 1) { run_phase<2>(layer, lds, true); grid_sync(bar); }
        run_phase<4>(layer, lds); grid_sync(bar); if constexpr ((DUP_MASK >> 4) & 1) { run_phase<4>(layer, lds, true); grid_sync(bar); }
        run_phase<6>(layer, lds); grid_sync(bar); if constexpr ((DUP_MASK >> 6) & 1) { run_phase<6>(layer, lds, true); grid_sync(bar); }
        run_phase<7>(layer, lds); grid_sync(bar); if constexpr ((DUP_MASK >> 7) & 1) { run_phase<7>(layer, lds, true); grid_sync(bar); }
        run_phase<8>(layer, lds); grid_sync(bar); if constexpr ((DUP_MASK >> 8) & 1) { run_phase<8>(layer, lds, true); grid_sync(bar); }
        run_phase<9>(layer, lds); grid_sync(bar); if constexpr ((DUP_MASK >> 9) & 1) { run_phase<9>(layer, lds, true); grid_sync(bar); }
        run_phase<10>(layer, lds); grid_sync(bar); if constexpr ((DUP_MASK >> 10) & 1) { run_phase<10>(layer, lds, true); grid_sync(bar); }
        run_phase<11>(layer, lds); grid_sync(bar); if constexpr ((DUP_MASK >> 11) & 1) { run_phase<11>(layer, lds, true); grid_sync(bar); }
    }
}
#else
template <int PH> __global__ __launch_bounds__(512, 2) void k_phase(Params p, int layer) {
    extern __shared__ __attribute__((aligned(16))) unsigned char shm[];
    run_phase<PH>(layer, (LAS unsigned char*)shm);
}
template <int PH> static void launch_phase(const Params& p, int layer, int grid, hipStream_t st) {
    static bool attr = false; if (!attr) { (void)hipFuncSetAttribute((const void*)k_phase<PH>, hipFuncAttributeMaxDynamicSharedMemorySize, LDS_TOTAL); attr = true; }
    hipLaunchKernelGGL((k_phase<PH>), dim3(grid), dim3(512), LDS_TOTAL, st, p, layer);
}
#endif

extern "C" void kernel_launch(void* const* d_in, const int* in_sizes, int n_in, void* d_out, int out_size, void* d_ws, size_t ws_size, hipStream_t stream) {
    Params p{};
    p.x = (const float*)d_in[0]; p.rel_bias = (const float*)d_in[1]; p.norm1_g = (const float*)d_in[2]; p.w_in = (const float*)d_in[3];
    p.mla_q_norm_g = (const float*)d_in[4]; p.mla_kv_norm_g = (const float*)d_in[5]; p.mla_w_uq = (const float*)d_in[6]; p.mla_w_ukv = (const float*)d_in[7];
    p.mla_qk_g = (const float*)d_in[8]; p.dil_qk_g = (const float*)d_in[9]; p.gqa_qk_g = (const float*)d_in[10]; p.diff_qk_g = (const float*)d_in[11];
    p.diff_lambda = (const float*)d_in[12]; p.diff_subln_g = (const float*)d_in[13]; p.mix_beta = (const float*)d_in[14]; p.w_out = (const float*)d_in[15];
    p.norm2_g = (const float*)d_in[16]; p.rg_w = (const float*)d_in[17]; p.rg_b = (const float*)d_in[18]; p.re_w = (const float*)d_in[19]; p.re_b = (const float*)d_in[20];
    p.w_gate = (const float*)d_in[21]; p.w_up = (const float*)d_in[22]; p.w_down = (const float*)d_in[23];
    p.out = (float*)d_out; p.ws = (unsigned char*)d_ws;
    static int grid = 0;
    if (!grid) {
        int dev = 0, cus = 0, per_cu = 0;
        (void)hipGetDevice(&dev);
        (void)hipDeviceGetAttribute(&cus, hipDeviceAttributeMultiprocessorCount, dev);
#if MK_FUSED
        (void)hipFuncSetAttribute((const void*)k_mega, hipFuncAttributeMaxDynamicSharedMemorySize, LDS_TOTAL);
        (void)hipOccupancyMaxActiveBlocksPerMultiprocessor(&per_cu, k_mega, 512, LDS_TOTAL);
#else
        per_cu = 1;
#endif
        if (cus <= 0) cus = 256;
        grid = per_cu >= 1 ? cus : 0;
        if (grid > 256) grid = 256;
    }
    (void)hipMemsetAsync(p.ws + OFF_BAR, 0, 64 * 1024, stream);
#if MK_FUSED
    if (grid > 0) hipLaunchKernelGGL(k_mega, dim3(grid), dim3(512), LDS_TOTAL, stream, p);
#else
    launch_phase<0>(p, 0, grid, stream);
    for (int l = 0; l < NL; ++l) {
        launch_phase<2>(p, l, grid, stream); launch_phase<4>(p, l, grid, stream);
        launch_phase<6>(p, l, grid, stream); launch_phase<7>(p, l, grid, stream); launch_phase<8>(p, l, grid, stream);
        launch_phase<9>(p, l, grid, stream); launch_phase<10>(p, l, grid, stream); launch_phase<11>(p, l, grid, stream);
    }
#endif
}
```

```cpp
#include <hip/hip_runtime.h>
#include <stdint.h>

typedef unsigned short bf16_t;
#ifndef ATT_DUP_KINDS
#define ATT_DUP_KINDS 15
#endif

constexpr int NB = 16, S = 2048, T = NB * S, DM = 1024, NL = 2;
constexpr int NPROJ = 2560;
constexpr int NIN = 2464;
constexpr float LOG2E = 1.4426950408889634f;
constexpr float EPS = 1e-6f;

constexpr size_t MiB = 1024ull * 1024ull;
constexpr size_t OFF_BAR   = 0;
constexpr size_t OFF_BIAS  = 64 * 1024;
constexpr size_t OFF_CS    = OFF_BIAS + 8 * 4096 * 4;
constexpr size_t OFF_WIN   = 1 * MiB;
constexpr size_t SZ_WIN    = (size_t)NL * NPROJ * 1024 * 2;
constexpr size_t OFF_WUP   = OFF_WIN + SZ_WIN;
constexpr size_t SZ_WUP    = (size_t)NL * 1024 * 384 * 2;
constexpr size_t OFF_WUPKV = OFF_WUP + (size_t)NL * 384 * 256 * 2;
constexpr size_t OFF_WOUT  = OFF_WUP + SZ_WUP;
constexpr size_t SZ_WOUT   = (size_t)NL * 1024 * 1024 * 2;
constexpr size_t OFF_WGU   = OFF_WOUT + SZ_WOUT;
constexpr size_t SZ_WGU    = (size_t)NL * 16 * 1024 * 1024 * 2;
constexpr size_t OFF_WDT   = OFF_WGU + SZ_WGU;
constexpr size_t SZ_WDT    = (size_t)NL * 16 * 1024 * 512 * 2;
constexpr size_t OFF_R1    = OFF_WDT + SZ_WDT;
constexpr size_t SZ_R1     = (size_t)T * 1024 * 2;
constexpr size_t OFF_R2    = OFF_R1 + SZ_R1;
constexpr size_t SZ_R2     = (size_t)T * NPROJ * 2;
constexpr size_t OFF_R5    = OFF_R2 + SZ_R2;
constexpr size_t SZ_H256   = (size_t)T * 256 * 2;
constexpr size_t OFF_QB = OFF_R5, OFF_KB = OFF_QB + SZ_H256, OFF_VB = OFF_KB + SZ_H256;
constexpr size_t OFF_QC = OFF_VB + SZ_H256, OFF_KC = OFF_QC + SZ_H256, OFF_VC = OFF_KC + SZ_H256 / 2;
constexpr size_t OFF_QD = OFF_VC + SZ_H256 / 2, OFF_KD = OFF_QD + SZ_H256, OFF_VD = OFF_KD + SZ_H256;
constexpr size_t OFF_KR    = OFF_VD + SZ_H256;
constexpr size_t OFF_ROUTE = OFF_KR + (size_t)T * 32 * 2;
constexpr size_t OFF_LB    = OFF_ROUTE + (size_t)T * 16;
constexpr size_t OFF_PERM  = OFF_LB + (size_t)3 * T * 4 * 4;
constexpr size_t OFF_SSX   = OFF_PERM + (size_t)24 * T * 16;
constexpr size_t OFF_SSQ   = OFF_SSX + (size_t)T * 16 * 4;
constexpr size_t OFF_SSKV  = OFF_SSQ + (size_t)T * 4 * 4;
constexpr size_t OFF_END   = OFF_SSKV + (size_t)T * 4 * 4;
constexpr size_t OFF_PREPQ = OFF_BAR + 24 * 1024;
constexpr size_t OFF_DUMMY = OFF_BAR + 32 * 1024;
constexpr size_t OFF_CNT   = OFF_BAR + 16 * 1024;
static_assert(OFF_END <= 512 * MiB, "workspace overflow");
constexpr size_t OFF_HN = OFF_R1;
constexpr size_t OFF_YA = OFF_R2 + 48 * MiB, OFF_YC = OFF_YA + SZ_H256, OFF_YD = OFF_YA + 2 * SZ_H256;
constexpr size_t OFF_AMLA = OFF_R2;
constexpr size_t OFF_QA = OFF_R2 + 96 * MiB;
constexpr size_t OFF_KA = OFF_QA + (size_t)T * 4 * 96 * 2;
constexpr size_t OFF_VA = OFF_KA + (size_t)T * 4 * 96 * 2;
constexpr size_t OFF_YBP = OFF_R2;
constexpr size_t OFF_MIX = OFF_R2 + 96 * MiB;
constexpr size_t OFF_HID = OFF_R2;

struct Params {
    const float* x; const float* rel_bias; const float* norm1_g; const float* w_in; const float* mla_q_norm_g; const float* mla_kv_norm_g;
    const float* mla_w_uq; const float* mla_w_ukv; const float* mla_qk_g; const float* dil_qk_g; const float* gqa_qk_g; const float* diff_qk_g;
    const float* diff_lambda; const float* diff_subln_g; const float* mix_beta; const float* w_out; const float* norm2_g;
    const float* rg_w; const float* rg_b; const float* re_w; const float* re_b; const float* w_gate; const float* w_up; const float* w_down;
    float* out; unsigned char* ws;
};

__device__ __forceinline__ float bf2f(bf16_t v) { return __uint_as_float(((unsigned)v) << 16); }
__device__ __forceinline__ bf16_t f2bf(float f) { unsigned u = __float_as_uint(f); u += 0x7fffu + ((u >> 16) & 1u); return (bf16_t)(u >> 16); }
__device__ __forceinline__ unsigned pack2(float lo, float hi) { unsigned r; asm("v_cvt_pk_bf16_f32 %0, %1, %2" : "=v"(r) : "v"(lo), "v"(hi)); return r; }
__device__ __forceinline__ void load8(const bf16_t* p, float (&x)[8]) {
    const uint4 v = *(const uint4*)p;
    x[0] = __uint_as_float(v.x << 16); x[1] = __uint_as_float(v.x & 0xffff0000u);
    x[2] = __uint_as_float(v.y << 16); x[3] = __uint_as_float(v.y & 0xffff0000u);
    x[4] = __uint_as_float(v.z << 16); x[5] = __uint_as_float(v.z & 0xffff0000u);
    x[6] = __uint_as_float(v.w << 16); x[7] = __uint_as_float(v.w & 0xffff0000u);
}
__device__ __forceinline__ void store8(bf16_t* p, const float (&x)[8]) {
    uint4 v; v.x = pack2(x[0], x[1]); v.y = pack2(x[2], x[3]); v.z = pack2(x[4], x[5]); v.w = pack2(x[6], x[7]);
    *(uint4*)p = v;
}
__device__ __forceinline__ float wave_sum(float v) {
#pragma unroll
    for (int o = 32; o >= 1; o >>= 1) v += __shfl_xor(v, o);
    return v;
}
__device__ __forceinline__ int opaque_s(int v) { asm volatile("" : "+s"(v)); return v; }
__device__ __forceinline__ int opaque_tid() { int t = threadIdx.x; asm volatile("" : "+v"(t)); return t; }
__device__ __forceinline__ float lambda_init_of(int layer) { return layer == 0 ? 0.2f : (0.8f - 0.6f * 0.7408182206817179f); }

#define LAS __attribute__((address_space(3)))
typedef short bf16x8 __attribute__((ext_vector_type(8)));
typedef float f32x4 __attribute__((ext_vector_type(4)));
typedef float f32x16 __attribute__((ext_vector_type(16)));
typedef unsigned u32x4 __attribute__((ext_vector_type(4)));
typedef float f32x2 __attribute__((ext_vector_type(2)));

#define XB_TMO      128
#define XB_XCNT(j)  (256  + 64 * (j))
#define XB_XSUB(j)  (1280 + 64 * (j))
#define XB_XGEN(j)  (2304 + 64 * (j))
#define XB_TOP      3328
#define XB_TOPGEN   3392
#define XCD_BAR_WORDS 3456
#define XB_SPIN_CAP (1u << 18)

__device__ __forceinline__ unsigned xb_ld(unsigned* p)              { return __hip_atomic_load(p, __ATOMIC_RELAXED, __HIP_MEMORY_SCOPE_AGENT); }
__device__ __forceinline__ unsigned xb_add(unsigned* p, unsigned v) { return __hip_atomic_fetch_add(p, v, __ATOMIC_RELAXED, __HIP_MEMORY_SCOPE_AGENT); }
__device__ __forceinline__ unsigned xb_xcc_id() { return (unsigned)__builtin_amdgcn_s_getreg((3 << 11) | 20) & 0xFu; }
#define XB_SPIN(cond, bar) do { unsigned _sp = 0; while (cond) { __builtin_amdgcn_s_sleep(1); \
    if ((++_sp & 255u) == 0u) { if (xb_ld(&(bar)[XB_TMO])) break; if (_sp > XB_SPIN_CAP) { atomicAdd(&(bar)[XB_TMO], 1u); break; } } } } while (0)

struct XcdBarrier {
    unsigned* bar; unsigned x;
    volatile LAS unsigned* st;
};

__device__ __forceinline__ XcdBarrier xcd_barrier_post(unsigned* bar, volatile LAS unsigned* st) {
    XcdBarrier b; b.bar = bar; b.x = xb_xcc_id(); b.st = st;
    if (threadIdx.x == 0) (void)xb_add(&bar[XB_XCNT(b.x)], 1u);
    return b;
}
__device__ __forceinline__ void xcd_barrier_complete(unsigned* bar, unsigned x, unsigned& nloc, unsigned& nx) {
    const unsigned G = gridDim.x * gridDim.y * gridDim.z;
    unsigned sum, cnt, mine, sp = 0u;
    for (;;) {
        sum = 0u; cnt = 0u; mine = 0u;
#pragma unroll
        for (unsigned j = 0; j < 16; ++j) { const unsigned c = xb_ld(&bar[XB_XCNT(j)]); sum += c; cnt += (c > 0u) ? 1u : 0u; mine = (j == x) ? c : mine; }
        if (sum == G) break;
        __builtin_amdgcn_s_sleep(1);
        if ((++sp & 255u) == 0u) { if (xb_ld(&bar[XB_TMO])) break; if (sp > XB_SPIN_CAP) { atomicAdd(&bar[XB_TMO], 1u); break; } }
    }
    nloc = mine > 0u ? mine : 1u; nx = cnt > 0u ? cnt : 1u;
}

__device__ __forceinline__ void xcd_barrier(const XcdBarrier& b) {
    asm volatile("s_waitcnt vmcnt(0)" ::: "memory");
    __syncthreads();
    if (threadIdx.x == 0) {
        unsigned* bar = b.bar;
        __builtin_amdgcn_s_waitcnt(0);
        unsigned nloc = b.st[0], nx = b.st[1];
        if (nloc == 0u) { xcd_barrier_complete(bar, b.x, nloc, nx); b.st[0] = nloc; b.st[1] = nx; }
        const unsigned old = xb_add(&bar[XB_XSUB(b.x)], 1u);
        const unsigned gen = old / nloc;
        if (old + 1u == (gen + 1u) * nloc) {
            __builtin_amdgcn_fence(__ATOMIC_RELEASE, "agent");
            asm volatile("s_waitcnt vmcnt(0)" ::: "memory");
            const unsigned og = xb_add(&bar[XB_TOP], 1u);
            const unsigned tg = og / nx;
            if (og + 1u == (tg + 1u) * nx) xb_add(&bar[XB_TOPGEN], 1u);
            else XB_SPIN(xb_ld(&bar[XB_TOPGEN]) == tg, bar);
            __builtin_amdgcn_fence(__ATOMIC_ACQUIRE, "agent");
            xb_add(&bar[XB_XGEN(b.x)], 1u);
            asm volatile("s_waitcnt vmcnt(0)" ::: "memory");
        } else {
            XB_SPIN(xb_ld(&bar[XB_XGEN(b.x)]) == gen, bar);
            __builtin_amdgcn_fence(__ATOMIC_ACQUIRE, "agent");
            asm volatile("s_waitcnt vmcnt(0)" ::: "memory");
        }
    }
    __syncthreads();
}


__device__ __forceinline__ void ph_prep_tables(const Params& p) {
    const int tidx = opaque_tid(); const int bidx = opaque_s((int)blockIdx.x), gdim = opaque_s((int)gridDim.x); (void)bidx; (void)gdim;
    float* bias = (float*)(p.ws + OFF_BIAS);
    float2* cs = (float2*)(p.ws + OFF_CS);
    for (int gid = bidx * blockDim.x + tidx; gid < 8 * 4096; gid += gdim * blockDim.x) {
        const int hh = gid >> 12, rel = (gid & 4095) - 2048;
        const int n = rel < 0 ? -rel : rel;
        int bucket;
        if (n < 8) bucket = n;
        else { const double lr = log((double)n / 8.0) / log(128.0); int large = 8 + (int)(lr * 8.0); bucket = large < 15 ? large : 15; }
        if (rel > 0) bucket += 16;
        bias[gid] = p.rel_bias[bucket * 8 + hh] * LOG2E;
        { const int pos = gid >> 4, i = gid & 15;
          const double inv = pow(10000.0, -(double)i / 16.0), ang = (double)pos * inv;
          cs[gid] = make_float2((float)cos(ang), (float)sin(ang)); }
    }
}

__device__ __forceinline__ int inproj_col(int n) {
    const int pn = n >> 8, phi = n & 255, bj = phi >> 7, wc = (phi >> 5) & 3, fq = (phi >> 3) & 3, nn = (phi >> 2) & 1, jj = phi & 3;
    const int e = 32 * bj + 8 * fq + 4 * nn + jj, L = 32 * bj + 16 * nn + 4 * fq + jj;
    switch (pn) {
        case 0: return phi;
        case 1: return phi < 128 ? 256 + phi : (phi < 160 ? 384 + (phi - 128) : -1);
        case 2: return 416 + 64 * wc + e;
        case 3: return 672 + 64 * wc + e;
        case 4: return 928 + 64 * wc + e;
        case 5: return 1184 + 64 * wc + L;
        case 6: return wc < 2 ? 1440 + 64 * wc + L : 1568 + 64 * (wc - 2) + e;
        case 7: return 1696 + 64 * wc + e;
        case 8: return 1952 + 64 * wc + e;
        default: return 2208 + 64 * wc + e;
    }
}
template <int KIND> __device__ __forceinline__ float prep_src(const Params& p, int batch, int n, int k) {
    if (KIND == 0) {
        const int oc = inproj_col(n);
        return oc < 0 ? 0.f : p.w_in[((size_t)batch * 1024 + k) * NIN + oc] * p.norm1_g[batch * 1024 + k];
    } else if (KIND == 1) {
        return p.mla_w_uq[((size_t)batch * 256 + k) * 384 + n] * p.mla_q_norm_g[batch * 256 + k];
    } else if (KIND == 2) {
        return p.w_out[((size_t)batch * 1024 + k) * 1024 + n];
    } else if (KIND == 3) {
        const int c = n >> 8, r = n & 255;
        return r < 128 ? p.w_gate[((size_t)batch * 1024 + k) * 512 + c * 128 + r] : p.w_up[((size_t)batch * 1024 + k) * 512 + c * 128 + (r - 128)];
    } else {
        return p.w_down[((size_t)batch * 512 + k) * 1024 + n];
    }
}
template <int KIND> __device__ __forceinline__ f32x4 prep_src4(const Params& p, int batch, int n, int k) {
    const f32x4 z = (f32x4){0.f, 0.f, 0.f, 0.f};
    if (KIND == 0) {
        const int oc = inproj_col(n);
        return oc < 0 ? z : *(const f32x4*)(p.w_in + ((size_t)batch * 1024 + k) * NIN + oc) * p.norm1_g[batch * 1024 + k];
    } else if (KIND == 1) {
        return *(const f32x4*)(p.mla_w_uq + ((size_t)batch * 256 + k) * 384 + n) * p.mla_q_norm_g[batch * 256 + k];
    } else if (KIND == 5) {
        return *(const f32x4*)(p.mla_w_ukv + ((size_t)batch * 128 + k) * 512 + n) * p.mla_kv_norm_g[batch * 128 + k];
    } else if (KIND == 2) {
        return *(const f32x4*)(p.w_out + ((size_t)batch * 1024 + k) * 1024 + n);
    } else if (KIND == 3) {
        const int c = n >> 8, r = n & 255;
        const float g2 = p.norm2_g[(batch >> 4) * 1024 + k];
        return (r < 128 ? *(const f32x4*)(p.w_gate + ((size_t)batch * 1024 + k) * 512 + c * 128 + r) : *(const f32x4*)(p.w_up + ((size_t)batch * 1024 + k) * 512 + c * 128 + (r - 128))) * g2;
    } else {
        return *(const f32x4*)(p.w_down + ((size_t)batch * 512 + k) * 1024 + n);
    }
}
template <int KIND> __device__ __forceinline__ void prep_tile(const Params& p, const int tidx, const int N, const int K, const int batch, const int rem, const size_t dst_off, LAS float* tile) {
    const int rn = (tidx & 31) * 4, rk = tidx >> 5;
    const int ntn = N / 128, k0 = (rem / ntn) * 64, n0 = (rem % ntn) * 128;
    f32x4 v[4];
#pragma unroll
    for (int i = 0; i < 4; ++i) v[i] = prep_src4<KIND>(p, batch, n0 + rn, k0 + rk + 16 * i);
    __syncthreads();
#pragma unroll
    for (int i = 0; i < 4; ++i)
#pragma unroll
        for (int e = 0; e < 4; ++e) tile[(rk + 16 * i) * 129 + rn + e] = v[i][e];
    __syncthreads();
    bf16_t* dst = (bf16_t*)(p.ws + dst_off) + (size_t)batch * N * K;
#pragma unroll
    for (int q = 0; q < 2; ++q) { const int c = tidx + 512 * q, wn = c >> 3, wkc = c & 7;
        float o[8];
#pragma unroll
        for (int jx = 0; jx < 8; ++jx) o[jx] = tile[(wkc * 8 + jx) * 129 + wn];
        store8(dst + (size_t)(n0 + wn) * K + k0 + wkc * 8, o); }
}
constexpr int PREP_TILES = 3540;
__device__ __forceinline__ void prep_layer_tile(const Params& p, const int tidx, const int layer, const int q, LAS float* tile) {
    if (q < 320) prep_tile<0>(p, tidx, NPROJ, 1024, layer, q, OFF_WIN, tile);
    else if (q < 332) prep_tile<1>(p, tidx, 384, 256, layer, q - 320, OFF_WUP, tile);
    else if (q < 340) prep_tile<5>(p, tidx, 512, 128, layer, q - 332, OFF_WUPKV, tile);
    else if (q < 468) prep_tile<2>(p, tidx, 1024, 1024, layer, q - 340, OFF_WOUT, tile);
    else if (q < 2516) prep_tile<3>(p, tidx, 1024, 1024, layer * 16 + ((q - 468) >> 7), (q - 468) & 127, OFF_WGU, tile);
    else prep_tile<4>(p, tidx, 1024, 512, layer * 16 + ((q - 2516) >> 6), (q - 2516) & 63, OFF_WDT, tile);
}
__device__ __forceinline__ void ph_prep_layer0(const Params& p, LAS float* tile) {
    const int tidx = opaque_tid(); const int bidx = opaque_s((int)blockIdx.x), gdim = opaque_s((int)gridDim.x);
    for (int q = bidx; q < PREP_TILES; q += gdim) prep_layer_tile(p, tidx, 0, q, tile);
}
__device__ __forceinline__ void prep_queue(const Params& p, const int budget, LAS float* tile, LAS int* slot) {
    const int tidx = opaque_tid();
    int* head = (int*)(p.ws + OFF_PREPQ);
    for (int n = 0; budget < 0 || n < budget; ++n) {
        __syncthreads();
        if (tidx == 0) *slot = atomicAdd(head, 1);
        __syncthreads();
        const int q = *slot;
        if (q >= PREP_TILES) break;
        prep_layer_tile(p, tidx, 1, q, tile);
    }
}

__device__ __forceinline__ void ph_xcast(const Params& p) {
    const int tidx = opaque_tid(); const int bidx = opaque_s((int)blockIdx.x), gdim = opaque_s((int)gridDim.x);
    const int lane = tidx & 63, wv = (bidx * blockDim.x + tidx) >> 6, nw = (gdim * blockDim.x) >> 6;
    bf16_t* xb = (bf16_t*)(p.ws + OFF_HN); float* ssx = (float*)(p.ws + OFF_SSX);
    for (int t0 = wv; t0 < T; t0 += 2 * nw) {
        float4 v[2][4];
#pragma unroll
        for (int k = 0; k < 2; ++k) { const int t = t0 + k * nw < T ? t0 + k * nw : t0;
#pragma unroll
            for (int i = 0; i < 4; ++i) v[k][i] = *(const float4*)(p.x + (size_t)t * 1024 + i * 256 + lane * 4); }
#pragma unroll
        for (int k = 0; k < 2; ++k) { const int t = t0 + k * nw; if (t < T) {
            float ss = 0.f;
#pragma unroll
            for (int i = 0; i < 4; ++i) ss += v[k][i].x * v[k][i].x + v[k][i].y * v[k][i].y + v[k][i].z * v[k][i].z + v[k][i].w * v[k][i].w;
            ss = wave_sum(ss);
#pragma unroll
            for (int i = 0; i < 4; ++i) { uint2 o; o.x = pack2(v[k][i].x, v[k][i].y); o.y = pack2(v[k][i].z, v[k][i].w); *(uint2*)(xb + (size_t)t * 1024 + i * 256 + lane * 4) = o; }
            if (lane < 16) ssx[(size_t)t * 16 + lane] = lane == 0 ? ss : 0.f; } }
    }
}

typedef float f32x4m __attribute__((ext_vector_type(4)));
__device__ __forceinline__ void ph_mla_up(const Params& p, int layer, LAS unsigned char* lds) {
    const int tidx = opaque_tid(); const int bidx = opaque_s((int)blockIdx.x), gdim = opaque_s((int)gridDim.x);
    const int wid = __builtin_amdgcn_readfirstlane(tidx >> 6), lane = tidx & 63, tk = lane & 15, kg = lane >> 4;
    unsigned char* ws = p.ws;
    const bf16_t* AMLA = (const bf16_t*)(ws + OFF_AMLA); const bf16_t* KR = (const bf16_t*)(ws + OFF_KR);
    const float* ssq = (const float*)(ws + OFF_SSQ); const float* sskv = (const float*)(ws + OFF_SSKV);
    const bf16_t* Wq = (const bf16_t*)(ws + OFF_WUP) + (size_t)layer * 384 * 256; const bf16_t* Wkv = (const bf16_t*)(ws + OFF_WUPKV) + (size_t)layer * 512 * 128;
    bf16_t* qA = (bf16_t*)(ws + OFF_QA); bf16_t* kA = (bf16_t*)(ws + OFF_KA); bf16_t* vA = (bf16_t*)(ws + OFF_VA);
    const float2* CS = (const float2*)(ws + OFF_CS);
    const float* gq = p.mla_qk_g + layer * 192; const float* gk = gq + 96;
    constexpr int QPB = 256 * 2 + 16, KPB = 128 * 2 + 16, KV_OFF = 96 * QPB;
    const float qscale = 0.10206207261596577f * LOG2E;
    LAS float* gl = (LAS float*)(lds + 88 * 1024);
    __syncthreads();
    if (tidx < 192) gl[tidx] = gq[tidx];
    __syncthreads();
    for (int grp = bidx; grp < T / 128; grp += gdim) {
        const int t = grp * 128 + wid * 16 + tk, b = t >> 11, sq = t & 2047;
        bf16x8 bq[8], bk[4];
        { const bf16_t* ap = AMLA + (size_t)t * 384 + 8 * kg;
#pragma unroll
          for (int s8 = 0; s8 < 8; ++s8) bq[s8] = *(const bf16x8*)(ap + 32 * s8);
#pragma unroll
          for (int s4 = 0; s4 < 4; ++s4) bk[s4] = *(const bf16x8*)(ap + 256 + 32 * s4); }
        const f32x4m a4 = *(const f32x4m*)(ssq + (size_t)t * 4), c4 = *(const f32x4m*)(sskv + (size_t)t * 4);
        const float rq = rsqrtf(((a4[0] + a4[1]) + (a4[2] + a4[3])) * (1.0f / 256.0f) + EPS), rk = rsqrtf(((c4[0] + c4[1]) + (c4[2] + c4[3])) * (1.0f / 128.0f) + EPS);
        float kr[2][4];
#pragma unroll
        for (int u = 0; u < 2; ++u) { const uint2 w = *(const uint2*)(KR + (size_t)t * 32 + 16 * u + 4 * kg);
            kr[u][0] = __uint_as_float(w.x << 16); kr[u][1] = __uint_as_float(w.x & 0xffff0000u); kr[u][2] = __uint_as_float(w.y << 16); kr[u][3] = __uint_as_float(w.y & 0xffff0000u); }
        float krss = 0.f;
#pragma unroll
        for (int u = 0; u < 2; ++u)
#pragma unroll
            for (int e = 0; e < 4; ++e) krss += kr[u][e] * kr[u][e];
        float2 cs[4];
#pragma unroll
        for (int e = 0; e < 4; ++e) cs[e] = CS[sq * 16 + 4 * kg + e];
        u32x4 wst[10];
#pragma unroll
        for (int i = 0; i < 6; ++i) { const int c = tidx + 512 * i; wst[i] = *(const u32x4*)(Wq + (size_t)(c >> 5) * 256 + (c & 31) * 8); }
#pragma unroll
        for (int i = 0; i < 4; ++i) { const int c = tidx + 512 * i; wst[6 + i] = *(const u32x4*)(Wkv + (size_t)(c >> 4) * 128 + (c & 15) * 8); }
#pragma unroll 1
        for (int h = 0; h < 4; ++h) {
            __syncthreads();
#pragma unroll
            for (int i = 0; i < 6; ++i) { const int c = tidx + 512 * i; *(LAS u32x4*)(lds + (c >> 5) * QPB + (c & 31) * 16) = wst[i]; }
#pragma unroll
            for (int i = 0; i < 4; ++i) { const int c = tidx + 512 * i; *(LAS u32x4*)(lds + KV_OFF + (c >> 4) * KPB + (c & 15) * 16) = wst[6 + i]; }
            __syncthreads();
            if (h < 3) {
#pragma unroll
                for (int i = 0; i < 6; ++i) { const int c = tidx + 512 * i; wst[i] = *(const u32x4*)(Wq + (size_t)(96 * (h + 1) + (c >> 5)) * 256 + (c & 31) * 8); }
#pragma unroll
                for (int i = 0; i < 4; ++i) { const int c = tidx + 512 * i; wst[6 + i] = *(const u32x4*)(Wkv + (size_t)(128 * (h + 1) + (c >> 4)) * 128 + (c & 15) * 8); } }
            const size_t orow = (size_t)(b * 4 + h) * S + sq;
            float qv[6][4]; float ss = 0.f;
#pragma unroll
            for (int mt = 0; mt < 6; ++mt) { f32x4 acc = (f32x4){0.f, 0.f, 0.f, 0.f};
#pragma unroll
                for (int s8 = 0; s8 < 8; ++s8) { const bf16x8 af = *(const LAS bf16x8*)(lds + (16 * mt + tk) * QPB + (32 * s8 + 8 * kg) * 2); acc = __builtin_amdgcn_mfma_f32_16x16x32_bf16(af, bq[s8], acc, 0, 0, 0); }
#pragma unroll
                for (int e = 0; e < 4; ++e) { qv[mt][e] = acc[e] * rq; ss += qv[mt][e] * qv[mt][e]; } }
            ss += __shfl_xor(ss, 16); ss += __shfl_xor(ss, 32);
            { const float rn = rsqrtf(ss * (1.0f / 96.0f) + EPS);
#pragma unroll
              for (int mt = 0; mt < 6; ++mt)
#pragma unroll
                  for (int e = 0; e < 4; ++e) qv[mt][e] *= rn * gl[16 * mt + 4 * kg + e];
#pragma unroll
              for (int e = 0; e < 4; ++e) { const float lo = qv[4][e], hi = qv[5][e]; qv[4][e] = lo * cs[e].x - hi * cs[e].y; qv[5][e] = hi * cs[e].x + lo * cs[e].y; }
#pragma unroll
              for (int mt = 0; mt < 6; ++mt) { uint2 w; w.x = pack2(qv[mt][0] * qscale, qv[mt][1] * qscale); w.y = pack2(qv[mt][2] * qscale, qv[mt][3] * qscale);
                  *(uint2*)(qA + orow * 96 + 16 * mt + 4 * kg) = w; } }
            float kv[8][4]; float sk = krss;
#pragma unroll
            for (int mt = 0; mt < 8; ++mt) { f32x4 acc = (f32x4){0.f, 0.f, 0.f, 0.f};
#pragma unroll
                for (int s4 = 0; s4 < 4; ++s4) { const bf16x8 af = *(const LAS bf16x8*)(lds + KV_OFF + (16 * mt + tk) * KPB + (32 * s4 + 8 * kg) * 2); acc = __builtin_amdgcn_mfma_f32_16x16x32_bf16(af, bk[s4], acc, 0, 0, 0); }
#pragma unroll
                for (int e = 0; e < 4; ++e) { kv[mt][e] = acc[e] * rk; if (mt < 4) sk += kv[mt][e] * kv[mt][e]; } }
            sk += __shfl_xor(sk, 16); sk += __shfl_xor(sk, 32);
            { const float rn = rsqrtf(sk * (1.0f / 96.0f) + EPS);
#pragma unroll
              for (int mt = 0; mt < 4; ++mt) { uint2 w;
                  w.x = pack2(kv[mt][0] * rn * gl[96 + 16 * mt + 4 * kg + 0], kv[mt][1] * rn * gl[96 + 16 * mt + 4 * kg + 1]); w.y = pack2(kv[mt][2] * rn * gl[96 + 16 * mt + 4 * kg + 2], kv[mt][3] * rn * gl[96 + 16 * mt + 4 * kg + 3]);
                  *(uint2*)(kA + orow * 96 + 16 * mt + 4 * kg) = w; }
              float lo[4], hi[4];
#pragma unroll
              for (int e = 0; e < 4; ++e) { const float a = kr[0][e] * rn * gl[96 + 64 + 4 * kg + e], bb = kr[1][e] * rn * gl[96 + 80 + 4 * kg + e]; lo[e] = a * cs[e].x - bb * cs[e].y; hi[e] = bb * cs[e].x + a * cs[e].y; }
              uint2 w; w.x = pack2(lo[0], lo[1]); w.y = pack2(lo[2], lo[3]); *(uint2*)(kA + orow * 96 + 64 + 4 * kg) = w;
              w.x = pack2(hi[0], hi[1]); w.y = pack2(hi[2], hi[3]); *(uint2*)(kA + orow * 96 + 80 + 4 * kg) = w;
#pragma unroll
              for (int mt = 4; mt < 8; ++mt) { uint2 wv; wv.x = pack2(kv[mt][0], kv[mt][1]); wv.y = pack2(kv[mt][2], kv[mt][3]); *(uint2*)(vA + orow * 64 + 16 * (mt - 4) + 4 * kg) = wv; } }
        }
    }
}

__device__ __forceinline__ void ph_mix(const Params& p, int layer) {
    const int tidx = opaque_tid(); const int bidx = opaque_s((int)blockIdx.x), gdim = opaque_s((int)gridDim.x);
    const int lane = tidx & 63, wv = (bidx * blockDim.x + tidx) >> 6, nw = (gdim * blockDim.x) >> 6;
    unsigned char* ws = p.ws;
    const bf16_t* YA = (const bf16_t*)(ws + OFF_YA); const bf16_t* YC = (const bf16_t*)(ws + OFF_YC); const bf16_t* YD = (const bf16_t*)(ws + OFF_YD);
    const bf16_t* YBP = (const bf16_t*)(ws + OFF_YBP); const float* LB = (const float*)(ws + OFF_LB);
    bf16_t* MIX = (bf16_t*)(ws + OFF_MIX);
    const float* beta = p.mix_beta + layer * 1024;
    const bool hiH = lane >= 32; const int cc = (lane & 31) * 8, hB = cc >> 6;
    float bt[2][8];
#pragma unroll
    for (int ps = 0; ps < 2; ++ps)
#pragma unroll
        for (int e = 0; e < 8; ++e) bt[ps][e] = beta[(ps * 64 + lane) * 8 + e];
    for (int t0 = wv; t0 < T; t0 += 2 * nw) {
        u32x4 v[2][2][3]; float lw[2][3];
#pragma unroll
        for (int k = 0; k < 2; ++k) { const int t = t0 + k * nw < T ? t0 + k * nw : t0;
            const bf16_t* p0a = (hiH ? YBP : YA) + (size_t)t * 256 + cc;
            const bf16_t* p0b = hiH ? YBP + (size_t)T * 256 + (size_t)t * 256 + cc : p0a; const bf16_t* p0c = hiH ? YBP + (size_t)2 * T * 256 + (size_t)t * 256 + cc : p0a;
            const bf16_t* p1a = (hiH ? YD : YC) + (size_t)t * 256 + cc;
            v[k][0][0] = *(const u32x4*)p0a; v[k][0][1] = *(const u32x4*)p0b; v[k][0][2] = *(const u32x4*)p0c; v[k][1][0] = *(const u32x4*)p1a;
#pragma unroll
            for (int br = 0; br < 3; ++br) lw[k][br] = LB[(size_t)br * T * 4 + (size_t)t * 4 + hB]; }
#pragma unroll
        for (int k = 0; k < 2; ++k) {
            const int t = t0 + k * nw; const bool ok = t < T;
#pragma unroll
            for (int ps = 0; ps < 2; ++ps) {
                float x[8];
                if (ps == 0) { const float l0 = hiH ? lw[k][0] : 1.0f, l1 = hiH ? lw[k][1] : 0.0f, l2 = hiH ? lw[k][2] : 0.0f; const float inv = 1.0f / (l0 + l1 + l2);
#pragma unroll
                    for (int w2 = 0; w2 < 4; ++w2) { const unsigned a = v[k][0][0][w2], b2 = v[k][0][1][w2], c2 = v[k][0][2][w2];
                        x[2 * w2] = (l0 * __uint_as_float(a << 16) + l1 * __uint_as_float(b2 << 16) + l2 * __uint_as_float(c2 << 16)) * inv;
                        x[2 * w2 + 1] = (l0 * __uint_as_float(a & 0xffff0000u) + l1 * __uint_as_float(b2 & 0xffff0000u) + l2 * __uint_as_float(c2 & 0xffff0000u)) * inv; }
                } else {
#pragma unroll
                    for (int w2 = 0; w2 < 4; ++w2) { const unsigned a = v[k][1][0][w2]; x[2 * w2] = __uint_as_float(a << 16); x[2 * w2 + 1] = __uint_as_float(a & 0xffff0000u); } }
                float ss = 0.f;
#pragma unroll
                for (int e = 0; e < 8; ++e) ss += x[e] * x[e];
#pragma unroll
                for (int off = 1; off <= 16; off <<= 1) ss += __shfl_xor(ss, off);
                const float rs = (ps == 1 && hiH) ? 1.0f : rsqrtf(ss * (1.0f / 256.0f) + EPS);
#pragma unroll
                for (int e = 0; e < 8; ++e) x[e] = x[e] * rs * bt[ps][e];
                if (ok) store8(MIX + (size_t)t * 1024 + (ps * 64 + lane) * 8, x);
            } }
    }
}

struct SortRec { int tok; float wlo, whi, rs; };
__device__ __forceinline__ float reduce20(const float (&v)[20], int lane) {
    float a[16];
#pragma unroll
    for (int i = 0; i < 16; ++i) { const bool up = lane & 32; const float hi = i < 4 ? v[16 + i] : 0.f; const float send = up ? v[i] : hi; const float keep = up ? hi : v[i]; a[i] = keep + __shfl_xor(send, 32); }
#pragma unroll
    for (int i = 0; i < 8; ++i) { const bool up = lane & 16; const float send = up ? a[i] : a[8 + i]; const float keep = up ? a[8 + i] : a[i]; a[i] = keep + __shfl_xor(send, 16); }
#pragma unroll
    for (int i = 0; i < 4; ++i) { const bool up = lane & 8; const float send = up ? a[i] : a[4 + i]; const float keep = up ? a[4 + i] : a[i]; a[i] = keep + __shfl_xor(send, 8); }
#pragma unroll
    for (int i = 0; i < 2; ++i) { const bool up = lane & 4; const float send = up ? a[i] : a[2 + i]; const float keep = up ? a[2 + i] : a[i]; a[i] = keep + __shfl_xor(send, 4); }
    { const bool up = lane & 2; const float send = up ? a[0] : a[1]; const float keep = up ? a[1] : a[0]; a[0] = keep + __shfl_xor(send, 2); }
    return a[0] + __shfl_xor(a[0], 1);
}
__device__ __forceinline__ void route_decide(const float (&lg)[20], const float* bg, const float* be, int& bucket, float& wlo, float& whi) {
    float gl[4]; int gi = 0;
#pragma unroll
    for (int i = 0; i < 4; ++i) gl[i] = lg[i] + bg[i];
    float gm = gl[0];
#pragma unroll
    for (int i = 1; i < 4; ++i) if (gl[i] > gm) { gm = gl[i]; gi = i; }
    float gs = 0.f;
#pragma unroll
    for (int i = 0; i < 4; ++i) gs += expf(gl[i] - gm);
    const float gw = 1.0f / gs;
    float el[4];
#pragma unroll
    for (int i = 0; i < 4; ++i) { const float v0 = lg[4 + i] + be[i], v1 = lg[8 + i] + be[4 + i], v2 = lg[12 + i] + be[8 + i], v3 = lg[16 + i] + be[12 + i];
        el[i] = gi == 0 ? v0 : (gi == 1 ? v1 : (gi == 2 ? v2 : v3)); }
    int i0 = 0; float m0 = el[0];
#pragma unroll
    for (int i = 1; i < 4; ++i) if (el[i] > m0) { m0 = el[i]; i0 = i; }
    int i1 = -1; float m1 = -3.0e38f;
#pragma unroll
    for (int i = 0; i < 4; ++i) if (i != i0 && el[i] > m1) { m1 = el[i]; i1 = i; }
    const float r = expf(m1 - m0); const float w0 = gw / (1.0f + r), w1 = gw * r / (1.0f + r);
    const int a = i0 < i1 ? i0 : i1, bq = i0 < i1 ? i1 : i0; const int pidx = a == 0 ? bq - 1 : (a == 1 ? bq + 1 : 5);
    bucket = gi * 6 + pidx; wlo = i0 < i1 ? w0 : w1; whi = i0 < i1 ? w1 : w0;
}
__device__ __forceinline__ void ph_norm2_route(const Params& p, int layer, LAS float* wl, const bool dup = false) {
    const int tidx = opaque_tid(); const int bidx = opaque_s((int)blockIdx.x), gdim = opaque_s((int)gridDim.x);
    const int wid = __builtin_amdgcn_readfirstlane(tidx >> 6), lane = tidx & 63, tk = lane & 15, kg = lane >> 4;
    const float* g = p.norm2_g + layer * 1024;
    const float* wg = p.rg_w + (size_t)layer * 1024 * 4; const float* we = p.re_w + (size_t)layer * 1024 * 16;
    const float* bg = p.rg_b + layer * 4; const float* be = p.re_b + layer * 16;
    const bf16_t* xs = (const bf16_t*)(p.ws + OFF_HN);
    LAS unsigned char* lb = (LAS unsigned char*)wl;
    constexpr int RP = 1024 * 2 + 16, WL_OFF = 20 * RP, Z_OFF = 40 * RP, AUX_OFF = 96 * 1024;
    __syncthreads();
    { f32x4 wv4[2][5]; float gd[2];
#pragma unroll
      for (int k = 0; k < 2; ++k) { const int d = tidx + 512 * k; gd[k] = g[d]; wv4[k][0] = *(const f32x4*)(wg + d * 4);
#pragma unroll
          for (int q = 0; q < 4; ++q) wv4[k][1 + q] = *(const f32x4*)(we + d * 16 + 4 * q); }
#pragma unroll
      for (int k = 0; k < 2; ++k) { const int d = tidx + 512 * k;
#pragma unroll
          for (int q = 0; q < 5; ++q)
#pragma unroll
              for (int e = 0; e < 4; ++e) { const float w = wv4[k][q][e] * gd[k]; const bf16_t hi = f2bf(w); const bf16_t lo = f2bf(w - bf2f(hi));
                  *(LAS bf16_t*)(lb + (q * 4 + e) * RP + d * 2) = hi; *(LAS bf16_t*)(lb + WL_OFF + (q * 4 + e) * RP + d * 2) = lo; } }
      if (tidx < RP / 16) { unsigned z = 0u; asm volatile("" : "+v"(z)); *(LAS u32x4*)(lb + Z_OFF + tidx * 16) = (u32x4){z, z, z, z}; } }
    __syncthreads();
    const unsigned a0h = tk * RP + kg * 16, a0l = WL_OFF + a0h;
    const unsigned a1h = (tk < 4 ? (16 + tk) * RP : Z_OFF) + kg * 16, a1l = (tk < 4 ? WL_OFF + (16 + tk) * RP : Z_OFF) + kg * 16;
    LAS int* rq = (LAS int*)(lb + AUX_OFF + 256) + wid * (64 * 5);
    int* cnt = (int*)(p.ws + OFF_CNT) + layer * 32 + (dup ? 4096 : 0); SortRec* recs = (SortRec*)(p.ws + OFF_PERM);
    int it = 0;
    for (int grp = bidx; grp < T / 128; grp += gdim, it += 16) {
        const int t = grp * 128 + wid * 16 + tk;
        const bf16_t* xp = xs + (size_t)t * 1024 + 8 * kg;
        f32x4 acc0 = (f32x4){0.f, 0.f, 0.f, 0.f}, acc1 = acc0; float ss = 0.f;
#pragma unroll 1
        for (int c8 = 0; c8 < 4; ++c8) {
            bf16x8 bf[8];
#pragma unroll
            for (int i = 0; i < 8; ++i) bf[i] = *(const bf16x8*)(xp + 32 * (8 * c8 + i));
#pragma unroll
            for (int i = 0; i < 8; ++i) { const int so = (8 * c8 + i) * 64;
                const u32x4 raw = __builtin_bit_cast(u32x4, bf[i]);
#pragma unroll
                for (int w2 = 0; w2 < 4; ++w2) { const float lo = __uint_as_float(raw[w2] << 16), hi = __uint_as_float(raw[w2] & 0xffff0000u); ss += lo * lo + hi * hi; }
                const bf16x8 ah0 = *(const LAS bf16x8*)(lb + a0h + so), al0 = *(const LAS bf16x8*)(lb + a0l + so), ah1 = *(const LAS bf16x8*)(lb + a1h + so), al1 = *(const LAS bf16x8*)(lb + a1l + so);
                acc0 = __builtin_amdgcn_mfma_f32_16x16x32_bf16(ah0, bf[i], acc0, 0, 0, 0); acc0 = __builtin_amdgcn_mfma_f32_16x16x32_bf16(al0, bf[i], acc0, 0, 0, 0);
                acc1 = __builtin_amdgcn_mfma_f32_16x16x32_bf16(ah1, bf[i], acc1, 0, 0, 0); acc1 = __builtin_amdgcn_mfma_f32_16x16x32_bf16(al1, bf[i], acc1, 0, 0, 0); }
        }
        ss += __shfl_xor(ss, 16); ss += __shfl_xor(ss, 32);
        const float rs = rsqrtf(ss * (1.0f / 1024.0f) + EPS);
        float lg[20];
#pragma unroll
        for (int r4 = 0; r4 < 4; ++r4) {
#pragma unroll
            for (int q = 0; q < 4; ++q) lg[4 * q + r4] = __shfl(acc0[r4], tk + 16 * q) * rs;
            lg[16 + r4] = __shfl(acc1[r4], tk) * rs; }
        int bk_; float wlo, whi;
        route_decide(lg, bg, be, bk_, wlo, whi);
        if (kg == 0) { LAS int* r0 = rq + ((it + tk) & 63) * 5; r0[0] = bk_; r0[1] = t; r0[2] = __float_as_int(wlo); r0[3] = __float_as_int(whi); r0[4] = __float_as_int(rs); }
        if (((it + 16) & 63) == 0) {
            const LAS int* rr = rq + lane * 5; const int b2 = rr[0]; const int slot = atomicAdd(cnt + b2, 1);
            SortRec sr; sr.tok = rr[1]; sr.wlo = __int_as_float(rr[2]); sr.whi = __int_as_float(rr[3]); sr.rs = __int_as_float(rr[4]); recs[(size_t)b2 * T + slot] = sr; }
    }
    const int npend = it & 63;
    int my_bucket = -1, my_tok = 0; float my_wlo = 0.f, my_whi = 0.f, my_rs = 0.f;
    if (lane < npend) { const LAS int* rr = rq + lane * 5; my_bucket = rr[0]; my_tok = rr[1]; my_wlo = __int_as_float(rr[2]); my_whi = __int_as_float(rr[3]); my_rs = __int_as_float(rr[4]); }
    { LAS int* hist = (LAS int*)(lb + AUX_OFF); LAS int* base = hist + 32;
      if (tidx < 32) hist[tidx] = 0;
      __syncthreads();
      int rank = 0;
      if (my_bucket >= 0) rank = __hip_atomic_fetch_add(hist + my_bucket, 1, __ATOMIC_RELAXED, __HIP_MEMORY_SCOPE_WORKGROUP);
      __syncthreads();
      if (tidx < 24) { const int c = hist[tidx]; base[tidx] = c > 0 ? atomicAdd(cnt + tidx, c) : 0; }
      __syncthreads();
      if (my_bucket >= 0) { const int slot = base[my_bucket] + rank; SortRec sr; sr.tok = my_tok; sr.wlo = my_wlo; sr.whi = my_whi; sr.rs = my_rs; recs[(size_t)my_bucket * T + slot] = sr; } }
}

namespace g8 {
constexpr int BM = 256, BK = 64, HALF = 128, HTB = HALF * BK * 2, STAGE_BYTES = 8 * HTB, NXCD = 8, WGM = 8;
__device__ __forceinline__ int lds_byte(int r, int c) { const int st = (r >> 4) * 2 + (c >> 5), rr = r & 15, cc = c & 31, ob = rr * 64 + cc * 2; return st * 1024 + (ob ^ (((ob >> 9) & 1) << 5)); }
__device__ __forceinline__ void stage_rc(int b, int& R, int& C) { const int st = b / 1024, sb = b % 1024, swz = sb ^ (((sb >> 9) & 1) << 5); R = (st >> 1) * 16 + swz / 64; C = (st & 1) * 32 + (swz % 64) / 2; }
__device__ __forceinline__ int perm32(int rho) { const int n = rho >> 4, i = rho & 15; return 8 * (i >> 2) + 4 * n + (i & 3); }
__device__ __forceinline__ unsigned cvt_pk_bf16(float lo, float hi) { unsigned r; asm volatile("v_cvt_pk_bf16_f32 %0, %1, %2" : "=v"(r) : "v"(lo), "v"(hi)); return r; }

struct GUnit { const char* A; const char* B; const char* B2; int pm, pn, k, s0, cnt, ord; };

struct DenseOrder {
    const bf16_t* A; const bf16_t* Bt; int lda, ldb, nM, nN, nwg, G, c;
    __device__ void init(const bf16_t* A_, int lda_, const bf16_t* Bt_, int ldb_, int M, int N, int G_, int c_) { A = A_; Bt = Bt_; lda = lda_; ldb = ldb_; nM = M / BM; nN = N / BM; nwg = nM * nN; G = G_; c = c_; }
    __device__ bool next(int i, GUnit& u) const {
        const long L = (long)i * G + c; if (L >= nwg) return false;
        int wgid = (int)L; { const int q = nwg / NXCD, r = nwg % NXCD, xcd = wgid % NXCD, off = wgid / NXCD; wgid = (xcd < r ? xcd * (q + 1) : r * (q + 1) + (xcd - r) * q) + off; }
        const int nig = WGM * nN, gid = wgid / nig, fm = gid * WGM, gsz = (nM - fm) < WGM ? (nM - fm) : WGM;
        u.pm = fm + ((wgid % nig) % gsz); u.pn = (wgid % nig) / gsz;
        u.A = (const char*)(A + (size_t)u.pm * BM * lda); u.B = (const char*)(Bt + (size_t)u.pn * BM * ldb); u.B2 = u.B; u.k = 0; u.s0 = 0; u.cnt = 0; u.ord = i;
        return true;
    }
    __device__ __forceinline__ void aoff(const GUnit&, const int (&R)[2], const int (&C)[2], unsigned (&vo)[2][2]) const {
#pragma unroll
        for (int h = 0; h < 2; ++h)
#pragma unroll
            for (int i = 0; i < 2; ++i) vo[h][i] = (unsigned)((h * HALF + R[i]) * lda + C[i]) * 2u;
    }
};

struct EpiResidBf16 {
    static constexpr bool PERM = true;
    bf16_t* X; int ldc; float accscale;
    __device__ __forceinline__ void operator()(const f32x4 (&acc)[2][2][4][2], const GUnit& u, int wr, int wc, int fr, int fq) const {
        const int row0 = u.pm * BM + wr * 64 + fr, col0 = u.pn * BM + wc * 32 + 8 * fq;
#pragma unroll
        for (int ai = 0; ai < 2; ++ai) {
            u32x4 r[4][2];
#pragma unroll
            for (int m = 0; m < 4; ++m)
#pragma unroll
                for (int bj = 0; bj < 2; ++bj) r[m][bj] = *(const u32x4*)(X + (size_t)(row0 + ai * HALF + m * 16) * ldc + col0 + bj * HALF);
#pragma unroll
            for (int m = 0; m < 4; ++m)
#pragma unroll
                for (int bj = 0; bj < 2; ++bj) asm volatile("" : "+v"(r[m][bj]));
#pragma unroll
            for (int m = 0; m < 4; ++m) { bf16_t* xp = X + (size_t)(row0 + ai * HALF + m * 16) * ldc + col0;
#pragma unroll
                for (int bj = 0; bj < 2; ++bj) { const u32x4 rr = r[m][bj];
                    const f32x4 a0 = acc[ai][bj][m][0] * accscale, a1 = acc[ai][bj][m][1] * accscale;
                    u32x4 w;
                    w.x = cvt_pk_bf16(__uint_as_float(rr.x << 16) + a0[0], __uint_as_float(rr.x & 0xffff0000u) + a0[1]);
                    w.y = cvt_pk_bf16(__uint_as_float(rr.y << 16) + a0[2], __uint_as_float(rr.y & 0xffff0000u) + a0[3]);
                    w.z = cvt_pk_bf16(__uint_as_float(rr.z << 16) + a1[0], __uint_as_float(rr.z & 0xffff0000u) + a1[1]);
                    w.w = cvt_pk_bf16(__uint_as_float(rr.w << 16) + a1[2], __uint_as_float(rr.w & 0xffff0000u) + a1[3]);
                    *(u32x4*)(xp + bj * HALF) = w; } } }
    }
};
struct EpiInProj {
    static constexpr bool PERM = true;
    const LAS float* rstab; const LAS f32x2* cstab;
    float* ssq; float* sskv; bf16_t* AMLA; bf16_t* KR;
    bf16_t* qB; bf16_t* kB; bf16_t* vB; bf16_t* qC; bf16_t* kC; bf16_t* vC; bf16_t* qD; bf16_t* kD; bf16_t* vD;
    const float* g_dil; const float* g_gqa; const float* g_diff;
    __device__ __forceinline__ void operator()(const f32x4 (&acc)[2][2][4][2], const GUnit& u, int wr, int wc, int fr, int fq) const {
        const int pn = u.pn;
        int kind = 0, hh = wc, nh = 4; bf16_t* base = vB; const float* g = g_dil; float scale = 1.f;
        if (pn == 0) kind = 4; else if (pn == 1) kind = 5;
        else if (pn == 2) { kind = 1; base = qB; g = g_dil; scale = 0.125f * LOG2E; }
        else if (pn == 3) { kind = 1; base = kB; g = g_dil + 64; }
        else if (pn == 4) { kind = 0; base = vB; }
        else if (pn == 5) { kind = 2; base = qC; g = g_gqa; scale = 0.125f * LOG2E; }
        else if (pn == 6) { nh = 2; if (wc < 2) { kind = 2; base = kC; g = g_gqa + 64; } else { kind = 0; hh = wc - 2; base = vC; } }
        else if (pn == 7) { kind = 3; base = qD; g = g_diff; scale = 0.17677669529663687f * LOG2E; }
        else if (pn == 8) { kind = 3; base = kD; g = g_diff + 32; }
        else { kind = 0; base = vD; }
        float gn[2][8];
#pragma unroll
        for (int bj = 0; bj < 2; ++bj)
#pragma unroll
            for (int e = 0; e < 8; ++e) gn[bj][e] = kind == 1 ? g[32 * bj + 8 * fq + e] : (kind == 2 ? g[32 * bj + 16 * (e >> 2) + 4 * fq + (e & 3)] : (kind == 3 ? g[8 * fq + e] : 1.0f));
        const LAS float* rsp = rstab + u.ord * 256 + wr * 64 + fr;
#pragma unroll
        for (int ai = 0; ai < 2; ++ai)
#pragma unroll
            for (int m = 0; m < 4; ++m) {
                const int lrow = ai * HALF + wr * 64 + m * 16 + fr, row = u.pm * BM + lrow, b = row >> 11, sq = row & 2047;
                const float rs = rsp[ai * HALF + m * 16];
                float v[2][8];
#pragma unroll
                for (int bj = 0; bj < 2; ++bj)
#pragma unroll
                    for (int n = 0; n < 2; ++n)
#pragma unroll
                        for (int jj = 0; jj < 4; ++jj) v[bj][4 * n + jj] = acc[ai][bj][m][n][jj] * rs;
                float q0 = 0.f, q1 = 0.f;
#pragma unroll
                for (int e = 0; e < 8; ++e) { q0 += v[0][e] * v[0][e]; q1 += v[1][e] * v[1][e]; }
                q0 += __shfl_xor(q0, 16); q0 += __shfl_xor(q0, 32); q1 += __shfl_xor(q1, 16); q1 += __shfl_xor(q1, 32);
                if (kind == 4) {
                    store8(AMLA + (size_t)row * 384 + 32 * wc + 8 * fq, v[0]); store8(AMLA + (size_t)row * 384 + 128 + 32 * wc + 8 * fq, v[1]);
                    if (fq == 0) ssq[(size_t)row * 4 + wc] = q0 + q1;
                } else if (kind == 5) {
                    store8(AMLA + (size_t)row * 384 + 256 + 32 * wc + 8 * fq, v[0]);
                    if (fq == 0) sskv[(size_t)row * 4 + wc] = q0;
                    if (wc == 0) store8(KR + (size_t)row * 32 + 8 * fq, v[1]);
                } else {
                    bf16_t* dst = base + ((size_t)(b * nh + hh) * S + sq) * 64;
                    if (kind == 1) { const float r64 = rsqrtf((q0 + q1) * (1.0f / 64.0f) + EPS) * scale;
#pragma unroll
                        for (int bj = 0; bj < 2; ++bj)
#pragma unroll
                            for (int e = 0; e < 8; ++e) v[bj][e] *= r64 * gn[bj][e];
                    } else if (kind == 3) { const float r0 = rsqrtf(q0 * (1.0f / 32.0f) + EPS) * scale, r1 = rsqrtf(q1 * (1.0f / 32.0f) + EPS) * scale;
#pragma unroll
                        for (int e = 0; e < 8; ++e) { v[0][e] *= r0 * gn[0][e]; v[1][e] *= r1 * gn[1][e]; }
                    } else if (kind == 2) { const float r64 = rsqrtf((q0 + q1) * (1.0f / 64.0f) + EPS);
#pragma unroll
                        for (int bj = 0; bj < 2; ++bj) { const int pos = bj == 0 ? (sq >> 6) : (sq & 63);
#pragma unroll
                            for (int jj = 0; jj < 4; ++jj) { const f32x2 c = cstab[pos * 16 + 4 * fq + jj];
                                const float lo = v[bj][jj] * r64 * gn[bj][jj], hi = v[bj][4 + jj] * r64 * gn[bj][4 + jj];
                                v[bj][jj] = (lo * c[0] - hi * c[1]) * scale; v[bj][4 + jj] = (hi * c[0] + lo * c[1]) * scale; } }
                    }
                    store8(dst + 8 * fq, v[0]); store8(dst + 32 + 8 * fq, v[1]);
                }
            }
    }
};
template <class Epi, class Sched>
__device__ __forceinline__ void gemm_phase(LAS unsigned char* lds, const Sched& S, const Epi& E, const int K, const int ks, const int ldb) {
    const int tid = opaque_tid(), wid = __builtin_amdgcn_readfirstlane(tid >> 6), lane = tid & 63, wr = wid >> 2, wc = wid & 3, fr = lane & 15, fq = lane >> 4;
    const int nt = K / BK;
    int Rs[2], Cs[2]; unsigned voffB[2];
#pragma unroll
    for (int i = 0; i < 2; ++i) { int R, C; stage_rc(tid * 16 + i * 8192, R, C); Rs[i] = R; Cs[i] = C; const int Rb = Epi::PERM ? ((R & ~31) + perm32(R & 31)) : R; voffB[i] = (unsigned)(Rb * ldb + C) * 2u; }
    const size_t kstep = (size_t)(BK * 2);
    const size_t hstepB = (size_t)HALF * ldb * 2;
    const unsigned ldsw = (unsigned)wid * 1024u;
    const int aoff = lds_byte(wr * 64 + fr, fq * 8), boff = lds_byte(wc * 32 + fr, fq * 8);
#define G8_SA(b, h) (((b) * 2 + (h)) * HTB)
#define G8_SB(b, h) ((4 + (b) * 2 + (h)) * HTB)
#define G8_STAGEB(bufoff, gbase) do { _Pragma("unroll") for (int _i = 0; _i < 2; ++_i) \
        __builtin_amdgcn_global_load_lds((const unsigned*)((const char*)(gbase) + voffB[_i]), (LAS unsigned*)(lds + (bufoff) + ldsw + _i * 8192), 16, 0, 0); } while (0)
#define G8_STAGEA(bufoff, gbase, v0, v1) do { \
        __builtin_amdgcn_global_load_lds((const unsigned*)((const char*)(gbase) + (v0)), (LAS unsigned*)(lds + (bufoff) + ldsw), 16, 0, 0); \
        __builtin_amdgcn_global_load_lds((const unsigned*)((const char*)(gbase) + (v1)), (LAS unsigned*)(lds + (bufoff) + ldsw + 8192), 16, 0, 0); } while (0)
#define G8_LDA(dst, b, h) do { _Pragma("unroll") for (int m = 0; m < 4; ++m) _Pragma("unroll") for (int k = 0; k < 2; ++k) dst[m][k] = *(const LAS bf16x8*)(lds + G8_SA(b, h) + aoff + m * 2048 + k * 1024); } while (0)
#define G8_LDB(dst, b, h) do { _Pragma("unroll") for (int n = 0; n < 2; ++n) _Pragma("unroll") for (int k = 0; k < 2; ++k) dst[n][k] = *(const LAS bf16x8*)(lds + G8_SB(b, h) + boff + n * 2048 + k * 1024); } while (0)
#define G8_MMA(ai, bj, At, Bt) do { __builtin_amdgcn_s_setprio(1); _Pragma("unroll") for (int m = 0; m < 4; ++m) _Pragma("unroll") for (int n = 0; n < 2; ++n) _Pragma("unroll") for (int k = 0; k < 2; ++k) \
        acc[ai][bj][m][n] = __builtin_amdgcn_mfma_f32_16x16x32_bf16(Bt[n][k], At[m][k], acc[ai][bj][m][n], 0, 0, 0); __builtin_amdgcn_s_setprio(0); } while (0)
#define G8_WAIT_V(n) asm volatile("s_waitcnt vmcnt(" #n ")" ::: "memory")
#define G8_WAIT_L(n) asm volatile("s_waitcnt lgkmcnt(" #n ")" ::: "memory")
#define G8_BAR __builtin_amdgcn_s_barrier()
#define G8_SCHED __builtin_amdgcn_sched_barrier(0)
#define G8_BK(u, t) ((t) < ks ? (u).B + (size_t)(t) * kstep : (u).B2 + (size_t)((t) - ks) * kstep)
    GUnit cur, nxt; int ui = 0;
    if (!S.next(0, cur)) return;
    f32x4 acc[2][2][4][2];
#pragma unroll
    for (int a = 0; a < 2; ++a)
#pragma unroll
        for (int b = 0; b < 2; ++b)
#pragma unroll
            for (int m = 0; m < 4; ++m)
#pragma unroll
                for (int n = 0; n < 2; ++n) acc[a][b][m][n] = (f32x4){0.f, 0.f, 0.f, 0.f};
    bf16x8 At[4][2], B0[2][2], B1[2][2];
    unsigned ca[2][2], na[2][2];
    S.aoff(cur, Rs, Cs, ca);
    { const char* b0 = G8_BK(cur, 0); const char* b1 = G8_BK(cur, 1);
      G8_STAGEB(G8_SB(0, 0), b0); G8_STAGEA(G8_SA(0, 0), cur.A, ca[0][0], ca[0][1]); G8_STAGEB(G8_SB(0, 1), b0 + hstepB); G8_STAGEA(G8_SA(0, 1), cur.A, ca[1][0], ca[1][1]);
      if (wr == 1) G8_BAR;
      G8_WAIT_V(4); G8_BAR;
      G8_STAGEB(G8_SB(1, 0), b1); G8_STAGEA(G8_SA(1, 0), cur.A + kstep, ca[0][0], ca[0][1]); G8_STAGEB(G8_SB(1, 1), b1 + hstepB);
      G8_WAIT_V(6); G8_BAR; }
    for (;;) {
        const bool has_next = S.next(ui + 1, nxt);
        if (has_next) S.aoff(nxt, Rs, Cs, na);
        else {
#pragma unroll
            for (int h = 0; h < 2; ++h)
#pragma unroll
                for (int i = 0; i < 2; ++i) na[h][i] = ca[h][i];
            nxt = cur; }
#pragma unroll 1
        for (int t = 0; t < nt; t += 2) {
            const bool last = (t == nt - 2);
            const char* a1 = cur.A + (size_t)(t + 1) * kstep;
            const char* a2 = last ? nxt.A : cur.A + (size_t)(t + 2) * kstep;
            const char* a3 = a2 + kstep;
            const char* b2 = last ? G8_BK(nxt, 0) : G8_BK(cur, t + 2);
            const char* b3 = last ? G8_BK(nxt, 1) : G8_BK(cur, t + 3);
            const unsigned x00 = last ? na[0][0] : ca[0][0], x01 = last ? na[0][1] : ca[0][1], x10 = last ? na[1][0] : ca[1][0], x11 = last ? na[1][1] : ca[1][1];
            G8_LDB(B0, 0, 0); G8_SCHED; G8_LDA(At, 0, 0); G8_STAGEA(G8_SA(1, 1), a1, ca[1][0], ca[1][1]);
            G8_WAIT_L(8); G8_BAR; G8_WAIT_L(0); G8_MMA(0, 0, At, B0); G8_BAR; G8_SCHED;
            G8_LDB(B1, 0, 1); G8_STAGEB(G8_SB(0, 0), b2);
            G8_BAR; G8_WAIT_L(0); G8_MMA(0, 1, At, B1); G8_BAR;
            G8_LDA(At, 0, 1); G8_STAGEA(G8_SA(0, 0), a2, x00, x01);
            G8_BAR; G8_WAIT_L(0); G8_MMA(1, 0, At, B0); G8_BAR; G8_SCHED;
            G8_STAGEB(G8_SB(0, 1), b2 + hstepB);
            G8_WAIT_V(6); G8_BAR; G8_MMA(1, 1, At, B1); G8_BAR;
            G8_LDB(B0, 1, 0); G8_SCHED; G8_LDA(At, 1, 0); G8_STAGEA(G8_SA(0, 1), a2, x10, x11);
            G8_WAIT_L(8); G8_BAR; G8_WAIT_L(0); G8_MMA(0, 0, At, B0); G8_BAR; G8_SCHED;
            G8_LDB(B1, 1, 1); G8_STAGEB(G8_SB(1, 0), b3);
            G8_BAR; G8_WAIT_L(0); G8_MMA(0, 1, At, B1); G8_BAR;
            G8_LDA(At, 1, 1); G8_STAGEA(G8_SA(1, 0), a3, x00, x01);
            G8_BAR; G8_WAIT_L(0); G8_MMA(1, 0, At, B0); G8_BAR; G8_SCHED;
            G8_STAGEB(G8_SB(1, 1), b3 + hstepB);
            G8_WAIT_V(6); G8_BAR; G8_MMA(1, 1, At, B1); G8_BAR;
        }
        E(acc, cur, wr, wc, fr, fq);
        if (!has_next) break;
#pragma unroll
        for (int a = 0; a < 2; ++a)
#pragma unroll
            for (int b = 0; b < 2; ++b)
#pragma unroll
                for (int m = 0; m < 4; ++m)
#pragma unroll
                    for (int n = 0; n < 2; ++n) acc[a][b][m][n] = (f32x4){0.f, 0.f, 0.f, 0.f};
        cur = nxt; ++ui;
#pragma unroll
        for (int h = 0; h < 2; ++h)
#pragma unroll
            for (int i = 0; i < 2; ++i) ca[h][i] = na[h][i];
    }
    G8_WAIT_V(0);
    if (wr == 0) G8_BAR;
    G8_BAR;
#undef G8_SA
#undef G8_SB
#undef G8_STAGEA
#undef G8_STAGEB
#undef G8_LDA
#undef G8_LDB
#undef G8_MMA
#undef G8_WAIT_V
#undef G8_WAIT_L
#undef G8_BAR
#undef G8_SCHED
#undef G8_BK
}

template <int MODE> struct MoeOrder {
    static constexpr int NPN = MODE == 1 ? 8 : 4;
    const LAS int* tab; const SortRec* recs; const bf16_t* A; const bf16_t* W; int G, c, layer;
    __device__ bool next(int i, GUnit& u) const {
        const int MT = __builtin_amdgcn_readfirstlane(tab[24]);
        int rt, pn;
        if ((G & 7) == 0) { const int x = c & 7, j = c >> 3, Gx = G >> 3, rt0 = (x * MT) >> 3, rt1 = ((x + 1) * MT) >> 3, q = i * Gx + j;
            rt = rt0 + q / NPN; pn = q % NPN; if (rt >= rt1) return false; }
        else { const int L = i * G + c; rt = L / NPN; pn = L % NPN; if (rt >= MT) return false; }
        int k = 0;
        for (int j = 1; j < 24; ++j) if (rt >= tab[j]) k = j;
        k = __builtin_amdgcn_readfirstlane(k);
        const int g = k / 6, pi = k % 6;
        const int a = pi < 3 ? 0 : (pi < 5 ? 1 : 2), b = pi < 3 ? pi + 1 : (pi < 5 ? pi - 1 : 3);
        const int lo = g * 4 + a, hi = g * 4 + b;
        u.ord = i; u.pm = rt; u.pn = pn; u.k = k; u.s0 = (rt - __builtin_amdgcn_readfirstlane(tab[k])) * BM; u.cnt = __builtin_amdgcn_readfirstlane(tab[32 + k]);
        if (MODE == 1) { u.A = (const char*)A; u.B = (const char*)(W + ((size_t)((layer * 16 + (pn < 4 ? lo : hi)) * 4 + (pn & 3))) * 256 * 1024); u.B2 = u.B; }
        else { u.A = (const char*)(A + (size_t)rt * BM * 1024); u.B = (const char*)(W + ((size_t)(layer * 16 + lo) * 1024 + pn * 256) * 512); u.B2 = (const char*)(W + ((size_t)(layer * 16 + hi) * 1024 + pn * 256) * 512); }
        return true;
    }
    __device__ __forceinline__ void aoff(const GUnit& u, const int (&R)[2], const int (&C)[2], unsigned (&vo)[2][2]) const {
#pragma unroll
        for (int h = 0; h < 2; ++h)
#pragma unroll
            for (int i = 0; i < 2; ++i) {
                if (MODE == 1) { const int slot = u.s0 + h * HALF + R[i]; int tok = recs[(size_t)u.k * T + slot].tok; tok = slot < u.cnt ? tok : 0; vo[h][i] = (unsigned)(tok * 1024 + C[i]) * 2u; }
                else vo[h][i] = (unsigned)((h * HALF + R[i]) * 1024 + C[i]) * 2u; }
    }
};
struct EpiGateUp {
    static constexpr bool PERM = true;
    bf16_t* HID; const SortRec* recs;
    __device__ __forceinline__ void operator()(const f32x4 (&acc)[2][2][4][2], const GUnit& u, int wr, int wc, int fr, int fq) const {
        const SortRec* rb = recs + (size_t)u.k * T;
        float wq[2][4], rsq[2][4];
#pragma unroll
        for (int ai = 0; ai < 2; ++ai)
#pragma unroll
            for (int m = 0; m < 4; ++m) { const float* rp = (const float*)(rb + (u.s0 + ai * HALF + wr * 64 + m * 16 + fr)); wq[ai][m] = rp[u.pn < 4 ? 1 : 2]; rsq[ai][m] = rp[3]; }
#pragma unroll
        for (int ai = 0; ai < 2; ++ai)
#pragma unroll
            for (int m = 0; m < 4; ++m) asm volatile("" : "+v"(wq[ai][m]), "+v"(rsq[ai][m]));
#pragma unroll
        for (int ai = 0; ai < 2; ++ai) {
#pragma unroll
            for (int m = 0; m < 4; ++m) { const int row = ai * HALF + wr * 64 + m * 16 + fr, slot = u.s0 + row;
                const float msk = slot < u.cnt ? 1.0f : 0.0f;
                const float w = wq[ai][m] * msk, rs = rsq[ai][m] * msk;
                float v[8];
#pragma unroll
                for (int n = 0; n < 2; ++n)
#pragma unroll
                    for (int j = 0; j < 4; ++j) { const float g = acc[ai][0][m][n][j] * rs, up = acc[ai][1][m][n][j] * rs;
                        v[n * 4 + j] = g * __builtin_amdgcn_rcpf(1.0f + __expf(-g)) * up * w; }
                u32x4 o; o.x = cvt_pk_bf16(v[0], v[1]); o.y = cvt_pk_bf16(v[2], v[3]); o.z = cvt_pk_bf16(v[4], v[5]); o.w = cvt_pk_bf16(v[6], v[7]);
                *(u32x4*)(HID + (size_t)(u.pm * BM + row) * 1024 + u.pn * 128 + wc * 32 + 8 * fq) = o; } }
    }
};
struct EpiScatterAdd {
    static constexpr bool PERM = true;
    bf16_t* xs; float* out; const SortRec* recs; bf16_t* dummy; float* ssx; int emit; float accscale;
    __device__ __forceinline__ void operator()(const f32x4 (&acc)[2][2][4][2], const GUnit& u, int wr, int wc, int fr, int fq) const {
        const int col0 = u.pn * BM + wc * 32 + 8 * fq;
        int tk[2][4];
#pragma unroll
        for (int ai = 0; ai < 2; ++ai)
#pragma unroll
            for (int m = 0; m < 4; ++m) tk[ai][m] = recs[(size_t)u.k * T + (u.s0 + ai * HALF + wr * 64 + m * 16 + fr)].tok;
#pragma unroll
        for (int ai = 0; ai < 2; ++ai)
#pragma unroll
            for (int m = 0; m < 4; ++m) asm volatile("" : "+v"(tk[ai][m]));
#pragma unroll
        for (int ai = 0; ai < 2; ++ai) {
            u32x4 rr8[4][2];
#pragma unroll
            for (int m = 0; m < 4; ++m) { const int slot = u.s0 + ai * HALF + wr * 64 + m * 16 + fr; const bf16_t* xp = (slot < u.cnt ? xs + (size_t)tk[ai][m] * 1024 : dummy) + col0;
#pragma unroll
                for (int bj = 0; bj < 2; ++bj) rr8[m][bj] = *(const u32x4*)(xp + bj * HALF); }
#pragma unroll
            for (int m = 0; m < 4; ++m)
#pragma unroll
                for (int bj = 0; bj < 2; ++bj) asm volatile("" : "+v"(rr8[m][bj]));
#pragma unroll
            for (int m = 0; m < 4; ++m) { const int row = ai * HALF + wr * 64 + m * 16 + fr, slot = u.s0 + row; const bool real = slot < u.cnt;
                bf16_t* xp = (real ? xs + (size_t)tk[ai][m] * 1024 : dummy) + col0;
                float ss = 0.f;
#pragma unroll
                for (int bj = 0; bj < 2; ++bj) { const u32x4 r = rr8[m][bj];
                    const f32x4 a0 = acc[ai][bj][m][0] * accscale, a1 = acc[ai][bj][m][1] * accscale;
                    const f32x4 x0 = (f32x4){__uint_as_float(r.x << 16) + a0[0], __uint_as_float(r.x & 0xffff0000u) + a0[1], __uint_as_float(r.y << 16) + a0[2], __uint_as_float(r.y & 0xffff0000u) + a0[3]};
                    const f32x4 x1 = (f32x4){__uint_as_float(r.z << 16) + a1[0], __uint_as_float(r.z & 0xffff0000u) + a1[1], __uint_as_float(r.w << 16) + a1[2], __uint_as_float(r.w & 0xffff0000u) + a1[3]};
                    if (emit) {
                        u32x4 w; w.x = cvt_pk_bf16(x0[0], x0[1]); w.y = cvt_pk_bf16(x0[2], x0[3]); w.z = cvt_pk_bf16(x1[0], x1[1]); w.w = cvt_pk_bf16(x1[2], x1[3]);
                        *(u32x4*)(xp + bj * HALF) = w;
                        const float b0 = __uint_as_float(w.x << 16), b1 = __uint_as_float(w.x & 0xffff0000u), b2 = __uint_as_float(w.y << 16), b3 = __uint_as_float(w.y & 0xffff0000u);
                        const float b4 = __uint_as_float(w.z << 16), b5 = __uint_as_float(w.z & 0xffff0000u), b6 = __uint_as_float(w.w << 16), b7 = __uint_as_float(w.w & 0xffff0000u);
                        ss += ((b0 * b0 + b1 * b1) + (b2 * b2 + b3 * b3)) + ((b4 * b4 + b5 * b5) + (b6 * b6 + b7 * b7));
                    } else if (real) { float* o = out + (size_t)tk[ai][m] * 1024 + col0 + bj * HALF; *(f32x4*)o = x0; *(f32x4*)(o + 4) = x1; } }
                if (emit) { ss += __shfl_xor(ss, 16); ss += __shfl_xor(ss, 32); if (real && fq == 0) ssx[(size_t)tk[ai][m] * 16 + u.pn * 4 + wc] = ss; } } }
    }
};
__device__ __forceinline__ void moe_build_tab(LAS int* tab, const int* cnt) {
    const int tidx = opaque_tid(); const int bidx = opaque_s((int)blockIdx.x), gdim = opaque_s((int)gridDim.x); (void)bidx; (void)gdim;
    if (tidx < 24) tab[32 + tidx] = __hip_atomic_load(cnt + tidx, __ATOMIC_RELAXED, __HIP_MEMORY_SCOPE_AGENT);
    __syncthreads();
    if (tidx == 0) { int acc = 0; for (int k = 0; k < 24; ++k) { tab[k] = acc; acc += (tab[32 + k] + BM - 1) / BM; } tab[24] = acc; }
    __syncthreads();
}
}

namespace at {
typedef __bf16 bf16x8b __attribute__((ext_vector_type(8)));
typedef float f32x8 __attribute__((ext_vector_type(8)));
typedef short s16x4 __attribute__((ext_vector_type(4)));
constexpr int VROWB = 192;
template <int DQK> struct Geo { static constexpr int KROWB = DQK * 2 + 16, KTB = 64 * KROWB, VTB = 64 * VROWB, BUF = KTB + VTB; };
constexpr int BIAS_OFF = 3 * (64 * (96 * 2 + 16) + 64 * VROWB);
constexpr int LDS_BYTES = BIAS_OFF + 4096 * 4;

struct Args { const bf16_t* Q; const bf16_t* K; const bf16_t* V; bf16_t* Y; const float* bias; const float* lamvec; const float* subln_g; const float* gq; const float* gk; const float* relb; int HQ, HKV, ng; float lam_init; };

__device__ __forceinline__ bf16x8 pack8(const f32x16& p, int s2) {
    f32x8 v;
    if (s2 == 0) v = __builtin_shufflevector(p, p, 0, 1, 2, 3, 4, 5, 6, 7); else v = __builtin_shufflevector(p, p, 8, 9, 10, 11, 12, 13, 14, 15);
    return __builtin_bit_cast(bf16x8, __builtin_convertvector(v, bf16x8b));
}
__device__ __forceinline__ bf16x8 tr_pair(const LAS unsigned char* p) {
    const s16x4 lo = __builtin_amdgcn_ds_read_tr16_b64_v4i16((LAS s16x4*)p);
    const s16x4 hi = __builtin_amdgcn_ds_read_tr16_b64_v4i16((LAS s16x4*)(p + 8 * VROWB));
    return __builtin_shufflevector(lo, hi, 0, 1, 2, 3, 4, 5, 6, 7);
}

template <int KIND>
__device__ __forceinline__ void attn_unit(LAS unsigned char* lds, const Args& a, const int b, const int h, const int qblk) {
    constexpr int DQK = KIND == 0 ? 96 : 64, NS = DQK / 16, CPR = DQK / 8;
    typedef Geo<DQK> G;
    const int tid = opaque_tid(), wid = __builtin_amdgcn_readfirstlane(tid >> 6), lane = tid & 63, r = lane & 31, hh = lane >> 5;
    const int hk = h / (a.HQ / a.HKV);
    const int q0w = qblk * 256 + wid * 32;
    const bf16_t* Kg = a.K + (size_t)(b * a.HKV + hk) * S * DQK;
    const bf16_t* Vg = a.V + (size_t)(b * a.HKV + hk) * S * 64;
    bf16x8 qf[NS];
    { const bf16_t* qp = a.Q + ((size_t)(b * a.HQ + h) * S + q0w + r) * DQK + 8 * hh;
#pragma unroll
      for (int s = 0; s < NS; ++s) qf[s] = *(const bf16x8*)(qp + 16 * s); }
    const int kkey0 = tid / CPR, kcc0 = tid % CPR, kkey1 = (tid + 512) / CPR, kcc1 = (tid + 512) % CPR;
    const bool k2 = (CPR == 12) && (tid < 256);
    const int vkey = tid >> 3, vcc = tid & 7;
    const unsigned kl0 = kkey0 * G::KROWB + kcc0 * 16, kl1 = kkey1 * G::KROWB + kcc1 * 16, vl = G::KTB + vkey * VROWB + vcc * 16;
    const bf16_t* kg0 = Kg + (size_t)kkey0 * DQK + kcc0 * 8; const bf16_t* kg1 = Kg + (size_t)kkey1 * DQK + kcc1 * 8; const bf16_t* vg = Vg + (size_t)vkey * 64 + vcc * 8;
    const unsigned ka = r * G::KROWB + hh * 16;
    const unsigned va = G::KTB + (4 * hh + ((lane & 15) >> 2)) * VROWB + (16 * ((lane >> 4) & 1) + 4 * (lane & 3)) * 2;
    LAS float* bl = (LAS float*)(lds + BIAS_OFF);
    float shift;
    { float mq = 0.f, mk = 0.f;
      for (int i = lane; i < a.ng; i += 64) { mq = fmaxf(mq, fabsf(a.gq[i])); mk = fmaxf(mk, fabsf(a.gk[i])); }
      float bm = (KIND == 2 && lane < 32) ? a.relb[lane * 8 + 4 + h] * LOG2E : 0.f;
#pragma unroll
      for (int o = 32; o >= 1; o >>= 1) { mq = fmaxf(mq, __shfl_xor(mq, o)); mk = fmaxf(mk, __shfl_xor(mk, o)); bm = fmaxf(bm, __shfl_xor(bm, o)); }
      shift = mq * mk * sqrtf((float)a.ng) * LOG2E * 1.02f + bm; }
    const float ninit = -shift;
    __syncthreads();
    if (KIND == 2) {
#pragma unroll
        for (int i = 0; i < 8; ++i) bl[tid + 512 * i] = a.bias[(size_t)h * 4096 + tid + 512 * i] - shift;
    }
    u32x4 t0, t1 = (u32x4){0u, 0u, 0u, 0u}, t2;
    { t0 = *(const u32x4*)kg0; if (k2) t1 = *(const u32x4*)kg1; t2 = *(const u32x4*)vg;
      *(LAS u32x4*)(lds + kl0) = t0; if (k2) *(LAS u32x4*)(lds + kl1) = t1; *(LAS u32x4*)(lds + vl) = t2; }
    constexpr int NT = S / 64;
    { const size_t go = 64; t0 = *(const u32x4*)(kg0 + go * DQK); if (k2) t1 = *(const u32x4*)(kg1 + go * DQK); t2 = *(const u32x4*)(vg + go * 64); }
    __syncthreads();
    f32x16 o0[2], o1[2]; float l0[4] = {0.f, 0.f, 0.f, 0.f}, l1[4] = {0.f, 0.f, 0.f, 0.f};
#pragma unroll
    for (int m = 0; m < 2; ++m)
#pragma unroll
        for (int i = 0; i < 16; ++i) { o0[m][i] = 0.f; o1[m][i] = 0.f; }
    bf16x8 kfr[NS], vfr[2][2];
    f32x16 sa0, sb0, sa1, sb1;
    auto ld_frags = [&](const bool has_next, const LAS unsigned char* kb, const int key0, f32x16& sa, f32x16& sb, const LAS unsigned char* vb) __attribute__((always_inline)) {
        if (has_next) {
#pragma unroll
            for (int s = 0; s < NS; ++s) kfr[s] = *(const LAS bf16x8*)(kb + ka + s * 32);
            if (KIND == 2) { const LAS float* bp = bl + ((key0 + 4 * hh) - (q0w + r) + 2048);
#pragma unroll
                for (int i = 0; i < 16; ++i) { const float bv = bp[(i & 3) + 8 * (i >> 2)]; sa[i] = bv; sb[i] = bv; } }
        }
#pragma unroll
        for (int s2 = 0; s2 < 2; ++s2)
#pragma unroll
            for (int m = 0; m < 2; ++m) vfr[s2][m] = tr_pair(vb + va + s2 * 16 * VROWB + m * 64);
    };
    auto qk_mma = [&](f32x16& sa, f32x16& sb) __attribute__((always_inline)) {
        if (KIND != 2) {
#pragma unroll
            for (int i = 0; i < 16; ++i) sa[i] = ninit; }
#pragma unroll
        for (int s = 0; s < NS; ++s) {
            if (KIND == 2 && s >= 2) sb = __builtin_amdgcn_mfma_f32_32x32x16_bf16(kfr[s], qf[s], sb, 0, 0, 0);
            else sa = __builtin_amdgcn_mfma_f32_32x32x16_bf16(kfr[s], qf[s], sa, 0, 0, 0);
        }
    };
    bf16x8 pa[2], pb[2];
    auto smx = [&](f32x16& sa, f32x16& sb) __attribute__((always_inline)) {
#pragma unroll
        for (int i = 0; i < 16; ++i) { sa[i] = __builtin_amdgcn_exp2f(sa[i]); l0[i & 3] += sa[i]; asm volatile("" : "+v"(l0[i & 3])); }
        pa[0] = pack8(sa, 0); pa[1] = pack8(sa, 1);
        if (KIND == 2) {
#pragma unroll
            for (int i = 0; i < 16; ++i) { sb[i] = __builtin_amdgcn_exp2f(sb[i]); l1[i & 3] += sb[i]; asm volatile("" : "+v"(l1[i & 3])); }
            pb[0] = pack8(sb, 0); pb[1] = pack8(sb, 1); }
    };
    auto pv_mma = [&]() __attribute__((always_inline)) {
#pragma unroll
        for (int s2 = 0; s2 < 2; ++s2)
#pragma unroll
            for (int m = 0; m < 2; ++m) {
                o0[m] = __builtin_amdgcn_mfma_f32_32x32x16_bf16(vfr[s2][m], pa[s2], o0[m], 0, 0, 0);
                if (KIND == 2) o1[m] = __builtin_amdgcn_mfma_f32_32x32x16_bf16(vfr[s2][m], pb[s2], o1[m], 0, 0, 0);
            }
    };
    {
#pragma unroll
      for (int s = 0; s < NS; ++s) kfr[s] = *(const LAS bf16x8*)(lds + ka + s * 32);
      if (KIND == 2) { const LAS float* bp = bl + ((4 * hh) - (q0w + r) + 2048);
#pragma unroll
          for (int i = 0; i < 16; ++i) { const float bv = bp[(i & 3) + 8 * (i >> 2)]; sa0[i] = bv; sb0[i] = bv; } }
      qk_mma(sa0, sb0); }
    unsigned cbo = 0, nbo = G::BUF;
    const bool stag = wid >= 4;
    auto tile_seam = [&](const int kt, LAS unsigned char* nb) __attribute__((always_inline)) {
        if (kt + 1 < NT) { *(LAS u32x4*)(nb + kl0) = t0; if (k2) *(LAS u32x4*)(nb + kl1) = t1; *(LAS u32x4*)(nb + vl) = t2; }
        __syncthreads();
        if (kt + 2 < NT) { const size_t go = (size_t)(kt + 2) * 64; t0 = *(const u32x4*)(kg0 + go * DQK); if (k2) t1 = *(const u32x4*)(kg1 + go * DQK); t2 = *(const u32x4*)(vg + go * 64); }
    };
    auto fine_block = [&](f32x16& sc, f32x16& sbc, f32x16& sn, f32x16& sbn) __attribute__((always_inline)) {
        qk_mma(sn, sbn);
        smx(sc, sbc);
        pv_mma();
#define SGB_MT(n) do { __builtin_amdgcn_sched_group_barrier(0x008, 1, 0); __builtin_amdgcn_sched_group_barrier(0x400, n, 0); } while (0)
#define SGB_MV(n) do { __builtin_amdgcn_sched_group_barrier(0x008, 1, 0); __builtin_amdgcn_sched_group_barrier(0x002, n, 0); } while (0)
        if constexpr (NS == 4) { SGB_MT(4); SGB_MT(4); SGB_MT(4); SGB_MT(4); }
        else { SGB_MT(3); SGB_MT(3); SGB_MT(3); SGB_MT(3); SGB_MT(2); SGB_MT(2); }
        __builtin_amdgcn_sched_group_barrier(0x002, 6, 0);
        SGB_MV(5); SGB_MV(5); SGB_MV(5); SGB_MV(3);
#undef SGB_MT
#undef SGB_MV
    };
#pragma unroll 1
    for (int kt = 0; kt < NT; ++kt) {
        const LAS unsigned char* cb = lds + cbo; LAS unsigned char* nb = lds + nbo;
        const bool more = kt + 1 < NT;
        if constexpr (KIND != 2) {
            ld_frags(true, cb + 32 * G::KROWB, kt * 64 + 32, sa1, sb1, cb);
            __builtin_amdgcn_sched_barrier(0);
            fine_block(sa0, sb0, sa1, sb1);
            __builtin_amdgcn_sched_barrier(0);
            tile_seam(kt, nb);
            __builtin_amdgcn_sched_barrier(0);
            ld_frags(true, more ? (const LAS unsigned char*)nb : cb, (more ? kt + 1 : kt) * 64, sa0, sb0, cb + 32 * VROWB);
            __builtin_amdgcn_sched_barrier(0);
            fine_block(sa1, sb1, sa0, sb0);
            __builtin_amdgcn_sched_barrier(0);
        } else {
        ld_frags(true, cb + 32 * G::KROWB, kt * 64 + 32, sa1, sb1, cb);
        __builtin_amdgcn_sched_barrier(0);
        smx(sa0, sb0);
        __builtin_amdgcn_sched_barrier(0);
        if (stag) tile_seam(kt, nb);
        __builtin_amdgcn_sched_barrier(0);
        qk_mma(sa1, sb1); pv_mma();
        __builtin_amdgcn_sched_barrier(0);
        if (!stag) tile_seam(kt, nb);
        __builtin_amdgcn_sched_barrier(0);
        ld_frags(true, more ? (const LAS unsigned char*)nb : cb, (more ? kt + 1 : kt) * 64, sa0, sb0, cb + 32 * VROWB);
        __builtin_amdgcn_sched_barrier(0);
        smx(sa1, sb1);
        __builtin_amdgcn_sched_barrier(0);
        qk_mma(sa0, sb0); pv_mma();
        __builtin_amdgcn_sched_barrier(0);
        }
        cbo = nbo; nbo = nbo + G::BUF; if (nbo >= 3 * G::BUF) nbo = 0;
    }
    float lt0 = (l0[0] + l0[1]) + (l0[2] + l0[3]); lt0 += __shfl_xor(lt0, 32);
    bf16_t* yp = a.Y + (size_t)(b * S + q0w + r) * 256 + h * 64 + 4 * hh;
    if (KIND != 2) {
        const float inv = 1.0f / lt0;
#pragma unroll
        for (int m = 0; m < 2; ++m)
#pragma unroll
            for (int g4 = 0; g4 < 4; ++g4) { uint2 w; w.x = pack2(o0[m][4 * g4] * inv, o0[m][4 * g4 + 1] * inv); w.y = pack2(o0[m][4 * g4 + 2] * inv, o0[m][4 * g4 + 3] * inv);
                *(uint2*)(yp + 32 * m + 8 * g4) = w; }
    } else {
        float lt1 = (l1[0] + l1[1]) + (l1[2] + l1[3]); lt1 += __shfl_xor(lt1, 32);
        float d01 = 0.f, d23 = 0.f;
#pragma unroll
        for (int e = 0; e < 32; ++e) { d01 += a.lamvec[e] * a.lamvec[32 + e]; d23 += a.lamvec[64 + e] * a.lamvec[96 + e]; }
        const float lam = expf(d01) - expf(d23) + a.lam_init;
        const float i0 = 1.0f / lt0, i1 = lam / lt1; float ss = 0.f;
#pragma unroll
        for (int m = 0; m < 2; ++m)
#pragma unroll
            for (int i = 0; i < 16; ++i) { const float v = o0[m][i] * i0 - o1[m][i] * i1; o0[m][i] = v; ss += v * v; }
        ss += __shfl_xor(ss, 32);
        const float rs = rsqrtf(ss * (1.0f / 64.0f) + EPS) * (1.0f - a.lam_init);
#pragma unroll
        for (int m = 0; m < 2; ++m)
#pragma unroll
            for (int g4 = 0; g4 < 4; ++g4) { const float4 gg = *(const float4*)(a.subln_g + 32 * m + 8 * g4 + 4 * hh);
                uint2 w; w.x = pack2(o0[m][4 * g4] * rs * gg.x, o0[m][4 * g4 + 1] * rs * gg.y); w.y = pack2(o0[m][4 * g4 + 2] * rs * gg.z, o0[m][4 * g4 + 3] * rs * gg.w);
                *(uint2*)(yp + 32 * m + 8 * g4) = w; }
    }
}
}


namespace at {
struct DilArgs { const bf16_t* Q; const bf16_t* K; const bf16_t* V; bf16_t* YBP; float* LB; const float* bias; const float* gq; const float* gk; const float* relb; };
constexpr int DKROWB = 144, DK_BYTES = 384 * DKROWB, DV_OFF = DK_BYTES, DBT_OFF = DK_BYTES + 384 * VROWB;
static_assert(DBT_OFF + 1024 <= 128 * 1024 + 1024, "dilated LDS layout");
struct DilStage { u32x4 kv[6], vv[6]; };
__device__ __forceinline__ void dil_fetch(DilStage& st, const DilArgs& a, const int tid, const int b, const int h, const int br, const int ublk) {
    const int lgd = br * 2, nsub = S >> lgd, bh = b * 4 + h, pbase = 256 * ublk - 64;
#pragma unroll
    for (int i = 0; i < 6; ++i) { const int c = tid + 512 * i, row = c >> 3, cc = c & 7; int pk = pbase + row; pk = pk < 0 ? 0 : (pk >= S ? S - 1 : pk);
        const int rho = pk >> (11 - lgd), lk = pk & (nsub - 1), t = (lk << lgd) + rho;
        st.kv[i] = *(const u32x4*)(a.K + ((size_t)bh * S + t) * 64 + cc * 8); st.vv[i] = *(const u32x4*)(a.V + ((size_t)bh * S + t) * 64 + cc * 8); }
}
__device__ __forceinline__ void dil_unit(LAS unsigned char* lds, const DilArgs& a, DilStage& st, const int b, const int h, const int br, const int ublk,
                                         const bool has_next, const int nb_, const int nh_, const int nbr_, const int nublk_) {
    const int tid = opaque_tid(), wid = __builtin_amdgcn_readfirstlane(tid >> 6), lane = tid & 63, r = lane & 31, hh = lane >> 5;
    const int lgd = br * 2, d = 1 << lgd, nsub = S >> lgd;
    const int bh = b * 4 + h;
    float shift;
    { float mq = 0.f, mk = 0.f;
      { mq = fabsf(a.gq[lane]); mk = fabsf(a.gk[lane]); }
      float bm = lane < 32 ? a.relb[lane * 8 + h] * LOG2E : 0.f;
#pragma unroll
      for (int o = 32; o >= 1; o >>= 1) { mq = fmaxf(mq, __shfl_xor(mq, o)); mk = fmaxf(mk, __shfl_xor(mk, o)); bm = fmaxf(bm, __shfl_xor(bm, o)); }
      shift = mq * mk * 8.0f * LOG2E * 1.02f + bm; }
    LAS float* bt = (LAS float*)(lds + DBT_OFF);
    __syncthreads();
    if (tid < 256) { const int jj = tid - 128; bt[tid] = (jj >= -64 && jj <= 64) ? a.bias[(size_t)h * 4096 + jj * d + 2048] - shift : -1.0e30f; }
#pragma unroll
    for (int i = 0; i < 6; ++i) { const int c = tid + 512 * i, row = c >> 3, cc = c & 7;
        *(LAS u32x4*)(lds + row * DKROWB + cc * 16) = st.kv[i]; *(LAS u32x4*)(lds + DV_OFF + row * VROWB + cc * 16) = st.vv[i]; }
    const int pi0 = 256 * ublk + 32 * wid, rho = pi0 >> (11 - lgd), l0 = pi0 & (nsub - 1);
    const int tq = ((l0 + r) << lgd) + rho;
    bf16x8 qf[4];
    { const bf16_t* qp = a.Q + ((size_t)bh * S + tq) * 64 + 8 * hh;
#pragma unroll
      for (int s = 0; s < 4; ++s) qf[s] = *(const bf16x8*)(qp + 16 * s); }
    __syncthreads();
    if (has_next) dil_fetch(st, a, tid, nb_, nh_, nbr_, nublk_);
    f32x16 o[2]; float l4[4] = {0.f, 0.f, 0.f, 0.f};
#pragma unroll
    for (int m = 0; m < 2; ++m)
#pragma unroll
        for (int i = 0; i < 16; ++i) o[m][i] = 0.f;
    const unsigned ka = (32 * wid + r) * DKROWB + hh * 16;
    const unsigned va = DV_OFF + (32 * wid + 4 * hh + ((lane & 15) >> 2)) * VROWB + (16 * ((lane >> 4) & 1) + 4 * (lane & 3)) * 2;
#pragma unroll
    for (int c = 0; c < 5; ++c) {
        const int lt = l0 + 32 * (c - 2);
        if (lt >= 0 && lt < nsub) {
            f32x16 sa;
            const LAS float* bp = bt + (32 * (c - 2) + 4 * hh - r + 128);
#pragma unroll
            for (int i = 0; i < 16; ++i) sa[i] = bp[(i & 3) + 8 * (i >> 2)];
#pragma unroll
            for (int s = 0; s < 4; ++s) { const bf16x8 kf = *(const LAS bf16x8*)(lds + ka + c * 32 * DKROWB + s * 32); sa = __builtin_amdgcn_mfma_f32_32x32x16_bf16(kf, qf[s], sa, 0, 0, 0); }
#pragma unroll
            for (int i = 0; i < 16; ++i) { sa[i] = __builtin_amdgcn_exp2f(sa[i]); l4[i & 3] += sa[i]; asm volatile("" : "+v"(l4[i & 3])); }
#pragma unroll
            for (int s2 = 0; s2 < 2; ++s2) { const bf16x8 pa = pack8(sa, s2);
#pragma unroll
                for (int m = 0; m < 2; ++m) { const bf16x8 vf = tr_pair(lds + va + c * 32 * VROWB + s2 * 16 * VROWB + m * 64); o[m] = __builtin_amdgcn_mfma_f32_32x32x16_bf16(vf, pa, o[m], 0, 0, 0); } }
        }
    }
    float lt0 = (l4[0] + l4[1]) + (l4[2] + l4[3]); lt0 += __shfl_xor(lt0, 32);
    const float inv = 1.0f / lt0;
    const int t = b * S + tq;
    bf16_t* yp = a.YBP + (size_t)br * T * 256 + (size_t)t * 256 + h * 64 + 4 * hh;
#pragma unroll
    for (int m = 0; m < 2; ++m)
#pragma unroll
        for (int g4 = 0; g4 < 4; ++g4) { uint2 w; w.x = pack2(o[m][4 * g4] * inv, o[m][4 * g4 + 1] * inv); w.y = pack2(o[m][4 * g4 + 2] * inv, o[m][4 * g4 + 3] * inv);
            *(uint2*)(yp + 32 * m + 8 * g4) = w; }
    if (hh == 0) a.LB[(size_t)br * T * 4 + (size_t)t * 4 + h] = lt0;
}
}

typedef const __attribute__((address_space(4))) Params* KParams;
__device__ __forceinline__ KParams kparams() { KParams k = (KParams)__builtin_amdgcn_kernarg_segment_ptr(); asm volatile("" : "+s"(k)); return k; }
constexpr int RSTAB_OFF = 128 * 1024 + 2048, CSTAB_OFF = RSTAB_OFF + 8192;
constexpr int LDS_TOTAL = CSTAB_OFF + 8192;
constexpr int NPHASE_LAYER = 11;
__device__ __forceinline__ Params load_params(KParams k) { Params p; p.x = k->x; p.rel_bias = k->rel_bias; p.norm1_g = k->norm1_g; p.w_in = k->w_in; p.mla_q_norm_g = k->mla_q_norm_g; p.mla_kv_norm_g = k->mla_kv_norm_g; p.mla_w_uq = k->mla_w_uq; p.mla_w_ukv = k->mla_w_ukv; p.mla_qk_g = k->mla_qk_g; p.dil_qk_g = k->dil_qk_g; p.gqa_qk_g = k->gqa_qk_g; p.diff_qk_g = k->diff_qk_g; p.diff_lambda = k->diff_lambda; p.diff_subln_g = k->diff_subln_g; p.mix_beta = k->mix_beta; p.w_out = k->w_out; p.norm2_g = k->norm2_g; p.rg_w = k->rg_w; p.rg_b = k->rg_b; p.re_w = k->re_w; p.re_b = k->re_b; p.w_gate = k->w_gate; p.w_up = k->w_up; p.w_down = k->w_down; p.out = k->out; p.ws = k->ws; return p; }
template <int PH> __device__ __forceinline__ void run_phase(const int layer, LAS unsigned char* lds, const bool dup = false) {
    const Params p = load_params(kparams());
    const int bidx = opaque_s((int)blockIdx.x), gdim = opaque_s((int)gridDim.x); (void)bidx; (void)gdim;
    unsigned char* ws = p.ws;
    const float* xin = layer == 0 ? p.x : p.out;
    if constexpr (PH == 0) {
        ph_prep_tables(p);
        ph_xcast(p);
        ph_prep_layer0(p, (LAS float*)lds);
    } else if constexpr (PH == 2) {
        g8::DenseOrder Sd; Sd.init((const bf16_t*)(ws + OFF_HN), 1024, (const bf16_t*)(ws + OFF_WIN) + (size_t)layer * NPROJ * 1024, 1024, T, NPROJ, gdim, bidx);
        LAS float* rstab = (LAS float*)(lds + RSTAB_OFF); LAS f32x2* cstab = (LAS f32x2*)(lds + CSTAB_OFF);
        { const int tidx = opaque_tid(); const float* ssx = (const float*)(ws + OFF_SSX); const float2* CS = (const float2*)(ws + OFF_CS);
          for (int i = tidx; i < 1024; i += 512) { const float2 c = CS[i]; cstab[i] = (f32x2){c.x, c.y}; }
          { const int half = tidx >> 8, rl = tidx & 255; f32x4 sv[4][4]; int okm = 0;
#pragma unroll
            for (int k = 0; k < 4; ++k) { g8::GUnit u; const bool ok = Sd.next(2 * k + half, u); const int pm = ok ? u.pm : 0; okm |= ok ? (1 << k) : 0;
                const f32x4* sp = (const f32x4*)(ssx + (size_t)(pm * 256 + rl) * 16); sv[k][0] = sp[0]; sv[k][1] = sp[1]; sv[k][2] = sp[2]; sv[k][3] = sp[3]; }
#pragma unroll
            for (int k = 0; k < 4; ++k) if (okm & (1 << k)) { const f32x4 s0 = sv[k][0], s1 = sv[k][1], s2 = sv[k][2], s3 = sv[k][3];
                const float tot = ((s0[0] + s0[1]) + (s0[2] + s0[3])) + ((s1[0] + s1[1]) + (s1[2] + s1[3])) + ((s2[0] + s2[1]) + (s2[2] + s2[3])) + ((s3[0] + s3[1]) + (s3[2] + s3[3]));
                rstab[(2 * k + half) * 256 + rl] = rsqrtf(tot * (1.0f / 1024.0f) + EPS); } }
          __syncthreads(); }
        g8::EpiInProj E; E.rstab = rstab; E.cstab = cstab; E.ssq = (float*)(ws + OFF_SSQ); E.sskv = (float*)(ws + OFF_SSKV); E.AMLA = (bf16_t*)(ws + OFF_AMLA); E.KR = (bf16_t*)(ws + OFF_KR);
        E.qB = (bf16_t*)(ws + OFF_QB); E.kB = (bf16_t*)(ws + OFF_KB); E.vB = (bf16_t*)(ws + OFF_VB); E.qC = (bf16_t*)(ws + OFF_QC); E.kC = (bf16_t*)(ws + OFF_KC); E.vC = (bf16_t*)(ws + OFF_VC);
        E.qD = (bf16_t*)(ws + OFF_QD); E.kD = (bf16_t*)(ws + OFF_KD); E.vD = (bf16_t*)(ws + OFF_VD);
        E.g_dil = p.dil_qk_g + layer * 128; E.g_gqa = p.gqa_qk_g + layer * 128; E.g_diff = p.diff_qk_g + layer * 64;
        g8::gemm_phase<g8::EpiInProj, g8::DenseOrder>(lds, Sd, E, 1024, 16, 1024);
    } else if constexpr (PH == 4) {
        ph_mla_up(p, layer, lds);
    } else if constexpr (PH == 6) {
        const float* bias = (const float*)(ws + OFF_BIAS);
        at::Args aD{}; aD.Q = (const bf16_t*)(ws + OFF_QD); aD.K = (const bf16_t*)(ws + OFF_KD); aD.V = (const bf16_t*)(ws + OFF_VD); aD.Y = (bf16_t*)(ws + OFF_YD);
        aD.gq = p.diff_qk_g + layer * 64; aD.gk = aD.gq + 32; aD.ng = 32; aD.HQ = 4; aD.HKV = 4; aD.bias = bias + 4 * 4096; aD.relb = p.rel_bias;
        aD.lamvec = p.diff_lambda + layer * 128; aD.lam_init = lambda_init_of(layer); aD.subln_g = p.diff_subln_g + layer * 64;
        at::Args aA{}; aA.Q = (const bf16_t*)(ws + OFF_QA); aA.K = (const bf16_t*)(ws + OFF_KA); aA.V = (const bf16_t*)(ws + OFF_VA); aA.Y = (bf16_t*)(ws + OFF_YA);
        aA.gq = p.mla_qk_g + layer * 192; aA.gk = aA.gq + 96; aA.ng = 96; aA.HQ = 4; aA.HKV = 4;
        at::Args aC{}; aC.Q = (const bf16_t*)(ws + OFF_QC); aC.K = (const bf16_t*)(ws + OFF_KC); aC.V = (const bf16_t*)(ws + OFF_VC); aC.Y = (bf16_t*)(ws + OFF_YC);
        aC.gq = p.gqa_qk_g + layer * 128; aC.gk = aC.gq + 64; aC.ng = 64; aC.HQ = 4; aC.HKV = 2;
        at::DilArgs aB{}; aB.Q = (const bf16_t*)(ws + OFF_QB); aB.K = (const bf16_t*)(ws + OFF_KB); aB.V = (const bf16_t*)(ws + OFF_VB); aB.YBP = (bf16_t*)(ws + OFF_YBP); aB.LB = (float*)(ws + OFF_LB);
        aB.bias = bias; aB.gq = p.dil_qk_g + layer * 128; aB.gk = aB.gq + 64; aB.relb = p.rel_bias;
        const int kinds = dup ? ATT_DUP_KINDS : 15;
        auto remap = [&](const int u) { if (gdim != 256) return u; const int i = u >> 8, c = u & 255, x = c & 7, sl = c >> 3; return ((x * 8 + i * 4 + (sl >> 3)) << 3) | (sl & 7); };
        if (kinds & 1) for (int u0 = bidx; u0 < 512; u0 += gdim) { const int u = remap(u0); at::attn_unit<2>(lds, aD, u >> 5, (u >> 3) & 3, u & 7); }
        if (kinds & 2) for (int u0 = bidx; u0 < 512; u0 += gdim) { const int u = remap(u0); at::attn_unit<0>(lds, aA, u >> 5, (u >> 3) & 3, u & 7); }
        if (kinds & 4) for (int u0 = bidx; u0 < 512; u0 += gdim) { const int u = remap(u0); at::attn_unit<1>(lds, aC, u >> 5, (u >> 3) & 3, u & 7); }
        if (kinds & 8) { at::DilStage st; const int tid0 = opaque_tid();
            if (bidx < 1536) at::dil_fetch(st, aB, tid0, bidx / 96, (bidx / 24) & 3, (bidx >> 3) % 3, bidx & 7);
            for (int u = bidx; u < 1536; u += gdim) { const int un = u + gdim; const bool hn = un < 1536;
                at::dil_unit(lds, aB, st, u / 96, (u / 24) & 3, (u >> 3) % 3, u & 7, hn, un / 96, (un / 24) & 3, (un >> 3) % 3, un & 7); } }
    } else if constexpr (PH == 7) {
        ph_mix(p, layer);
    } else if constexpr (PH == 8) {
        g8::EpiResidBf16 E; E.X = (bf16_t*)(ws + OFF_HN); E.ldc = 1024; E.accscale = dup ? 0.f : 1.f;
        g8::DenseOrder Sd; Sd.init((const bf16_t*)(ws + OFF_MIX), 1024, (const bf16_t*)(ws + OFF_WOUT) + (size_t)layer * 1024 * 1024, 1024, T, 1024, gdim, bidx);
        g8::gemm_phase<g8::EpiResidBf16, g8::DenseOrder>(lds, Sd, E, 1024, 16, 1024);
    } else if constexpr (PH == 9) {
        ph_norm2_route(p, layer, (LAS float*)lds, dup);
    } else if constexpr (PH == 10 || PH == 11) {
        constexpr int MODE = PH == 10 ? 1 : 2;
        LAS int* tab = (LAS int*)(lds + g8::STAGE_BYTES);
        g8::moe_build_tab(tab, (const int*)(ws + OFF_CNT) + layer * 32);
        g8::MoeOrder<MODE> Sm; Sm.tab = tab; Sm.recs = (const SortRec*)(ws + OFF_PERM); Sm.G = gdim; Sm.c = bidx; Sm.layer = layer;
        if constexpr (MODE == 1) { Sm.A = (const bf16_t*)(ws + OFF_HN); Sm.W = (const bf16_t*)(ws + OFF_WGU);
            g8::EpiGateUp E; E.HID = (bf16_t*)(ws + OFF_HID); E.recs = Sm.recs;
            g8::gemm_phase<g8::EpiGateUp, g8::MoeOrder<MODE>>(lds, Sm, E, 1024, 16, 1024);
            if (layer == 0 && !dup) {
                int mine = 0, most = 0; { g8::GUnit uu; while (Sm.next(mine, uu)) ++mine; const int MT = tab[24]; for (int x = 0; x < 8; ++x) { const int nu = ((((x + 1) * MT) >> 3) - ((x * MT) >> 3)) * 8; const int per = (nu + (gdim >> 3) - 1) / (gdim >> 3); most = per > most ? per : most; } }
                if (mine < most) prep_queue(p, 14 * (most - mine), (LAS float*)lds, (LAS int*)(lds + 64 * 1024)); }
        } else { Sm.A = (const bf16_t*)(ws + OFF_HID); Sm.W = (const bf16_t*)(ws + OFF_WDT);
            g8::EpiScatterAdd E; E.xs = (bf16_t*)(ws + OFF_HN); E.out = p.out; E.recs = Sm.recs; E.dummy = (bf16_t*)(ws + OFF_DUMMY); E.ssx = (float*)(ws + OFF_SSX); E.emit = layer + 1 < NL ? 1 : 0; E.accscale = dup ? 0.f : 1.f;
            g8::gemm_phase<g8::EpiScatterAdd, g8::MoeOrder<MODE>>(lds, Sm, E, 1024, 8, 512);
            if (layer == 0 && !dup) prep_queue(p, -1, (LAS float*)lds, (LAS int*)(lds + 64 * 1024));
        }
    }
}

#ifndef MK_FUSED
#define MK_FUSED 1
#endif
#ifndef DUP_MASK
#define DUP_MASK 0
#endif
#if MK_FUSED
__device__ __forceinline__ void grid_sync(const XcdBarrier& b0) { XcdBarrier b = b0; asm volatile("" : "+s"(b.bar), "+s"(b.x)); xcd_barrier(b); }
__global__ __launch_bounds__(512, 2) void k_mega(Params p) {
    extern __shared__ __attribute__((aligned(16))) unsigned char shm[];
    LAS unsigned char* lds = (LAS unsigned char*)shm;
    volatile LAS unsigned* xbw = (volatile LAS unsigned*)(lds + 128 * 1024 + 1024);
    if (threadIdx.x == 0) { xbw[0] = 0u; xbw[1] = 0u; }
    __syncthreads();
    XcdBarrier bar = xcd_barrier_post((unsigned*)(kparams()->ws + OFF_BAR), xbw);
    run_phase<0>(0, lds); grid_sync(bar); if constexpr ((DUP_MASK >> 0) & 1) { run_phase<0>(0, lds, true); grid_sync(bar); }
#pragma unroll 1
    for (int layer = 0; layer < NL; ++layer) {
        run_phase<2>(layer, lds); grid_sync(bar); if constexpr ((DUP_MASK >> 2) & 1) { run_phase<2>(layer, lds, true); grid_sync(bar); }
        run_phase<4>(layer, lds); grid_sync(bar); if constexpr ((DUP_MASK >> 4) & 1) { run_phase<4>(layer, lds, true); grid_sync(bar); }
        run_phase<6>(layer, lds); grid_sync(bar); if constexpr ((DUP_MASK >> 6) & 1) { run_phase<6>(layer, lds, true); grid_sync(bar); }
        run_phase<7>(layer, lds); grid_sync(bar); if constexpr ((DUP_MASK >> 7) & 1) { run_phase<7>(layer, lds, true); grid_sync(bar); }
        run_phase<8>(layer, lds); grid_sync(bar); if constexpr ((DUP_MASK >> 8) & 1) { run_phase<8>(layer, lds, true); grid_sync(bar); }
        run_phase<9>(layer, lds); grid_sync(bar); if constexpr ((DUP_MASK >> 9) & 1) { run_phase<9>(layer, lds, true); grid_sync(bar); }
        run_phase<10>(layer, lds); grid_sync(bar); if constexpr ((DUP_MASK >> 10) & 1) { run_phase<10>(layer, lds, true); grid_sync(bar); }
        run_phase<11>(layer, lds); grid_sync(bar); if constexpr ((DUP_MASK >> 11) & 1) { run_phase<11>(layer, lds, true); grid_sync(bar); }
    }
}
#else
template <int PH> __global__ __launch_bounds__(512, 2) void k_phase(Params p, int layer) {
    extern __shared__ __attribute__((aligned(16))) unsigned char shm[];
    run_phase<PH>(layer, (LAS unsigned char*)shm);
}
template <int PH> static void launch_phase(const Params& p, int layer, int grid, hipStream_t st) {
    static bool attr = false; if (!attr) { (void)hipFuncSetAttribute((const void*)k_phase<PH>, hipFuncAttributeMaxDynamicSharedMemorySize, LDS_TOTAL); attr = true; }
    hipLaunchKernelGGL((k_phase<PH>), dim3(grid), dim3(512), LDS_TOTAL, st, p, layer);
}
#endif

extern "C" void kernel_launch(void* const* d_in, const int* in_sizes, int n_in, void* d_out, int out_size, void* d_ws, size_t ws_size, hipStream_t stream) {
    Params p{};
    p.x = (const float*)d_in[0]; p.rel_bias = (const float*)d_in[1]; p.norm1_g = (const float*)d_in[2]; p.w_in = (const float*)d_in[3];
    p.mla_q_norm_g = (const float*)d_in[4]; p.mla_kv_norm_g = (const float*)d_in[5]; p.mla_w_uq = (const float*)d_in[6]; p.mla_w_ukv = (const float*)d_in[7];
    p.mla_qk_g = (const float*)d_in[8]; p.dil_qk_g = (const float*)d_in[9]; p.gqa_qk_g = (const float*)d_in[10]; p.diff_qk_g = (const float*)d_in[11];
    p.diff_lambda = (const float*)d_in[12]; p.diff_subln_g = (const float*)d_in[13]; p.mix_beta = (const float*)d_in[14]; p.w_out = (const float*)d_in[15];
    p.norm2_g = (const float*)d_in[16]; p.rg_w = (const float*)d_in[17]; p.rg_b = (const float*)d_in[18]; p.re_w = (const float*)d_in[19]; p.re_b = (const float*)d_in[20];
    p.w_gate = (const float*)d_in[21]; p.w_up = (const float*)d_in[22]; p.w_down = (const float*)d_in[23];
    p.out = (float*)d_out; p.ws = (unsigned char*)d_ws;
    static int grid = 0;
    if (!grid) {
        int dev = 0, cus = 0, per_cu = 0;
        (void)hipGetDevice(&dev);
        (void)hipDeviceGetAttribute(&cus, hipDeviceAttributeMultiprocessorCount, dev);
#if MK_FUSED
        (void)hipFuncSetAttribute((const void*)k_mega, hipFuncAttributeMaxDynamicSharedMemorySize, LDS_TOTAL);
        (void)hipOccupancyMaxActiveBlocksPerMultiprocessor(&per_cu, k_mega, 512, LDS_TOTAL);
#else
        per_cu = 1;
#endif
        if (cus <= 0) cus = 256;
        grid = per_cu >= 1 ? cus : 0;
        if (grid > 256) grid = 256;
    }
    (void)hipMemsetAsync(p.ws + OFF_BAR, 0, 64 * 1024, stream);
#if MK_FUSED
    if (grid > 0) hipLaunchKernelGGL(k_mega, dim3(grid), dim3(512), LDS_TOTAL, stream, p);
#else
    launch_phase<0>(p, 0, grid, stream);
    for (int l = 0; l < NL; ++l) {
        launch_phase<2>(p, l, grid, stream); launch_phase<4>(p, l, grid, stream);
        launch_phase<6>(p, l, grid, stream); launch_phase<7>(p, l, grid, stream); launch_phase<8>(p, l, grid, stream);
        launch_phase<9>(p, l, grid, stream); launch_phase<10>(p, l, grid, stream); launch_phase<11>(p, l, grid, stream);
    }
#endif
}
```

```cpp
#include <hip/hip_runtime.h>
#include <stdint.h>

typedef unsigned short bf16_t;
#ifndef ATT_DUP_KINDS
#define ATT_DUP_KINDS 15
#endif

constexpr int NB = 16, S = 2048, T = NB * S, DM = 1024, NL = 2;
constexpr int NPROJ = 2560;
constexpr int NIN = 2464;
constexpr float LOG2E = 1.4426950408889634f;
constexpr float EPS = 1e-6f;

constexpr size_t MiB = 1024ull * 1024ull;
constexpr size_t OFF_BAR   = 0;
constexpr size_t OFF_BIAS  = 64 * 1024;
constexpr size_t OFF_CS    = OFF_BIAS + 8 * 4096 * 4;
constexpr size_t OFF_WIN   = 1 * MiB;
constexpr size_t SZ_WIN    = (size_t)NL * NPROJ * 1024 * 2;
constexpr size_t OFF_WUP   = OFF_WIN + SZ_WIN;
constexpr size_t SZ_WUP    = (size_t)NL * 1024 * 384 * 2;
constexpr size_t OFF_WUPKV = OFF_WUP + (size_t)NL * 384 * 256 * 2;
constexpr size_t OFF_WOUT  = OFF_WUP + SZ_WUP;
constexpr size_t SZ_WOUT   = (size_t)NL * 1024 * 1024 * 2;
constexpr size_t OFF_WGU   = OFF_WOUT + SZ_WOUT;
constexpr size_t SZ_WGU    = (size_t)NL * 16 * 1024 * 1024 * 2;
constexpr size_t OFF_WDT   = OFF_WGU + SZ_WGU;
constexpr size_t SZ_WDT    = (size_t)NL * 16 * 1024 * 512 * 2;
constexpr size_t OFF_R1    = OFF_WDT + SZ_WDT;
constexpr size_t SZ_R1     = (size_t)T * 1024 * 2;
constexpr size_t OFF_R2    = OFF_R1 + SZ_R1;
constexpr size_t SZ_R2     = (size_t)T * NPROJ * 2;
constexpr size_t OFF_R5    = OFF_R2 + SZ_R2;
constexpr size_t SZ_H256   = (size_t)T * 256 * 2;
constexpr size_t OFF_QB = OFF_R5, OFF_KB = OFF_QB + SZ_H256, OFF_VB = OFF_KB + SZ_H256;
constexpr size_t OFF_QC = OFF_VB + SZ_H256, OFF_KC = OFF_QC + SZ_H256, OFF_VC = OFF_KC + SZ_H256 / 2;
constexpr size_t OFF_QD = OFF_VC + SZ_H256 / 2, OFF_KD = OFF_QD + SZ_H256, OFF_VD = OFF_KD + SZ_H256;
constexpr size_t OFF_KR    = OFF_VD + SZ_H256;
constexpr size_t OFF_ROUTE = OFF_KR + (size_t)T * 32 * 2;
constexpr size_t OFF_LB    = OFF_ROUTE + (size_t)T * 16;
constexpr size_t OFF_PERM  = OFF_LB + (size_t)3 * T * 4 * 4;
constexpr size_t OFF_SSX   = OFF_PERM + (size_t)24 * T * 16;
constexpr size_t OFF_SSQ   = OFF_SSX + (size_t)T * 16 * 4;
constexpr size_t OFF_SSKV  = OFF_SSQ + (size_t)T * 4 * 4;
constexpr size_t OFF_END   = OFF_SSKV + (size_t)T * 4 * 4;
constexpr size_t OFF_PREPQ = OFF_BAR + 24 * 1024;
constexpr size_t OFF_DUMMY = OFF_BAR + 32 * 1024;
constexpr size_t OFF_CNT   = OFF_BAR + 16 * 1024;
static_assert(OFF_END <= 512 * MiB, "workspace overflow");
constexpr size_t OFF_HN = OFF_R1;
constexpr size_t OFF_YA = OFF_R2 + 48 * MiB, OFF_YC = OFF_YA + SZ_H256, OFF_YD = OFF_YA + 2 * SZ_H256;
constexpr size_t OFF_AMLA = OFF_R2;
constexpr size_t OFF_QA = OFF_R2 + 96 * MiB;
constexpr size_t OFF_KA = OFF_QA + (size_t)T * 4 * 96 * 2;
constexpr size_t OFF_VA = OFF_KA + (size_t)T * 4 * 96 * 2;
constexpr size_t OFF_YBP = OFF_R2;
constexpr size_t OFF_MIX = OFF_R2 + 96 * MiB;
constexpr size_t OFF_HID = OFF_R2;

struct Params {
    const float* x; const float* rel_bias; const float* norm1_g; const float* w_in; const float* mla_q_norm_g; const float* mla_kv_norm_g;
    const float* mla_w_uq; const float* mla_w_ukv; const float* mla_qk_g; const float* dil_qk_g; const float* gqa_qk_g; const float* diff_qk_g;
    const float* diff_lambda; const float* diff_subln_g; const float* mix_beta; const float* w_out; const float* norm2_g;
    const float* rg_w; const float* rg_b; const float* re_w; const float* re_b; const float* w_gate; const float* w_up; const float* w_down;
    float* out; unsigned char* ws;
};

__device__ __forceinline__ float bf2f(bf16_t v) { return __uint_as_float(((unsigned)v) << 16); }
__device__ __forceinline__ bf16_t f2bf(float f) { unsigned u = __float_as_uint(f); u += 0x7fffu + ((u >> 16) & 1u); return (bf16_t)(u >> 16); }
__device__ __forceinline__ unsigned pack2(float lo, float hi) { unsigned r; asm("v_cvt_pk_bf16_f32 %0, %1, %2" : "=v"(r) : "v"(lo), "v"(hi)); return r; }
__device__ __forceinline__ void load8(const bf16_t* p, float (&x)[8]) {
    const uint4 v = *(const uint4*)p;
    x[0] = __uint_as_float(v.x << 16); x[1] = __uint_as_float(v.x & 0xffff0000u);
    x[2] = __uint_as_float(v.y << 16); x[3] = __uint_as_float(v.y & 0xffff0000u);
    x[4] = __uint_as_float(v.z << 16); x[5] = __uint_as_float(v.z & 0xffff0000u);
    x[6] = __uint_as_float(v.w << 16); x[7] = __uint_as_float(v.w & 0xffff0000u);
}
__device__ __forceinline__ void store8(bf16_t* p, const float (&x)[8]) {
    uint4 v; v.x = pack2(x[0], x[1]); v.y = pack2(x[2], x[3]); v.z = pack2(x[4], x[5]); v.w = pack2(x[6], x[7]);
    *(uint4*)p = v;
}
__device__ __forceinline__ float wave_sum(float v) {
#pragma unroll
    for (int o = 32; o >= 1; o >>= 1) v += __shfl_xor(v, o);
    return v;
}
__device__ __forceinline__ int opaque_s(int v) { asm volatile("" : "+s"(v)); return v; }
__device__ __forceinline__ int opaque_tid() { int t = threadIdx.x; asm volatile("" : "+v"(t)); return t; }
__device__ __forceinline__ float lambda_init_of(int layer) { return layer == 0 ? 0.2f : (0.8f - 0.6f * 0.7408182206817179f); }

#define LAS __attribute__((address_space(3)))
typedef short bf16x8 __attribute__((ext_vector_type(8)));
typedef float f32x4 __attribute__((ext_vector_type(4)));
typedef float f32x16 __attribute__((ext_vector_type(16)));
typedef unsigned u32x4 __attribute__((ext_vector_type(4)));
typedef float f32x2 __attribute__((ext_vector_type(2)));

#define XB_TMO      128
#define XB_XCNT(j)  (256  + 64 * (j))
#define XB_XSUB(j)  (1280 + 64 * (j))
#define XB_XGEN(j)  (2304 + 64 * (j))
#define XB_TOP      3328
#define XB_TOPGEN   3392
#define XCD_BAR_WORDS 3456
#define XB_SPIN_CAP (1u << 18)

__device__ __forceinline__ unsigned xb_ld(unsigned* p)              { return __hip_atomic_load(p, __ATOMIC_RELAXED, __HIP_MEMORY_SCOPE_AGENT); }
__device__ __forceinline__ unsigned xb_add(unsigned* p, unsigned v) { return __hip_atomic_fetch_add(p, v, __ATOMIC_RELAXED, __HIP_MEMORY_SCOPE_AGENT); }
__device__ __forceinline__ unsigned xb_xcc_id() { return (unsigned)__builtin_amdgcn_s_getreg((3 << 11) | 20) & 0xFu; }
#define XB_SPIN(cond, bar) do { unsigned _sp = 0; while (cond) { __builtin_amdgcn_s_sleep(1); \
    if ((++_sp & 255u) == 0u) { if (xb_ld(&(bar)[XB_TMO])) break; if (_sp > XB_SPIN_CAP) { atomicAdd(&(bar)[XB_TMO], 1u); break; } } } } while (0)

struct XcdBarrier {
    unsigned* bar; unsigned x;
    volatile LAS unsigned* st;
};

__device__ __forceinline__ XcdBarrier xcd_barrier_post(unsigned* bar, volatile LAS unsigned* st) {
    XcdBarrier b; b.bar = bar; b.x = xb_xcc_id(); b.st = st;
    if (threadIdx.x == 0) (void)xb_add(&bar[XB_XCNT(b.x)], 1u);
    return b;
}
__device__ __forceinline__ void xcd_barrier_complete(unsigned* bar, unsigned x, unsigned& nloc, unsigned& nx) {
    const unsigned G = gridDim.x * gridDim.y * gridDim.z;
    unsigned sum, cnt, mine, sp = 0u;
    for (;;) {
        sum = 0u; cnt = 0u; mine = 0u;
#pragma unroll
        for (unsigned j = 0; j < 16; ++j) { const unsigned c = xb_ld(&bar[XB_XCNT(j)]); sum += c; cnt += (c > 0u) ? 1u : 0u; mine = (j == x) ? c : mine; }
        if (sum == G) break;
        __builtin_amdgcn_s_sleep(1);
        if ((++sp & 255u) == 0u) { if (xb_ld(&bar[XB_TMO])) break; if (sp > XB_SPIN_CAP) { atomicAdd(&bar[XB_TMO], 1u); break; } }
    }
    nloc = mine > 0u ? mine : 1u; nx = cnt > 0u ? cnt : 1u;
}

__device__ __forceinline__ void xcd_barrier(const XcdBarrier& b) {
    asm volatile("s_waitcnt vmcnt(0)" ::: "memory");
    __syncthreads();
    if (threadIdx.x == 0) {
        unsigned* bar = b.bar;
        __builtin_amdgcn_s_waitcnt(0);
        unsigned nloc = b.st[0], nx = b.st[1];
        if (nloc == 0u) { xcd_barrier_complete(bar, b.x, nloc, nx); b.st[0] = nloc; b.st[1] = nx; }
        const unsigned old = xb_add(&bar[XB_XSUB(b.x)], 1u);
        const unsigned gen = old / nloc;
        if (old + 1u == (gen + 1u) * nloc) {
            __builtin_amdgcn_fence(__ATOMIC_RELEASE, "agent");
            asm volatile("s_waitcnt vmcnt(0)" ::: "memory");
            const unsigned og = xb_add(&bar[XB_TOP], 1u);
            const unsigned tg = og / nx;
            if (og + 1u == (tg + 1u) * nx) xb_add(&bar[XB_TOPGEN], 1u);
            else XB_SPIN(xb_ld(&bar[XB_TOPGEN]) == tg, bar);
            __builtin_amdgcn_fence(__ATOMIC_ACQUIRE, "agent");
            xb_add(&bar[XB_XGEN(b.x)], 1u);
            asm volatile("s_waitcnt vmcnt(0)" ::: "memory");
        } else {
            XB_SPIN(xb_ld(&bar[XB_XGEN(b.x)]) == gen, bar);
            __builtin_amdgcn_fence(__ATOMIC_ACQUIRE, "agent");
            asm volatile("s_waitcnt vmcnt(0)" ::: "memory");
        }
    }
    __syncthreads();
}


__device__ __forceinline__ void ph_prep_tables(const Params& p) {
    const int tidx = opaque_tid(); const int bidx = opaque_s((int)blockIdx.x), gdim = opaque_s((int)gridDim.x); (void)bidx; (void)gdim;
    float* bias = (float*)(p.ws + OFF_BIAS);
    float2* cs = (float2*)(p.ws + OFF_CS);
    for (int gid = bidx * blockDim.x + tidx; gid < 8 * 4096; gid += gdim * blockDim.x) {
        const int hh = gid >> 12, rel = (gid & 4095) - 2048;
        const int n = rel < 0 ? -rel : rel;
        int bucket;
        if (n < 8) bucket = n;
        else { const double lr = log((double)n / 8.0) / log(128.0); int large = 8 + (int)(lr * 8.0); bucket = large < 15 ? large : 15; }
        if (rel > 0) bucket += 16;
        bias[gid] = p.rel_bias[bucket * 8 + hh] * LOG2E;
        { const int pos = gid >> 4, i = gid & 15;
          const double inv = pow(10000.0, -(double)i / 16.0), ang = (double)pos * inv;
          cs[gid] = make_float2((float)cos(ang), (float)sin(ang)); }
    }
}

__device__ __forceinline__ int inproj_col(int n) {
    const int pn = n >> 8, phi = n & 255, bj = phi >> 7, wc = (phi >> 5) & 3, fq = (phi >> 3) & 3, nn = (phi >> 2) & 1, jj = phi & 3;
    const int e = 32 * bj + 8 * fq + 4 * nn + jj, L = 32 * bj + 16 * nn + 4 * fq + jj;
    switch (pn) {
        case 0: return phi;
        case 1: return phi < 128 ? 256 + phi : (phi < 160 ? 384 + (phi - 128) : -1);
        case 2: return 416 + 64 * wc + e;
        case 3: return 672 + 64 * wc + e;
        case 4: return 928 + 64 * wc + e;
        case 5: return 1184 + 64 * wc + L;
        case 6: return wc < 2 ? 1440 + 64 * wc + L : 1568 + 64 * (wc - 2) + e;
        case 7: return 1696 + 64 * wc + e;
        case 8: return 1952 + 64 * wc + e;
        default: return 2208 + 64 * wc + e;
    }
}
template <int KIND> __device__ __forceinline__ float prep_src(const Params& p, int batch, int n, int k) {
    if (KIND == 0) {
        const int oc = inproj_col(n);
        return oc < 0 ? 0.f : p.w_in[((size_t)batch * 1024 + k) * NIN + oc] * p.norm1_g[batch * 1024 + k];
    } else if (KIND == 1) {
        return p.mla_w_uq[((size_t)batch * 256 + k) * 384 + n] * p.mla_q_norm_g[batch * 256 + k];
    } else if (KIND == 2) {
        return p.w_out[((size_t)batch * 1024 + k) * 1024 + n];
    } else if (KIND == 3) {
        const int c = n >> 8, r = n & 255;
        return r < 128 ? p.w_gate[((size_t)batch * 1024 + k) * 512 + c * 128 + r] : p.w_up[((size_t)batch * 1024 + k) * 512 + c * 128 + (r - 128)];
    } else {
        return p.w_down[((size_t)batch * 512 + k) * 1024 + n];
    }
}
template <int KIND> __device__ __forceinline__ f32x4 prep_src4(const Params& p, int batch, int n, int k) {
    const f32x4 z = (f32x4){0.f, 0.f, 0.f, 0.f};
    if (KIND == 0) {
        const int oc = inproj_col(n);
        return oc < 0 ? z : *(const f32x4*)(p.w_in + ((size_t)batch * 1024 + k) * NIN + oc) * p.norm1_g[batch * 1024 + k];
    } else if (KIND == 1) {
        return *(const f32x4*)(p.mla_w_uq + ((size_t)batch * 256 + k) * 384 + n) * p.mla_q_norm_g[batch * 256 + k];
    } else if (KIND == 5) {
        return *(const f32x4*)(p.mla_w_ukv + ((size_t)batch * 128 + k) * 512 + n) * p.mla_kv_norm_g[batch * 128 + k];
    } else if (KIND == 2) {
        return *(const f32x4*)(p.w_out + ((size_t)batch * 1024 + k) * 1024 + n);
    } else if (KIND == 3) {
        const int c = n >> 8, r = n & 255;
        const float g2 = p.norm2_g[(batch >> 4) * 1024 + k];
        return (r < 128 ? *(const f32x4*)(p.w_gate + ((size_t)batch * 1024 + k) * 512 + c * 128 + r) : *(const f32x4*)(p.w_up + ((size_t)batch * 1024 + k) * 512 + c * 128 + (r - 128))) * g2;
    } else {
        return *(const f32x4*)(p.w_down + ((size_t)batch * 512 + k) * 1024 + n);
    }
}
template <int KIND> __device__ __forceinline__ void prep_tile(const Params& p, const int tidx, const int N, const int K, const int batch, const int rem, const size_t dst_off, LAS float* tile) {
    const int rn = (tidx & 31) * 4, rk = tidx >> 5;
    const int ntn = N / 128, k0 = (rem / ntn) * 64, n0 = (rem % ntn) * 128;
    f32x4 v[4];
#pragma unroll
    for (int i = 0; i < 4; ++i) v[i] = prep_src4<KIND>(p, batch, n0 + rn, k0 + rk + 16 * i);
    __syncthreads();
#pragma unroll
    for (int i = 0; i < 4; ++i)
#pragma unroll
        for (int e = 0; e < 4; ++e) tile[(rk + 16 * i) * 129 + rn + e] = v[i][e];
    __syncthreads();
    bf16_t* dst = (bf16_t*)(p.ws + dst_off) + (size_t)batch * N * K;
#pragma unroll
    for (int q = 0; q < 2; ++q) { const int c = tidx + 512 * q, wn = c >> 3, wkc = c & 7;
        float o[8];
#pragma unroll
        for (int jx = 0; jx < 8; ++jx) o[jx] = tile[(wkc * 8 + jx) * 129 + wn];
        store8(dst + (size_t)(n0 + wn) * K + k0 + wkc * 8, o); }
}
constexpr int PREP_TILES = 3540;
__device__ __forceinline__ void prep_layer_tile(const Params& p, const int tidx, const int layer, const int q, LAS float* tile) {
    if (q < 320) prep_tile<0>(p, tidx, NPROJ, 1024, layer, q, OFF_WIN, tile);
    else if (q < 332) prep_tile<1>(p, tidx, 384, 256, layer, q - 320, OFF_WUP, tile);
    else if (q < 340) prep_tile<5>(p, tidx, 512, 128, layer, q - 332, OFF_WUPKV, tile);
    else if (q < 468) prep_tile<2>(p, tidx, 1024, 1024, layer, q - 340, OFF_WOUT, tile);
    else if (q < 2516) prep_tile<3>(p, tidx, 1024, 1024, layer * 16 + ((q - 468) >> 7), (q - 468) & 127, OFF_WGU, tile);
    else prep_tile<4>(p, tidx, 1024, 512, layer * 16 + ((q - 2516) >> 6), (q - 2516) & 63, OFF_WDT, tile);
}
__device__ __forceinline__ void ph_prep_layer0(const Params& p, LAS float* tile) {
    const int tidx = opaque_tid(); const int bidx = opaque_s((int)blockIdx.x), gdim = opaque_s((int)gridDim.x);
    for (int q = bidx; q < PREP_TILES; q += gdim) prep_layer_tile(p, tidx, 0, q, tile);
}
__device__ __forceinline__ void prep_queue(const Params& p, const int budget, LAS float* tile, LAS int* slot) {
    const int tidx = opaque_tid();
    int* head = (int*)(p.ws + OFF_PREPQ);
    for (int n = 0; budget < 0 || n < budget; ++n) {
        __syncthreads();
        if (tidx == 0) *slot = atomicAdd(head, 1);
        __syncthreads();
        const int q = *slot;
        if (q >= PREP_TILES) break;
        prep_layer_tile(p, tidx, 1, q, tile);
    }
}

__device__ __forceinline__ void ph_xcast(const Params& p) {
    const int tidx = opaque_tid(); const int bidx = opaque_s((int)blockIdx.x), gdim = opaque_s((int)gridDim.x);
    const int lane = tidx & 63, wv = (bidx * blockDim.x + tidx) >> 6, nw = (gdim * blockDim.x) >> 6;
    bf16_t* xb = (bf16_t*)(p.ws + OFF_HN); float* ssx = (float*)(p.ws + OFF_SSX);
    for (int t0 = wv; t0 < T; t0 += 2 * nw) {
        float4 v[2][4];
#pragma unroll
        for (int k = 0; k < 2; ++k) { const int t = t0 + k * nw < T ? t0 + k * nw : t0;
#pragma unroll
            for (int i = 0; i < 4; ++i) v[k][i] = *(const float4*)(p.x + (size_t)t * 1024 + i * 256 + lane * 4); }
#pragma unroll
        for (int k = 0; k < 2; ++k) { const int t = t0 + k * nw; if (t < T) {
            float ss = 0.f;
#pragma unroll
            for (int i = 0; i < 4; ++i) ss += v[k][i].x * v[k][i].x + v[k][i].y * v[k][i].y + v[k][i].z * v[k][i].z + v[k][i].w * v[k][i].w;
            ss = wave_sum(ss);
#pragma unroll
            for (int i = 0; i < 4; ++i) { uint2 o; o.x = pack2(v[k][i].x, v[k][i].y); o.y = pack2(v[k][i].z, v[k][i].w); *(uint2*)(xb + (size_t)t * 1024 + i * 256 + lane * 4) = o; }
            if (lane < 16) ssx[(size_t)t * 16 + lane] = lane == 0 ? ss : 0.f; } }
    }
}

typedef float f32x4m __attribute__((ext_vector_type(4)));
__device__ __forceinline__ void ph_mla_up(const Params& p, int layer, LAS unsigned char* lds) {
    const int tidx = opaque_tid(); const int bidx = opaque_s((int)blockIdx.x), gdim = opaque_s((int)gridDim.x);
    const int wid = __builtin_amdgcn_readfirstlane(tidx >> 6), lane = tidx & 63, tk = lane & 15, kg = lane >> 4;
    unsigned char* ws = p.ws;
    const bf16_t* AMLA = (const bf16_t*)(ws + OFF_AMLA); const bf16_t* KR = (const bf16_t*)(ws + OFF_KR);
    const float* ssq = (const float*)(ws + OFF_SSQ); const float* sskv = (const float*)(ws + OFF_SSKV);
    const bf16_t* Wq = (const bf16_t*)(ws + OFF_WUP) + (size_t)layer * 384 * 256; const bf16_t* Wkv = (const bf16_t*)(ws + OFF_WUPKV) + (size_t)layer * 512 * 128;
    bf16_t* qA = (bf16_t*)(ws + OFF_QA); bf16_t* kA = (bf16_t*)(ws + OFF_KA); bf16_t* vA = (bf16_t*)(ws + OFF_VA);
    const float2* CS = (const float2*)(ws + OFF_CS);
    const float* gq = p.mla_qk_g + layer * 192; const float* gk = gq + 96;
    constexpr int QPB = 256 * 2 + 16, KPB = 128 * 2 + 16, KV_OFF = 96 * QPB;
    const float qscale = 0.10206207261596577f * LOG2E;
    LAS float* gl = (LAS float*)(lds + 88 * 1024);
    __syncthreads();
    if (tidx < 192) gl[tidx] = gq[tidx];
    __syncthreads();
    for (int grp = bidx; grp < T / 128; grp += gdim) {
        const int t = grp * 128 + wid * 16 + tk, b = t >> 11, sq = t & 2047;
        bf16x8 bq[8], bk[4];
        { const bf16_t* ap = AMLA + (size_t)t * 384 + 8 * kg;
#pragma unroll
          for (int s8 = 0; s8 < 8; ++s8) bq[s8] = *(const bf16x8*)(ap + 32 * s8);
#pragma unroll
          for (int s4 = 0; s4 < 4; ++s4) bk[s4] = *(const bf16x8*)(ap + 256 + 32 * s4); }
        const f32x4m a4 = *(const f32x4m*)(ssq + (size_t)t * 4), c4 = *(const f32x4m*)(sskv + (size_t)t * 4);
        const float rq = rsqrtf(((a4[0] + a4[1]) + (a4[2] + a4[3])) * (1.0f / 256.0f) + EPS), rk = rsqrtf(((c4[0] + c4[1]) + (c4[2] + c4[3])) * (1.0f / 128.0f) + EPS);
        float kr[2][4];
#pragma unroll
        for (int u = 0; u < 2; ++u) { const uint2 w = *(const uint2*)(KR + (size_t)t * 32 + 16 * u + 4 * kg);
            kr[u][0] = __uint_as_float(w.x << 16); kr[u][1] = __uint_as_float(w.x & 0xffff0000u); kr[u][2] = __uint_as_float(w.y << 16); kr[u][3] = __uint_as_float(w.y & 0xffff0000u); }
        float krss = 0.f;
#pragma unroll
        for (int u = 0; u < 2; ++u)
#pragma unroll
            for (int e = 0; e < 4; ++e) krss += kr[u][e] * kr[u][e];
        float2 cs[4];
#pragma unroll
        for (int e = 0; e < 4; ++e) cs[e] = CS[sq * 16 + 4 * kg + e];
        u32x4 wst[10];
#pragma unroll
        for (int i = 0; i < 6; ++i) { const int c = tidx + 512 * i; wst[i] = *(const u32x4*)(Wq + (size_t)(c >> 5) * 256 + (c & 31) * 8); }
#pragma unroll
        for (int i = 0; i < 4; ++i) { const int c = tidx + 512 * i; wst[6 + i] = *(const u32x4*)(Wkv + (size_t)(c >> 4) * 128 + (c & 15) * 8); }
#pragma unroll 1
        for (int h = 0; h < 4; ++h) {
            __syncthreads();
#pragma unroll
            for (int i = 0; i < 6; ++i) { const int c = tidx + 512 * i; *(LAS u32x4*)(lds + (c >> 5) * QPB + (c & 31) * 16) = wst[i]; }
#pragma unroll
            for (int i = 0; i < 4; ++i) { const int c = tidx + 512 * i; *(LAS u32x4*)(lds + KV_OFF + (c >> 4) * KPB + (c & 15) * 16) = wst[6 + i]; }
            __syncthreads();
            if (h < 3) {
#pragma unroll
                for (int i = 0; i < 6; ++i) { const int c = tidx + 512 * i; wst[i] = *(const u32x4*)(Wq + (size_t)(96 * (h + 1) + (c >> 5)) * 256 + (c & 31) * 8); }
#pragma unroll
                for (int i = 0; i < 4; ++i) { const int c = tidx + 512 * i; wst[6 + i] = *(const u32x4*)(Wkv + (size_t)(128 * (h + 1) + (c >> 4)) * 128 + (c & 15) * 8); } }
            const size_t orow = (size_t)(b * 4 + h) * S + sq;
            float qv[6][4]; float ss = 0.f;
#pragma unroll
            for (int mt = 0; mt < 6; ++mt) { f32x4 acc = (f32x4){0.f, 0.f, 0.f, 0.f};
#pragma unroll
                for (int s8 = 0; s8 < 8; ++s8) { const bf16x8 af = *(const LAS bf16x8*)(lds + (16 * mt + tk) * QPB + (32 * s8 + 8 * kg) * 2); acc = __builtin_amdgcn_mfma_f32_16x16x32_bf16(af, bq[s8], acc, 0, 0, 0); }
#pragma unroll
                for (int e = 0; e < 4; ++e) { qv[mt][e] = acc[e] * rq; ss += qv[mt][e] * qv[mt][e]; } }
            ss += __shfl_xor(ss, 16); ss += __shfl_xor(ss, 32);
            { const float rn = rsqrtf(ss * (1.0f / 96.0f) + EPS);
#pragma unroll
              for (int mt = 0; mt < 6; ++mt)
#pragma unroll
                  for (int e = 0; e < 4; ++e) qv[mt][e] *= rn * gl[16 * mt + 4 * kg + e];
#pragma unroll
              for (int e = 0; e < 4; ++e) { const float lo = qv[4][e], hi = qv[5][e]; qv[4][e] = lo * cs[e].x - hi * cs[e].y; qv[5][e] = hi * cs[e].x + lo * cs[e].y; }
#pragma unroll
              for (int mt = 0; mt < 6; ++mt) { uint2 w; w.x = pack2(qv[mt][0] * qscale, qv[mt][1] * qscale); w.y = pack2(qv[mt][2] * qscale, qv[mt][3] * qscale);
                  *(uint2*)(qA + orow * 96 + 16 * mt + 4 * kg) = w; } }
            float kv[8][4]; float sk = krss;
#pragma unroll
            for (int mt = 0; mt < 8; ++mt) { f32x4 acc = (f32x4){0.f, 0.f, 0.f, 0.f};
#pragma unroll
                for (int s4 = 0; s4 < 4; ++s4) { const bf16x8 af = *(const LAS bf16x8*)(lds + KV_OFF + (16 * mt + tk) * KPB + (32 * s4 + 8 * kg) * 2); acc = __builtin_amdgcn_mfma_f32_16x16x32_bf16(af, bk[s4], acc, 0, 0, 0); }
#pragma unroll
                for (int e = 0; e < 4; ++e) { kv[mt][e] = acc[e] * rk; if (mt < 4) sk += kv[mt][e] * kv[mt][e]; } }
            sk += __shfl_xor(sk, 16); sk += __shfl_xor(sk, 32);
            { const float rn = rsqrtf(sk * (1.0f / 96.0f) + EPS);
#pragma unroll
              for (int mt = 0; mt < 4; ++mt) { uint2 w;
                  w.x = pack2(kv[mt][0] * rn * gl[96 + 16 * mt + 4 * kg + 0], kv[mt][1] * rn * gl[96 + 16 * mt + 4 * kg + 1]); w.y = pack2(kv[mt][2] * rn * gl[96 + 16 * mt + 4 * kg + 2], kv[mt][3] * rn * gl[96 + 16 * mt + 4 * kg + 3]);
                  *(uint2*)(kA + orow * 96 + 16 * mt + 4 * kg) = w; }
              float lo[4], hi[4];
#pragma unroll
              for (int e = 0; e < 4; ++e) { const float a = kr[0][e] * rn * gl[96 + 64 + 4 * kg + e], bb = kr[1][e] * rn * gl[96 + 80 + 4 * kg + e]; lo[e] = a * cs[e].x - bb * cs[e].y; hi[e] = bb * cs[e].x + a * cs[e].y; }
              uint2 w; w.x = pack2(lo[0], lo[1]); w.y = pack2(lo[2], lo[3]); *(uint2*)(kA + orow * 96 + 64 + 4 * kg) = w;
              w.x = pack2(hi[0], hi[1]); w.y = pack2(hi[2], hi[3]); *(uint2*)(kA + orow * 96 + 80 + 4 * kg) = w;
#pragma unroll
              for (int mt = 4; mt < 8; ++mt) { uint2 wv; wv.x = pack2(kv[mt][0], kv[mt][1]); wv.y = pack2(kv[mt][2], kv[mt][3]); *(uint2*)(vA + orow * 64 + 16 * (mt - 4) + 4 * kg) = wv; } }
        }
    }
}

__device__ __forceinline__ void ph_mix(const Params& p, int layer) {
    const int tidx = opaque_tid(); const int bidx = opaque_s((int)blockIdx.x), gdim = opaque_s((int)gridDim.x);
    const int lane = tidx & 63, wv = (bidx * blockDim.x + tidx) >> 6, nw = (gdim * blockDim.x) >> 6;
    unsigned char* ws = p.ws;
    const bf16_t* YA = (const bf16_t*)(ws + OFF_YA); const bf16_t* YC = (const bf16_t*)(ws + OFF_YC); const bf16_t* YD = (const bf16_t*)(ws + OFF_YD);
    const bf16_t* YBP = (const bf16_t*)(ws + OFF_YBP); const float* LB = (const float*)(ws + OFF_LB);
    bf16_t* MIX = (bf16_t*)(ws + OFF_MIX);
    const float* beta = p.mix_beta + layer * 1024;
    const bool hiH = lane >= 32; const int cc = (lane & 31) * 8, hB = cc >> 6;
    float bt[2][8];
#pragma unroll
    for (int ps = 0; ps < 2; ++ps)
#pragma unroll
        for (int e = 0; e < 8; ++e) bt[ps][e] = beta[(ps * 64 + lane) * 8 + e];
    for (int t0 = wv; t0 < T; t0 += 2 * nw) {
        u32x4 v[2][2][3]; float lw[2][3];
#pragma unroll
        for (int k = 0; k < 2; ++k) { const int t = t0 + k * nw < T ? t0 + k * nw : t0;
            const bf16_t* p0a = (hiH ? YBP : YA) + (size_t)t * 256 + cc;
            const bf16_t* p0b = hiH ? YBP + (size_t)T * 256 + (size_t)t * 256 + cc : p0a; const bf16_t* p0c = hiH ? YBP + (size_t)2 * T * 256 + (size_t)t * 256 + cc : p0a;
            const bf16_t* p1a = (hiH ? YD : YC) + (size_t)t * 256 + cc;
            v[k][0][0] = *(const u32x4*)p0a; v[k][0][1] = *(const u32x4*)p0b; v[k][0][2] = *(const u32x4*)p0c; v[k][1][0] = *(const u32x4*)p1a;
#pragma unroll
            for (int br = 0; br < 3; ++br) lw[k][br] = LB[(size_t)br * T * 4 + (size_t)t * 4 + hB]; }
#pragma unroll
        for (int k = 0; k < 2; ++k) {
            const int t = t0 + k * nw; const bool ok = t < T;
#pragma unroll
            for (int ps = 0; ps < 2; ++ps) {
                float x[8];
                if (ps == 0) { const float l0 = hiH ? lw[k][0] : 1.0f, l1 = hiH ? lw[k][1] : 0.0f, l2 = hiH ? lw[k][2] : 0.0f; const float inv = 1.0f / (l0 + l1 + l2);
#pragma unroll
                    for (int w2 = 0; w2 < 4; ++w2) { const unsigned a = v[k][0][0][w2], b2 = v[k][0][1][w2], c2 = v[k][0][2][w2];
                        x[2 * w2] = (l0 * __uint_as_float(a << 16) + l1 * __uint_as_float(b2 << 16) + l2 * __uint_as_float(c2 << 16)) * inv;
                        x[2 * w2 + 1] = (l0 * __uint_as_float(a & 0xffff0000u) + l1 * __uint_as_float(b2 & 0xffff0000u) + l2 * __uint_as_float(c2 & 0xffff0000u)) * inv; }
                } else {
#pragma unroll
                    for (int w2 = 0; w2 < 4; ++w2) { const unsigned a = v[k][1][0][w2]; x[2 * w2] = __uint_as_float(a << 16); x[2 * w2 + 1] = __uint_as_float(a & 0xffff0000u); } }
                float ss = 0.f;
#pragma unroll
                for (int e = 0; e < 8; ++e) ss += x[e] * x[e];
#pragma unroll
                for (int off = 1; off <= 16; off <<= 1) ss += __shfl_xor(ss, off);
                const float rs = (ps == 1 && hiH) ? 1.0f : rsqrtf(ss * (1.0f / 256.0f) + EPS);
#pragma unroll
                for (int e = 0; e < 8; ++e) x[e] = x[e] * rs * bt[ps][e];
                if (ok) store8(MIX + (size_t)t * 1024 + (ps * 64 + lane) * 8, x);
            } }
    }
}

struct SortRec { int tok; float wlo, whi, rs; };
__device__ __forceinline__ float reduce20(const float (&v)[20], int lane) {
    float a[16];
#pragma unroll
    for (int i = 0; i < 16; ++i) { const bool up = lane & 32; const float hi = i < 4 ? v[16 + i] : 0.f; const float send = up ? v[i] : hi; const float keep = up ? hi : v[i]; a[i] = keep + __shfl_xor(send, 32); }
#pragma unroll
    for (int i = 0; i < 8; ++i) { const bool up = lane & 16; const float send = up ? a[i] : a[8 + i]; const float keep = up ? a[8 + i] : a[i]; a[i] = keep + __shfl_xor(send, 16); }
#pragma unroll
    for (int i = 0; i < 4; ++i) { const bool up = lane & 8; const float send = up ? a[i] : a[4 + i]; const float keep = up ? a[4 + i] : a[i]; a[i] = keep + __shfl_xor(send, 8); }
#pragma unroll
    for (int i = 0; i < 2; ++i) { const bool up = lane & 4; const float send = up ? a[i] : a[2 + i]; const float keep = up ? a[2 + i] : a[i]; a[i] = keep + __shfl_xor(send, 4); }
    { const bool up = lane & 2; const float send = up ? a[0] : a[1]; const float keep = up ? a[1] : a[0]; a[0] = keep + __shfl_xor(send, 2); }
    return a[0] + __shfl_xor(a[0], 1);
}
__device__ __forceinline__ void route_decide(const float (&lg)[20], const float* bg, const float* be, int& bucket, float& wlo, float& whi) {
    float gl[4]; int gi = 0;
#pragma unroll
    for (int i = 0; i < 4; ++i) gl[i] = lg[i] + bg[i];
    float gm = gl[0];
#pragma unroll
    for (int i = 1; i < 4; ++i) if (gl[i] > gm) { gm = gl[i]; gi = i; }
    float gs = 0.f;
#pragma unroll
    for (int i = 0; i < 4; ++i) gs += expf(gl[i] - gm);
    const float gw = 1.0f / gs;
    float el[4];
#pragma unroll
    for (int i = 0; i < 4; ++i) { const float v0 = lg[4 + i] + be[i], v1 = lg[8 + i] + be[4 + i], v2 = lg[12 + i] + be[8 + i], v3 = lg[16 + i] + be[12 + i];
        el[i] = gi == 0 ? v0 : (gi == 1 ? v1 : (gi == 2 ? v2 : v3)); }
    int i0 = 0; float m0 = el[0];
#pragma unroll
    for (int i = 1; i < 4; ++i) if (el[i] > m0) { m0 = el[i]; i0 = i; }
    int i1 = -1; float m1 = -3.0e38f;
#pragma unroll
    for (int i = 0; i < 4; ++i) if (i != i0 && el[i] > m1) { m1 = el[i]; i1 = i; }
    const float r = expf(m1 - m0); const float w0 = gw / (1.0f + r), w1 = gw * r / (1.0f + r);
    const int a = i0 < i1 ? i0 : i1, bq = i0 < i1 ? i1 : i0; const int pidx = a == 0 ? bq - 1 : (a == 1 ? bq + 1 : 5);
    bucket = gi * 6 + pidx; wlo = i0 < i1 ? w0 : w1; whi = i0 < i1 ? w1 : w0;
}
__device__ __forceinline__ void ph_norm2_route(const Params& p, int layer, LAS float* wl, const bool dup = false) {
    const int tidx = opaque_tid(); const int bidx = opaque_s((int)blockIdx.x), gdim = opaque_s((int)gridDim.x);
    const int wid = __builtin_amdgcn_readfirstlane(tidx >> 6), lane = tidx & 63, tk = lane & 15, kg = lane >> 4;
    const float* g = p.norm2_g + layer * 1024;
    const float* wg = p.rg_w + (size_t)layer * 1024 * 4; const float* we = p.re_w + (size_t)layer * 1024 * 16;
    const float* bg = p.rg_b + layer * 4; const float* be = p.re_b + layer * 16;
    const bf16_t* xs = (const bf16_t*)(p.ws + OFF_HN);
    LAS unsigned char* lb = (LAS unsigned char*)wl;
    constexpr int RP = 1024 * 2 + 16, WL_OFF = 20 * RP, Z_OFF = 40 * RP, AUX_OFF = 96 * 1024;
    __syncthreads();
    { f32x4 wv4[2][5]; float gd[2];
#pragma unroll
      for (int k = 0; k < 2; ++k) { const int d = tidx + 512 * k; gd[k] = g[d]; wv4[k][0] = *(const f32x4*)(wg + d * 4);
#pragma unroll
          for (int q = 0; q < 4; ++q) wv4[k][1 + q] = *(const f32x4*)(we + d * 16 + 4 * q); }
#pragma unroll
      for (int k = 0; k < 2; ++k) { const int d = tidx + 512 * k;
#pragma unroll
          for (int q = 0; q < 5; ++q)
#pragma unroll
              for (int e = 0; e < 4; ++e) { const float w = wv4[k][q][e] * gd[k]; const bf16_t hi = f2bf(w); const bf16_t lo = f2bf(w - bf2f(hi));
                  *(LAS bf16_t*)(lb + (q * 4 + e) * RP + d * 2) = hi; *(LAS bf16_t*)(lb + WL_OFF + (q * 4 + e) * RP + d * 2) = lo; } }
      if (tidx < RP / 16) { unsigned z = 0u; asm volatile("" : "+v"(z)); *(LAS u32x4*)(lb + Z_OFF + tidx * 16) = (u32x4){z, z, z, z}; } }
    __syncthreads();
    const unsigned a0h = tk * RP + kg * 16, a0l = WL_OFF + a0h;
    const unsigned a1h = (tk < 4 ? (16 + tk) * RP : Z_OFF) + kg * 16, a1l = (tk < 4 ? WL_OFF + (16 + tk) * RP : Z_OFF) + kg * 16;
    LAS int* rq = (LAS int*)(lb + AUX_OFF + 256) + wid * (64 * 5);
    int* cnt = (int*)(p.ws + OFF_CNT) + layer * 32 + (dup ? 4096 : 0); SortRec* recs = (SortRec*)(p.ws + OFF_PERM);
    int it = 0;
    for (int grp = bidx; grp < T / 128; grp += gdim, it += 16) {
        const int t = grp * 128 + wid * 16 + tk;
        const bf16_t* xp = xs + (size_t)t * 1024 + 8 * kg;
        f32x4 acc0 = (f32x4){0.f, 0.f, 0.f, 0.f}, acc1 = acc0; float ss = 0.f;
#pragma unroll 1
        for (int c8 = 0; c8 < 4; ++c8) {
            bf16x8 bf[8];
#pragma unroll
            for (int i = 0; i < 8; ++i) bf[i] = *(const bf16x8*)(xp + 32 * (8 * c8 + i));
#pragma unroll
            for (int i = 0; i < 8; ++i) { const int so = (8 * c8 + i) * 64;
                const u32x4 raw = __builtin_bit_cast(u32x4, bf[i]);
#pragma unroll
                for (int w2 = 0; w2 < 4; ++w2) { const float lo = __uint_as_float(raw[w2] << 16), hi = __uint_as_float(raw[w2] & 0xffff0000u); ss += lo * lo + hi * hi; }
                const bf16x8 ah0 = *(const LAS bf16x8*)(lb + a0h + so), al0 = *(const LAS bf16x8*)(lb + a0l + so), ah1 = *(const LAS bf16x8*)(lb + a1h + so), al1 = *(const LAS bf16x8*)(lb + a1l + so);
                acc0 = __builtin_amdgcn_mfma_f32_16x16x32_bf16(ah0, bf[i], acc0, 0, 0, 0); acc0 = __builtin_amdgcn_mfma_f32_16x16x32_bf16(al0, bf[i], acc0, 0, 0, 0);
                acc1 = __builtin_amdgcn_mfma_f32_16x16x32_bf16(ah1, bf[i], acc1, 0, 0, 0); acc1 = __builtin_amdgcn_mfma_f32_16x16x32_bf16(al1, bf[i], acc1, 0, 0, 0); }
        }
        ss += __shfl_xor(ss, 16); ss += __shfl_xor(ss, 32);
        const float rs = rsqrtf(ss * (1.0f / 1024.0f) + EPS);
        float lg[20];
#pragma unroll
        for (int r4 = 0; r4 < 4; ++r4) {
#pragma unroll
            for (int q = 0; q < 4; ++q) lg[4 * q + r4] = __shfl(acc0[r4], tk + 16 * q) * rs;
            lg[16 + r4] = __shfl(acc1[r4], tk) * rs; }
        int bk_; float wlo, whi;
        route_decide(lg, bg, be, bk_, wlo, whi);
        if (kg == 0) { LAS int* r0 = rq + ((it + tk) & 63) * 5; r0[0] = bk_; r0[1] = t; r0[2] = __float_as_int(wlo); r0[3] = __float_as_int(whi); r0[4] = __float_as_int(rs); }
        if (((it + 16) & 63) == 0) {
            const LAS int* rr = rq + lane * 5; const int b2 = rr[0]; const int slot = atomicAdd(cnt + b2, 1);
            SortRec sr; sr.tok = rr[1]; sr.wlo = __int_as_float(rr[2]); sr.whi = __int_as_float(rr[3]); sr.rs = __int_as_float(rr[4]); recs[(size_t)b2 * T + slot] = sr; }
    }
    const int npend = it & 63;
    int my_bucket = -1, my_tok = 0; float my_wlo = 0.f, my_whi = 0.f, my_rs = 0.f;
    if (lane < npend) { const LAS int* rr = rq + lane * 5; my_bucket = rr[0]; my_tok = rr[1]; my_wlo = __int_as_float(rr[2]); my_whi = __int_as_float(rr[3]); my_rs = __int_as_float(rr[4]); }
    { LAS int* hist = (LAS int*)(lb + AUX_OFF); LAS int* base = hist + 32;
      if (tidx < 32) hist[tidx] = 0;
      __syncthreads();
      int rank = 0;
      if (my_bucket >= 0) rank = __hip_atomic_fetch_add(hist + my_bucket, 1, __ATOMIC_RELAXED, __HIP_MEMORY_SCOPE_WORKGROUP);
      __syncthreads();
      if (tidx < 24) { const int c = hist[tidx]; base[tidx] = c > 0 ? atomicAdd(cnt + tidx, c) : 0; }
      __syncthreads();
      if (my_bucket >= 0) { const int slot = base[my_bucket] + rank; SortRec sr; sr.tok = my_tok; sr.wlo = my_wlo; sr.whi = my_whi; sr.rs = my_rs; recs[(size_t)my_bucket * T + slot] = sr; } }
}

namespace g8 {
constexpr int BM = 256, BK = 64, HALF = 128, HTB = HALF * BK * 2, STAGE_BYTES = 8 * HTB, NXCD = 8, WGM = 8;
__device__ __forceinline__ int lds_byte(int r, int c) { const int st = (r >> 4) * 2 + (c >> 5), rr = r & 15, cc = c & 31, ob = rr * 64 + cc * 2; return st * 1024 + (ob ^ (((ob >> 9) & 1) << 5)); }
__device__ __forceinline__ void stage_rc(int b, int& R, int& C) { const int st = b / 1024, sb = b % 1024, swz = sb ^ (((sb >> 9) & 1) << 5); R = (st >> 1) * 16 + swz / 64; C = (st & 1) * 32 + (swz % 64) / 2; }
__device__ __forceinline__ int perm32(int rho) { const int n = rho >> 4, i = rho & 15; return 8 * (i >> 2) + 4 * n + (i & 3); }
__device__ __forceinline__ unsigned cvt_pk_bf16(float lo, float hi) { unsigned r; asm volatile("v_cvt_pk_bf16_f32 %0, %1, %2" : "=v"(r) : "v"(lo), "v"(hi)); return r; }

struct GUnit { const char* A; const char* B; const char* B2; int pm, pn, k, s0, cnt, ord, half; };

struct DenseOrder {
    const bf16_t* A; const bf16_t* Bt; int lda, ldb, nM, nN, nwg, G, c;
    __device__ void init(const bf16_t* A_, int lda_, const bf16_t* Bt_, int ldb_, int M, int N, int G_, int c_) { A = A_; Bt = Bt_; lda = lda_; ldb = ldb_; nM = M / BM; nN = N / BM; nwg = nM * nN; G = G_; c = c_; }
    __device__ bool next(int i, GUnit& u) const {
        const long L = (long)i * G + c; if (L >= nwg) return false;
        int wgid = (int)L; { const int q = nwg / NXCD, r = nwg % NXCD, xcd = wgid % NXCD, off = wgid / NXCD; wgid = (xcd < r ? xcd * (q + 1) : r * (q + 1) + (xcd - r) * q) + off; }
        const int nig = WGM * nN, gid = wgid / nig, fm = gid * WGM, gsz = (nM - fm) < WGM ? (nM - fm) : WGM;
        u.pm = fm + ((wgid % nig) % gsz); u.pn = (wgid % nig) / gsz;
        u.A = (const char*)(A + (size_t)u.pm * BM * lda); u.B = (const char*)(Bt + (size_t)u.pn * BM * ldb); u.B2 = u.B; u.k = 0; u.s0 = 0; u.cnt = 0; u.ord = i; u.half = 0;
        return true;
    }
    __device__ __forceinline__ void aoff(const GUnit&, const int (&R)[2], const int (&C)[2], unsigned (&vo)[2][2]) const {
#pragma unroll
        for (int h = 0; h < 2; ++h)
#pragma unroll
            for (int i = 0; i < 2; ++i) vo[h][i] = (unsigned)((h * HALF + R[i]) * lda + C[i]) * 2u;
    }
};

struct EpiResidBf16 {
    static constexpr bool PERM = true;
    bf16_t* X; int ldc; float accscale;
    __device__ __forceinline__ void operator()(const f32x4 (&acc)[2][2][4][2], const GUnit& u, int wr, int wc, int fr, int fq) const {
        const int row0 = u.pm * BM + wr * 64 + fr, col0 = u.pn * BM + wc * 32 + 8 * fq;
#pragma unroll
        for (int ai = 0; ai < 2; ++ai) {
            u32x4 r[4][2];
#pragma unroll
            for (int m = 0; m < 4; ++m)
#pragma unroll
                for (int bj = 0; bj < 2; ++bj) r[m][bj] = *(const u32x4*)(X + (size_t)(row0 + ai * HALF + m * 16) * ldc + col0 + bj * HALF);
#pragma unroll
            for (int m = 0; m < 4; ++m)
#pragma unroll
                for (int bj = 0; bj < 2; ++bj) asm volatile("" : "+v"(r[m][bj]));
#pragma unroll
            for (int m = 0; m < 4; ++m) { bf16_t* xp = X + (size_t)(row0 + ai * HALF + m * 16) * ldc + col0;
#pragma unroll
                for (int bj = 0; bj < 2; ++bj) { const u32x4 rr = r[m][bj];
                    const f32x4 a0 = acc[ai][bj][m][0] * accscale, a1 = acc[ai][bj][m][1] * accscale;
                    u32x4 w;
                    w.x = cvt_pk_bf16(__uint_as_float(rr.x << 16) + a0[0], __uint_as_float(rr.x & 0xffff0000u) + a0[1]);
                    w.y = cvt_pk_bf16(__uint_as_float(rr.y << 16) + a0[2], __uint_as_float(rr.y & 0xffff0000u) + a0[3]);
                    w.z = cvt_pk_bf16(__uint_as_float(rr.z << 16) + a1[0], __uint_as_float(rr.z & 0xffff0000u) + a1[1]);
                    w.w = cvt_pk_bf16(__uint_as_float(rr.w << 16) + a1[2], __uint_as_float(rr.w & 0xffff0000u) + a1[3]);
                    *(u32x4*)(xp + bj * HALF) = w; } } }
    }
};
struct EpiInProj {
    static constexpr bool PERM = true;
    const LAS float* rstab; const LAS f32x2* cstab;
    float* ssq; float* sskv; bf16_t* AMLA; bf16_t* KR;
    bf16_t* qB; bf16_t* kB; bf16_t* vB; bf16_t* qC; bf16_t* kC; bf16_t* vC; bf16_t* qD; bf16_t* kD; bf16_t* vD;
    const float* g_dil; const float* g_gqa; const float* g_diff;
    __device__ __forceinline__ void operator()(const f32x4 (&acc)[2][2][4][2], const GUnit& u, int wr, int wc, int fr, int fq) const {
        const int pn = u.pn;
        int kind = 0, hh = wc, nh = 4; bf16_t* base = vB; const float* g = g_dil; float scale = 1.f;
        if (pn == 0) kind = 4; else if (pn == 1) kind = 5;
        else if (pn == 2) { kind = 1; base = qB; g = g_dil; scale = 0.125f * LOG2E; }
        else if (pn == 3) { kind = 1; base = kB; g = g_dil + 64; }
        else if (pn == 4) { kind = 0; base = vB; }
        else if (pn == 5) { kind = 2; base = qC; g = g_gqa; scale = 0.125f * LOG2E; }
        else if (pn == 6) { nh = 2; if (wc < 2) { kind = 2; base = kC; g = g_gqa + 64; } else { kind = 0; hh = wc - 2; base = vC; } }
        else if (pn == 7) { kind = 3; base = qD; g = g_diff; scale = 0.17677669529663687f * LOG2E; }
        else if (pn == 8) { kind = 3; base = kD; g = g_diff + 32; }
        else { kind = 0; base = vD; }
        float gn[2][8];
#pragma unroll
        for (int bj = 0; bj < 2; ++bj)
#pragma unroll
            for (int e = 0; e < 8; ++e) gn[bj][e] = kind == 1 ? g[32 * bj + 8 * fq + e] : (kind == 2 ? g[32 * bj + 16 * (e >> 2) + 4 * fq + (e & 3)] : (kind == 3 ? g[8 * fq + e] : 1.0f));
        const LAS float* rsp = rstab + u.ord * 256 + wr * 64 + fr;
#pragma unroll
        for (int ai = 0; ai < 2; ++ai)
#pragma unroll
            for (int m = 0; m < 4; ++m) {
                const int lrow = ai * HALF + wr * 64 + m * 16 + fr, row = u.pm * BM + lrow, b = row >> 11, sq = row & 2047;
                const float rs = rsp[ai * HALF + m * 16];
                float v[2][8];
#pragma unroll
                for (int bj = 0; bj < 2; ++bj)
#pragma unroll
                    for (int n = 0; n < 2; ++n)
#pragma unroll
                        for (int jj = 0; jj < 4; ++jj) v[bj][4 * n + jj] = acc[ai][bj][m][n][jj] * rs;
                float q0 = 0.f, q1 = 0.f;
#pragma unroll
                for (int e = 0; e < 8; ++e) { q0 += v[0][e] * v[0][e]; q1 += v[1][e] * v[1][e]; }
                q0 += __shfl_xor(q0, 16); q0 += __shfl_xor(q0, 32); q1 += __shfl_xor(q1, 16); q1 += __shfl_xor(q1, 32);
                if (kind == 4) {
                    store8(AMLA + (size_t)row * 384 + 32 * wc + 8 * fq, v[0]); store8(AMLA + (size_t)row * 384 + 128 + 32 * wc + 8 * fq, v[1]);
                    if (fq == 0) ssq[(size_t)row * 4 + wc] = q0 + q1;
                } else if (kind == 5) {
                    store8(AMLA + (size_t)row * 384 + 256 + 32 * wc + 8 * fq, v[0]);
                    if (fq == 0) sskv[(size_t)row * 4 + wc] = q0;
                    if (wc == 0) store8(KR + (size_t)row * 32 + 8 * fq, v[1]);
                } else {
                    bf16_t* dst = base + ((size_t)(b * nh + hh) * S + sq) * 64;
                    if (kind == 1) { const float r64 = rsqrtf((q0 + q1) * (1.0f / 64.0f) + EPS) * scale;
#pragma unroll
                        for (int bj = 0; bj < 2; ++bj)
#pragma unroll
                            for (int e = 0; e < 8; ++e) v[bj][e] *= r64 * gn[bj][e];
                    } else if (kind == 3) { const float r0 = rsqrtf(q0 * (1.0f / 32.0f) + EPS) * scale, r1 = rsqrtf(q1 * (1.0f / 32.0f) + EPS) * scale;
#pragma unroll
                        for (int e = 0; e < 8; ++e) { v[0][e] *= r0 * gn[0][e]; v[1][e] *= r1 * gn[1][e]; }
                    } else if (kind == 2) { const float r64 = rsqrtf((q0 + q1) * (1.0f / 64.0f) + EPS);
#pragma unroll
                        for (int bj = 0; bj < 2; ++bj) { const int pos = bj == 0 ? (sq >> 6) : (sq & 63);
#pragma unroll
                            for (int jj = 0; jj < 4; ++jj) { const f32x2 c = cstab[pos * 16 + 4 * fq + jj];
                                const float lo = v[bj][jj] * r64 * gn[bj][jj], hi = v[bj][4 + jj] * r64 * gn[bj][4 + jj];
                                v[bj][jj] = (lo * c[0] - hi * c[1]) * scale; v[bj][4 + jj] = (hi * c[0] + lo * c[1]) * scale; } }
                    }
                    store8(dst + 8 * fq, v[0]); store8(dst + 32 + 8 * fq, v[1]);
                }
            }
    }
};
template <class Epi, class Sched>
__device__ __forceinline__ void gemm_phase(LAS unsigned char* lds, const Sched& S, const Epi& E, const int K, const int ks, const int ldb) {
    const int tid = opaque_tid(), wid = __builtin_amdgcn_readfirstlane(tid >> 6), lane = tid & 63, wr = wid >> 2, wc = wid & 3, fr = lane & 15, fq = lane >> 4;
    const int nt = K / BK;
    int Rs[2], Cs[2]; unsigned voffB[2];
#pragma unroll
    for (int i = 0; i < 2; ++i) { int R, C; stage_rc(tid * 16 + i * 8192, R, C); Rs[i] = R; Cs[i] = C; const int Rb = Epi::PERM ? ((R & ~31) + perm32(R & 31)) : R; voffB[i] = (unsigned)(Rb * ldb + C) * 2u; }
    const size_t kstep = (size_t)(BK * 2);
    const size_t hstepB = (size_t)HALF * ldb * 2;
    const unsigned ldsw = (unsigned)wid * 1024u;
    const int aoff = lds_byte(wr * 64 + fr, fq * 8), boff = lds_byte(wc * 32 + fr, fq * 8);
#define G8_SA(b, h) (((b) * 2 + (h)) * HTB)
#define G8_SB(b, h) ((4 + (b) * 2 + (h)) * HTB)
#define G8_STAGEB(bufoff, gbase) do { _Pragma("unroll") for (int _i = 0; _i < 2; ++_i) \
        __builtin_amdgcn_global_load_lds((const unsigned*)((const char*)(gbase) + voffB[_i]), (LAS unsigned*)(lds + (bufoff) + ldsw + _i * 8192), 16, 0, 0); } while (0)
#define G8_STAGEA(bufoff, gbase, v0, v1) do { \
        __builtin_amdgcn_global_load_lds((const unsigned*)((const char*)(gbase) + (v0)), (LAS unsigned*)(lds + (bufoff) + ldsw), 16, 0, 0); \
        __builtin_amdgcn_global_load_lds((const unsigned*)((const char*)(gbase) + (v1)), (LAS unsigned*)(lds + (bufoff) + ldsw + 8192), 16, 0, 0); } while (0)
#define G8_LDA(dst, b, h) do { _Pragma("unroll") for (int m = 0; m < 4; ++m) _Pragma("unroll") for (int k = 0; k < 2; ++k) dst[m][k] = *(const LAS bf16x8*)(lds + G8_SA(b, h) + aoff + m * 2048 + k * 1024); } while (0)
#define G8_LDB(dst, b, h) do { _Pragma("unroll") for (int n = 0; n < 2; ++n) _Pragma("unroll") for (int k = 0; k < 2; ++k) dst[n][k] = *(const LAS bf16x8*)(lds + G8_SB(b, h) + boff + n * 2048 + k * 1024); } while (0)
#define G8_MMA(ai, bj, At, Bt) do { __builtin_amdgcn_s_setprio(1); _Pragma("unroll") for (int m = 0; m < 4; ++m) _Pragma("unroll") for (int n = 0; n < 2; ++n) _Pragma("unroll") for (int k = 0; k < 2; ++k) \
        acc[ai][bj][m][n] = __builtin_amdgcn_mfma_f32_16x16x32_bf16(Bt[n][k], At[m][k], acc[ai][bj][m][n], 0, 0, 0); __builtin_amdgcn_s_setprio(0); } while (0)
#define G8_WAIT_V(n) asm volatile("s_waitcnt vmcnt(" #n ")" ::: "memory")
#define G8_WAIT_L(n) asm volatile("s_waitcnt lgkmcnt(" #n ")" ::: "memory")
#define G8_BAR __builtin_amdgcn_s_barrier()
#define G8_SCHED __builtin_amdgcn_sched_barrier(0)
#define G8_BK(u, t) ((t) < ks ? (u).B + (size_t)(t) * kstep : (u).B2 + (size_t)((t) - ks) * kstep)
    GUnit cur, nxt; int ui = 0;
    if (!S.next(0, cur)) return;
    f32x4 acc[2][2][4][2];
#pragma unroll
    for (int a = 0; a < 2; ++a)
#pragma unroll
        for (int b = 0; b < 2; ++b)
#pragma unroll
            for (int m = 0; m < 4; ++m)
#pragma unroll
                for (int n = 0; n < 2; ++n) acc[a][b][m][n] = (f32x4){0.f, 0.f, 0.f, 0.f};
    bf16x8 At[4][2], B0[2][2], B1[2][2];
    unsigned ca[2][2], na[2][2];
    S.aoff(cur, Rs, Cs, ca);
    { const char* b0 = G8_BK(cur, 0); const char* b1 = G8_BK(cur, 1);
      G8_STAGEB(G8_SB(0, 0), b0); G8_STAGEA(G8_SA(0, 0), cur.A, ca[0][0], ca[0][1]); G8_STAGEB(G8_SB(0, 1), b0 + hstepB); G8_STAGEA(G8_SA(0, 1), cur.A, ca[1][0], ca[1][1]);
      if (wr == 1) G8_BAR;
      G8_WAIT_V(4); G8_BAR;
      G8_STAGEB(G8_SB(1, 0), b1); G8_STAGEA(G8_SA(1, 0), cur.A + kstep, ca[0][0], ca[0][1]); G8_STAGEB(G8_SB(1, 1), b1 + hstepB);
      G8_WAIT_V(6); G8_BAR; }
    for (;;) {
        const bool has_next = S.next(ui + 1, nxt);
        if (has_next) S.aoff(nxt, Rs, Cs, na);
        else {
#pragma unroll
            for (int h = 0; h < 2; ++h)
#pragma unroll
                for (int i = 0; i < 2; ++i) na[h][i] = ca[h][i];
            nxt = cur; }
        const bool fullm = cur.half == 0;
#pragma unroll 1
        for (int t = 0; t < nt; t += 2) {
            const bool last = (t == nt - 2);
            const char* a1 = cur.A + (size_t)(t + 1) * kstep;
            const char* a2 = last ? nxt.A : cur.A + (size_t)(t + 2) * kstep;
            const char* a3 = a2 + kstep;
            const char* b2 = last ? G8_BK(nxt, 0) : G8_BK(cur, t + 2);
            const char* b3 = last ? G8_BK(nxt, 1) : G8_BK(cur, t + 3);
            const unsigned x00 = last ? na[0][0] : ca[0][0], x01 = last ? na[0][1] : ca[0][1], x10 = last ? na[1][0] : ca[1][0], x11 = last ? na[1][1] : ca[1][1];
            G8_LDB(B0, 0, 0); G8_SCHED; G8_LDA(At, 0, 0); G8_STAGEA(G8_SA(1, 1), a1, ca[1][0], ca[1][1]);
            G8_WAIT_L(8); G8_BAR; G8_WAIT_L(0); G8_MMA(0, 0, At, B0); G8_BAR; G8_SCHED;
            G8_LDB(B1, 0, 1); G8_STAGEB(G8_SB(0, 0), b2);
            G8_BAR; G8_WAIT_L(0); G8_MMA(0, 1, At, B1); G8_BAR;
            G8_LDA(At, 0, 1); G8_STAGEA(G8_SA(0, 0), a2, x00, x01);
            G8_BAR; G8_WAIT_L(0); if (fullm) G8_MMA(1, 0, At, B0); G8_BAR; G8_SCHED;
            G8_STAGEB(G8_SB(0, 1), b2 + hstepB);
            G8_WAIT_V(6); G8_BAR; if (fullm) G8_MMA(1, 1, At, B1); G8_BAR;
            G8_LDB(B0, 1, 0); G8_SCHED; G8_LDA(At, 1, 0); G8_STAGEA(G8_SA(0, 1), a2, x10, x11);
            G8_WAIT_L(8); G8_BAR; G8_WAIT_L(0); G8_MMA(0, 0, At, B0); G8_BAR; G8_SCHED;
            G8_LDB(B1, 1, 1); G8_STAGEB(G8_SB(1, 0), b3);
            G8_BAR; G8_WAIT_L(0); G8_MMA(0, 1, At, B1); G8_BAR;
            G8_LDA(At, 1, 1); G8_STAGEA(G8_SA(1, 0), a3, x00, x01);
            G8_BAR; G8_WAIT_L(0); if (fullm) G8_MMA(1, 0, At, B0); G8_BAR; G8_SCHED;
            G8_STAGEB(G8_SB(1, 1), b3 + hstepB);
            G8_WAIT_V(6); G8_BAR; if (fullm) G8_MMA(1, 1, At, B1); G8_BAR;
        }
        E(acc, cur, wr, wc, fr, fq);
        if (!has_next) break;
#pragma unroll
        for (int a = 0; a < 2; ++a)
#pragma unroll
            for (int b = 0; b < 2; ++b)
#pragma unroll
                for (int m = 0; m < 4; ++m)
#pragma unroll
                    for (int n = 0; n < 2; ++n) acc[a][b][m][n] = (f32x4){0.f, 0.f, 0.f, 0.f};
        cur = nxt; ++ui;
#pragma unroll
        for (int h = 0; h < 2; ++h)
#pragma unroll
            for (int i = 0; i < 2; ++i) ca[h][i] = na[h][i];
    }
    G8_WAIT_V(0);
    if (wr == 0) G8_BAR;
    G8_BAR;
#undef G8_SA
#undef G8_SB
#undef G8_STAGEA
#undef G8_STAGEB
#undef G8_LDA
#undef G8_LDB
#undef G8_MMA
#undef G8_WAIT_V
#undef G8_WAIT_L
#undef G8_BAR
#undef G8_SCHED
#undef G8_BK
}

template <int MODE> struct MoeOrder {
    static constexpr int NPN = MODE == 1 ? 8 : 4;
    const LAS int* tab; const SortRec* recs; const bf16_t* A; const bf16_t* W; int G, c, layer;
    __device__ bool next(int i, GUnit& u) const {
        const int MT = __builtin_amdgcn_readfirstlane(tab[24]);
        int rt, pn;
        if ((G & 7) == 0) { const int x = c & 7, j = c >> 3, Gx = G >> 3, rt0 = (x * MT) >> 3, rt1 = ((x + 1) * MT) >> 3, q = i * Gx + j;
            rt = rt0 + q / NPN; pn = q % NPN; if (rt >= rt1) return false; }
        else { const int L = i * G + c; rt = L / NPN; pn = L % NPN; if (rt >= MT) return false; }
        const int ent = __builtin_amdgcn_readfirstlane(tab[512 + rt]);
        rt = ent & 0xffff; u.half = ent >> 16;
        int k = 0;
        for (int j = 1; j < 24; ++j) if (rt >= tab[j]) k = j;
        k = __builtin_amdgcn_readfirstlane(k);
        const int g = k / 6, pi = k % 6;
        const int a = pi < 3 ? 0 : (pi < 5 ? 1 : 2), b = pi < 3 ? pi + 1 : (pi < 5 ? pi - 1 : 3);
        const int lo = g * 4 + a, hi = g * 4 + b;
        u.ord = i; u.pm = rt; u.pn = pn; u.k = k; u.s0 = (rt - __builtin_amdgcn_readfirstlane(tab[k])) * BM; u.cnt = __builtin_amdgcn_readfirstlane(tab[32 + k]);
        if (MODE == 1) { u.A = (const char*)A; u.B = (const char*)(W + ((size_t)((layer * 16 + (pn < 4 ? lo : hi)) * 4 + (pn & 3))) * 256 * 1024); u.B2 = u.B; }
        else { u.A = (const char*)(A + (size_t)rt * BM * 1024); u.B = (const char*)(W + ((size_t)(layer * 16 + lo) * 1024 + pn * 256) * 512); u.B2 = (const char*)(W + ((size_t)(layer * 16 + hi) * 1024 + pn * 256) * 512); }
        return true;
    }
    __device__ __forceinline__ void aoff(const GUnit& u, const int (&R)[2], const int (&C)[2], unsigned (&vo)[2][2]) const {
#pragma unroll
        for (int h = 0; h < 2; ++h)
#pragma unroll
            for (int i = 0; i < 2; ++i) {
                if (MODE == 1) { const int slot = u.s0 + h * HALF + R[i]; int tok = recs[(size_t)u.k * T + slot].tok; tok = slot < u.cnt ? tok : 0; vo[h][i] = (unsigned)(tok * 1024 + C[i]) * 2u; }
                else vo[h][i] = (unsigned)((h * HALF + R[i]) * 1024 + C[i]) * 2u; }
    }
};
struct EpiGateUp {
    static constexpr bool PERM = true;
    bf16_t* HID; const SortRec* recs;
    __device__ __forceinline__ void operator()(const f32x4 (&acc)[2][2][4][2], const GUnit& u, int wr, int wc, int fr, int fq) const {
        const SortRec* rb = recs + (size_t)u.k * T;
        float wq[2][4], rsq[2][4];
#pragma unroll
        for (int ai = 0; ai < 2; ++ai)
#pragma unroll
            for (int m = 0; m < 4; ++m) { const float* rp = (const float*)(rb + (u.s0 + ai * HALF + wr * 64 + m * 16 + fr)); wq[ai][m] = rp[u.pn < 4 ? 1 : 2]; rsq[ai][m] = rp[3]; }
#pragma unroll
        for (int ai = 0; ai < 2; ++ai)
#pragma unroll
            for (int m = 0; m < 4; ++m) asm volatile("" : "+v"(wq[ai][m]), "+v"(rsq[ai][m]));
#pragma unroll
        for (int ai = 0; ai < 2; ++ai) { if (ai == 1 && u.half) break;
#pragma unroll
            for (int m = 0; m < 4; ++m) { const int row = ai * HALF + wr * 64 + m * 16 + fr, slot = u.s0 + row;
                const float msk = slot < u.cnt ? 1.0f : 0.0f;
                const float w = wq[ai][m] * msk, rs = rsq[ai][m] * msk;
                float v[8];
#pragma unroll
                for (int n = 0; n < 2; ++n)
#pragma unroll
                    for (int j = 0; j < 4; ++j) { const float g = acc[ai][0][m][n][j] * rs, up = acc[ai][1][m][n][j] * rs;
                        v[n * 4 + j] = g * __builtin_amdgcn_rcpf(1.0f + __expf(-g)) * up * w; }
                u32x4 o; o.x = cvt_pk_bf16(v[0], v[1]); o.y = cvt_pk_bf16(v[2], v[3]); o.z = cvt_pk_bf16(v[4], v[5]); o.w = cvt_pk_bf16(v[6], v[7]);
                *(u32x4*)(HID + (size_t)(u.pm * BM + row) * 1024 + u.pn * 128 + wc * 32 + 8 * fq) = o; } }
    }
};
struct EpiScatterAdd {
    static constexpr bool PERM = true;
    bf16_t* xs; float* out; const SortRec* recs; bf16_t* dummy; float* ssx; int emit; float accscale;
    __device__ __forceinline__ void operator()(const f32x4 (&acc)[2][2][4][2], const GUnit& u, int wr, int wc, int fr, int fq) const {
        const int col0 = u.pn * BM + wc * 32 + 8 * fq;
        int tk[2][4];
#pragma unroll
        for (int ai = 0; ai < 2; ++ai)
#pragma unroll
            for (int m = 0; m < 4; ++m) tk[ai][m] = recs[(size_t)u.k * T + (u.s0 + ai * HALF + wr * 64 + m * 16 + fr)].tok;
#pragma unroll
        for (int ai = 0; ai < 2; ++ai)
#pragma unroll
            for (int m = 0; m < 4; ++m) asm volatile("" : "+v"(tk[ai][m]));
#pragma unroll
        for (int ai = 0; ai < 2; ++ai) { if (ai == 1 && u.half) break;
            u32x4 rr8[4][2];
#pragma unroll
            for (int m = 0; m < 4; ++m) { const int slot = u.s0 + ai * HALF + wr * 64 + m * 16 + fr; const bf16_t* xp = (slot < u.cnt ? xs + (size_t)tk[ai][m] * 1024 : dummy) + col0;
#pragma unroll
                for (int bj = 0; bj < 2; ++bj) rr8[m][bj] = *(const u32x4*)(xp + bj * HALF); }
#pragma unroll
            for (int m = 0; m < 4; ++m)
#pragma unroll
                for (int bj = 0; bj < 2; ++bj) asm volatile("" : "+v"(rr8[m][bj]));
#pragma unroll
            for (int m = 0; m < 4; ++m) { const int row = ai * HALF + wr * 64 + m * 16 + fr, slot = u.s0 + row; const bool real = slot < u.cnt;
                bf16_t* xp = (real ? xs + (size_t)tk[ai][m] * 1024 : dummy) + col0;
                float ss = 0.f;
#pragma unroll
                for (int bj = 0; bj < 2; ++bj) { const u32x4 r = rr8[m][bj];
                    const f32x4 a0 = acc[ai][bj][m][0] * accscale, a1 = acc[ai][bj][m][1] * accscale;
                    const f32x4 x0 = (f32x4){__uint_as_float(r.x << 16) + a0[0], __uint_as_float(r.x & 0xffff0000u) + a0[1], __uint_as_float(r.y << 16) + a0[2], __uint_as_float(r.y & 0xffff0000u) + a0[3]};
                    const f32x4 x1 = (f32x4){__uint_as_float(r.z << 16) + a1[0], __uint_as_float(r.z & 0xffff0000u) + a1[1], __uint_as_float(r.w << 16) + a1[2], __uint_as_float(r.w & 0xffff0000u) + a1[3]};
                    if (emit) {
                        u32x4 w; w.x = cvt_pk_bf16(x0[0], x0[1]); w.y = cvt_pk_bf16(x0[2], x0[3]); w.z = cvt_pk_bf16(x1[0], x1[1]); w.w = cvt_pk_bf16(x1[2], x1[3]);
                        *(u32x4*)(xp + bj * HALF) = w;
                        const float b0 = __uint_as_float(w.x << 16), b1 = __uint_as_float(w.x & 0xffff0000u), b2 = __uint_as_float(w.y << 16), b3 = __uint_as_float(w.y & 0xffff0000u);
                        const float b4 = __uint_as_float(w.z << 16), b5 = __uint_as_float(w.z & 0xffff0000u), b6 = __uint_as_float(w.w << 16), b7 = __uint_as_float(w.w & 0xffff0000u);
                        ss += ((b0 * b0 + b1 * b1) + (b2 * b2 + b3 * b3)) + ((b4 * b4 + b5 * b5) + (b6 * b6 + b7 * b7));
                    } else if (real) { float* o = out + (size_t)tk[ai][m] * 1024 + col0 + bj * HALF; *(f32x4*)o = x0; *(f32x4*)(o + 4) = x1; } }
                if (emit) { ss += __shfl_xor(ss, 16); ss += __shfl_xor(ss, 32); if (real && fq == 0) ssx[(size_t)tk[ai][m] * 16 + u.pn * 4 + wc] = ss; } } }
    }
};
__device__ __forceinline__ void moe_build_tab(LAS int* tab, const int* cnt) {
    const int tidx = opaque_tid(); const int bidx = opaque_s((int)blockIdx.x), gdim = opaque_s((int)gridDim.x); (void)bidx; (void)gdim;
    if (tidx < 24) tab[32 + tidx] = __hip_atomic_load(cnt + tidx, __ATOMIC_RELAXED, __HIP_MEMORY_SCOPE_AGENT);
    if (tidx < 8) tab[56 + tidx] = 0;
    __syncthreads();
    if (tidx == 0) { int acc = 0; for (int k = 0; k < 24; ++k) { tab[k] = acc; acc += (tab[32 + k] + BM - 1) / BM; } tab[24] = acc; }
    __syncthreads();
    const int MT = tab[24];
    int myhalf = 0;
    if (tidx < MT) { int k = 0; for (int j = 1; j < 24; ++j) if (tidx >= tab[j]) k = j;
        myhalf = (tidx == tab[k + 1] - 1 && tab[32 + k] - (tidx - tab[k]) * BM <= HALF) ? 1 : 0; tab[768 + tidx] = myhalf; }
    __syncthreads();
    if (tidx < MT) { int x = 0; for (int j = 1; j < 8; ++j) if (tidx >= ((j * MT) >> 3)) x = j;
        const int rt0 = (x * MT) >> 3, rt1 = ((x + 1) * MT) >> 3; int nf = 0, nh = 0, F = 0;
        for (int t = rt0; t < rt1; ++t) { const int h = tab[768 + t]; F += 1 - h; if (t < tidx) { nf += 1 - h; nh += h; } }
        tab[512 + (myhalf ? rt0 + F + nh : rt0 + nf)] = tidx | (myhalf << 16);
        if (tidx == rt0) tab[56 + x] = F; }
    __syncthreads();
}
}

namespace at {
typedef __bf16 bf16x8b __attribute__((ext_vector_type(8)));
typedef float f32x8 __attribute__((ext_vector_type(8)));
typedef short s16x4 __attribute__((ext_vector_type(4)));
constexpr int VROWB = 192;
template <int DQK> struct Geo { static constexpr int KROWB = DQK * 2 + 16, KTB = 64 * KROWB, VTB = 64 * VROWB, BUF = KTB + VTB; };
constexpr int BIAS_OFF = 3 * (64 * (96 * 2 + 16) + 64 * VROWB);
constexpr int LDS_BYTES = BIAS_OFF + 4096 * 4;

struct Args { const bf16_t* Q; const bf16_t* K; const bf16_t* V; bf16_t* Y; const float* bias; const float* lamvec; const float* subln_g; const float* gq; const float* gk; const float* relb; int HQ, HKV, ng; float lam_init; };

__device__ __forceinline__ bf16x8 pack8(const f32x16& p, int s2) {
    f32x8 v;
    if (s2 == 0) v = __builtin_shufflevector(p, p, 0, 1, 2, 3, 4, 5, 6, 7); else v = __builtin_shufflevector(p, p, 8, 9, 10, 11, 12, 13, 14, 15);
    return __builtin_bit_cast(bf16x8, __builtin_convertvector(v, bf16x8b));
}
__device__ __forceinline__ bf16x8 tr_pair(const LAS unsigned char* p) {
    const s16x4 lo = __builtin_amdgcn_ds_read_tr16_b64_v4i16((LAS s16x4*)p);
    const s16x4 hi = __builtin_amdgcn_ds_read_tr16_b64_v4i16((LAS s16x4*)(p + 8 * VROWB));
    return __builtin_shufflevector(lo, hi, 0, 1, 2, 3, 4, 5, 6, 7);
}

template <int KIND>
__device__ __forceinline__ void attn_unit(LAS unsigned char* lds, const Args& a, const int b, const int h, const int qblk) {
    constexpr int DQK = KIND == 0 ? 96 : 64, NS = DQK / 16, CPR = DQK / 8;
    typedef Geo<DQK> G;
    const int tid = opaque_tid(), wid = __builtin_amdgcn_readfirstlane(tid >> 6), lane = tid & 63, r = lane & 31, hh = lane >> 5;
    const int hk = h / (a.HQ / a.HKV);
    const int q0w = qblk * 256 + wid * 32;
    const bf16_t* Kg = a.K + (size_t)(b * a.HKV + hk) * S * DQK;
    const bf16_t* Vg = a.V + (size_t)(b * a.HKV + hk) * S * 64;
    bf16x8 qf[NS];
    { const bf16_t* qp = a.Q + ((size_t)(b * a.HQ + h) * S + q0w + r) * DQK + 8 * hh;
#pragma unroll
      for (int s = 0; s < NS; ++s) qf[s] = *(const bf16x8*)(qp + 16 * s); }
    const int kkey0 = tid / CPR, kcc0 = tid % CPR, kkey1 = (tid + 512) / CPR, kcc1 = (tid + 512) % CPR;
    const bool k2 = (CPR == 12) && (tid < 256);
    const int vkey = tid >> 3, vcc = tid & 7;
    const unsigned kl0 = kkey0 * G::KROWB + kcc0 * 16, kl1 = kkey1 * G::KROWB + kcc1 * 16, vl = G::KTB + vkey * VROWB + vcc * 16;
    const bf16_t* kg0 = Kg + (size_t)kkey0 * DQK + kcc0 * 8; const bf16_t* kg1 = Kg + (size_t)kkey1 * DQK + kcc1 * 8; const bf16_t* vg = Vg + (size_t)vkey * 64 + vcc * 8;
    const unsigned ka = r * G::KROWB + hh * 16;
    const unsigned va = G::KTB + (4 * hh + ((lane & 15) >> 2)) * VROWB + (16 * ((lane >> 4) & 1) + 4 * (lane & 3)) * 2;
    LAS float* bl = (LAS float*)(lds + BIAS_OFF);
    float shift;
    { float mq = 0.f, mk = 0.f;
      for (int i = lane; i < a.ng; i += 64) { mq = fmaxf(mq, fabsf(a.gq[i])); mk = fmaxf(mk, fabsf(a.gk[i])); }
      float bm = (KIND == 2 && lane < 32) ? a.relb[lane * 8 + 4 + h] * LOG2E : 0.f;
#pragma unroll
      for (int o = 32; o >= 1; o >>= 1) { mq = fmaxf(mq, __shfl_xor(mq, o)); mk = fmaxf(mk, __shfl_xor(mk, o)); bm = fmaxf(bm, __shfl_xor(bm, o)); }
      shift = mq * mk * sqrtf((float)a.ng) * LOG2E * 1.02f + bm; }
    const float ninit = -shift;
    __syncthreads();
    if (KIND == 2) {
#pragma unroll
        for (int i = 0; i < 8; ++i) bl[tid + 512 * i] = a.bias[(size_t)h * 4096 + tid + 512 * i] - shift;
    }
    u32x4 t0, t1 = (u32x4){0u, 0u, 0u, 0u}, t2;
    { t0 = *(const u32x4*)kg0; if (k2) t1 = *(const u32x4*)kg1; t2 = *(const u32x4*)vg;
      *(LAS u32x4*)(lds + kl0) = t0; if (k2) *(LAS u32x4*)(lds + kl1) = t1; *(LAS u32x4*)(lds + vl) = t2; }
    constexpr int NT = S / 64;
    { const size_t go = 64; t0 = *(const u32x4*)(kg0 + go * DQK); if (k2) t1 = *(const u32x4*)(kg1 + go * DQK); t2 = *(const u32x4*)(vg + go * 64); }
    __syncthreads();
    f32x16 o0[2], o1[2]; float l0[4] = {0.f, 0.f, 0.f, 0.f}, l1[4] = {0.f, 0.f, 0.f, 0.f};
#pragma unroll
    for (int m = 0; m < 2; ++m)
#pragma unroll
        for (int i = 0; i < 16; ++i) { o0[m][i] = 0.f; o1[m][i] = 0.f; }
    bf16x8 kfr[NS], vfr[2][2];
    f32x16 sa0, sb0, sa1, sb1;
    auto ld_frags = [&](const bool has_next, const LAS unsigned char* kb, const int key0, f32x16& sa, f32x16& sb, const LAS unsigned char* vb) __attribute__((always_inline)) {
        if (has_next) {
#pragma unroll
            for (int s = 0; s < NS; ++s) kfr[s] = *(const LAS bf16x8*)(kb + ka + s * 32);
            if (KIND == 2) { const LAS float* bp = bl + ((key0 + 4 * hh) - (q0w + r) + 2048);
#pragma unroll
                for (int i = 0; i < 16; ++i) { const float bv = bp[(i & 3) + 8 * (i >> 2)]; sa[i] = bv; sb[i] = bv; } }
        }
#pragma unroll
        for (int s2 = 0; s2 < 2; ++s2)
#pragma unroll
            for (int m = 0; m < 2; ++m) vfr[s2][m] = tr_pair(vb + va + s2 * 16 * VROWB + m * 64);
    };
    auto qk_mma = [&](f32x16& sa, f32x16& sb) __attribute__((always_inline)) {
        if (KIND != 2) {
#pragma unroll
            for (int i = 0; i < 16; ++i) sa[i] = ninit; }
#pragma unroll
        for (int s = 0; s < NS; ++s) {
            if (KIND == 2 && s >= 2) sb = __builtin_amdgcn_mfma_f32_32x32x16_bf16(kfr[s], qf[s], sb, 0, 0, 0);
            else sa = __builtin_amdgcn_mfma_f32_32x32x16_bf16(kfr[s], qf[s], sa, 0, 0, 0);
        }
    };
    bf16x8 pa[2], pb[2];
    auto smx = [&](f32x16& sa, f32x16& sb) __attribute__((always_inline)) {
#pragma unroll
        for (int i = 0; i < 16; ++i) { sa[i] = __builtin_amdgcn_exp2f(sa[i]); l0[i & 3] += sa[i]; asm volatile("" : "+v"(l0[i & 3])); }
        pa[0] = pack8(sa, 0); pa[1] = pack8(sa, 1);
        if (KIND == 2) {
#pragma unroll
            for (int i = 0; i < 16; ++i) { sb[i] = __builtin_amdgcn_exp2f(sb[i]); l1[i & 3] += sb[i]; asm volatile("" : "+v"(l1[i & 3])); }
            pb[0] = pack8(sb, 0); pb[1] = pack8(sb, 1); }
    };
    auto pv_mma = [&]() __attribute__((always_inline)) {
#pragma unroll
        for (int s2 = 0; s2 < 2; ++s2)
#pragma unroll
            for (int m = 0; m < 2; ++m) {
                o0[m] = __builtin_amdgcn_mfma_f32_32x32x16_bf16(vfr[s2][m], pa[s2], o0[m], 0, 0, 0);
                if (KIND == 2) o1[m] = __builtin_amdgcn_mfma_f32_32x32x16_bf16(vfr[s2][m], pb[s2], o1[m], 0, 0, 0);
            }
    };
    {
#pragma unroll
      for (int s = 0; s < NS; ++s) kfr[s] = *(const LAS bf16x8*)(lds + ka + s * 32);
      if (KIND == 2) { const LAS float* bp = bl + ((4 * hh) - (q0w + r) + 2048);
#pragma unroll
          for (int i = 0; i < 16; ++i) { const float bv = bp[(i & 3) + 8 * (i >> 2)]; sa0[i] = bv; sb0[i] = bv; } }
      qk_mma(sa0, sb0); }
    unsigned cbo = 0, nbo = G::BUF;
    const bool stag = wid >= 4;
    auto tile_seam = [&](const int kt, LAS unsigned char* nb) __attribute__((always_inline)) {
        if (kt + 1 < NT) { *(LAS u32x4*)(nb + kl0) = t0; if (k2) *(LAS u32x4*)(nb + kl1) = t1; *(LAS u32x4*)(nb + vl) = t2; }
        __syncthreads();
        if (kt + 2 < NT) { const size_t go = (size_t)(kt + 2) * 64; t0 = *(const u32x4*)(kg0 + go * DQK); if (k2) t1 = *(const u32x4*)(kg1 + go * DQK); t2 = *(const u32x4*)(vg + go * 64); }
    };
#pragma unroll 1
    for (int kt = 0; kt < NT; ++kt) {
        const LAS unsigned char* cb = lds + cbo; LAS unsigned char* nb = lds + nbo;
        const bool more = kt + 1 < NT;
        ld_frags(true, cb + 32 * G::KROWB, kt * 64 + 32, sa1, sb1, cb);
        __builtin_amdgcn_sched_barrier(0);
        smx(sa0, sb0);
        __builtin_amdgcn_sched_barrier(0);
        if (stag) tile_seam(kt, nb);
        __builtin_amdgcn_sched_barrier(0);
        qk_mma(sa1, sb1); pv_mma();
        __builtin_amdgcn_sched_barrier(0);
        if (!stag) tile_seam(kt, nb);
        __builtin_amdgcn_sched_barrier(0);
        ld_frags(true, more ? (const LAS unsigned char*)nb : cb, (more ? kt + 1 : kt) * 64, sa0, sb0, cb + 32 * VROWB);
        __builtin_amdgcn_sched_barrier(0);
        smx(sa1, sb1);
        __builtin_amdgcn_sched_barrier(0);
        qk_mma(sa0, sb0); pv_mma();
        __builtin_amdgcn_sched_barrier(0);
        cbo = nbo; nbo = nbo + G::BUF; if (nbo >= 3 * G::BUF) nbo = 0;
    }
    float lt0 = (l0[0] + l0[1]) + (l0[2] + l0[3]); lt0 += __shfl_xor(lt0, 32);
    bf16_t* yp = a.Y + (size_t)(b * S + q0w + r) * 256 + h * 64 + 4 * hh;
    if (KIND != 2) {
        const float inv = 1.0f / lt0;
#pragma unroll
        for (int m = 0; m < 2; ++m)
#pragma unroll
            for (int g4 = 0; g4 < 4; ++g4) { uint2 w; w.x = pack2(o0[m][4 * g4] * inv, o0[m][4 * g4 + 1] * inv); w.y = pack2(o0[m][4 * g4 + 2] * inv, o0[m][4 * g4 + 3] * inv);
                *(uint2*)(yp + 32 * m + 8 * g4) = w; }
    } else {
        float lt1 = (l1[0] + l1[1]) + (l1[2] + l1[3]); lt1 += __shfl_xor(lt1, 32);
        float d01 = 0.f, d23 = 0.f;
#pragma unroll
        for (int e = 0; e < 32; ++e) { d01 += a.lamvec[e] * a.lamvec[32 + e]; d23 += a.lamvec[64 + e] * a.lamvec[96 + e]; }
        const float lam = expf(d01) - expf(d23) + a.lam_init;
        const float i0 = 1.0f / lt0, i1 = lam / lt1; float ss = 0.f;
#pragma unroll
        for (int m = 0; m < 2; ++m)
#pragma unroll
            for (int i = 0; i < 16; ++i) { const float v = o0[m][i] * i0 - o1[m][i] * i1; o0[m][i] = v; ss += v * v; }
        ss += __shfl_xor(ss, 32);
        const float rs = rsqrtf(ss * (1.0f / 64.0f) + EPS) * (1.0f - a.lam_init);
#pragma unroll
        for (int m = 0; m < 2; ++m)
#pragma unroll
            for (int g4 = 0; g4 < 4; ++g4) { const float4 gg = *(const float4*)(a.subln_g + 32 * m + 8 * g4 + 4 * hh);
                uint2 w; w.x = pack2(o0[m][4 * g4] * rs * gg.x, o0[m][4 * g4 + 1] * rs * gg.y); w.y = pack2(o0[m][4 * g4 + 2] * rs * gg.z, o0[m][4 * g4 + 3] * rs * gg.w);
                *(uint2*)(yp + 32 * m + 8 * g4) = w; }
    }
}
}


namespace at {
struct DilArgs { const bf16_t* Q; const bf16_t* K; const bf16_t* V; bf16_t* YBP; float* LB; const float* bias; const float* gq; const float* gk; const float* relb; };
constexpr int DKROWB = 144, DK_BYTES = 384 * DKROWB, DV_OFF = DK_BYTES, DBT_OFF = DK_BYTES + 384 * VROWB;
static_assert(DBT_OFF + 1024 <= 128 * 1024 + 1024, "dilated LDS layout");
struct DilStage { u32x4 kv[6], vv[6]; };
__device__ __forceinline__ void dil_fetch(DilStage& st, const DilArgs& a, const int tid, const int b, const int h, const int br, const int ublk) {
    const int lgd = br * 2, nsub = S >> lgd, bh = b * 4 + h, pbase = 256 * ublk - 64;
#pragma unroll
    for (int i = 0; i < 6; ++i) { const int c = tid + 512 * i, row = c >> 3, cc = c & 7; int pk = pbase + row; pk = pk < 0 ? 0 : (pk >= S ? S - 1 : pk);
        const int rho = pk >> (11 - lgd), lk = pk & (nsub - 1), t = (lk << lgd) + rho;
        st.kv[i] = *(const u32x4*)(a.K + ((size_t)bh * S + t) * 64 + cc * 8); st.vv[i] = *(const u32x4*)(a.V + ((size_t)bh * S + t) * 64 + cc * 8); }
}
__device__ __forceinline__ void dil_unit(LAS unsigned char* lds, const DilArgs& a, DilStage& st, const int b, const int h, const int br, const int ublk,
                                         const bool has_next, const int nb_, const int nh_, const int nbr_, const int nublk_) {
    const int tid = opaque_tid(), wid = __builtin_amdgcn_readfirstlane(tid >> 6), lane = tid & 63, r = lane & 31, hh = lane >> 5;
    const int lgd = br * 2, d = 1 << lgd, nsub = S >> lgd;
    const int bh = b * 4 + h;
    float shift;
    { float mq = 0.f, mk = 0.f;
      { mq = fabsf(a.gq[lane]); mk = fabsf(a.gk[lane]); }
      float bm = lane < 32 ? a.relb[lane * 8 + h] * LOG2E : 0.f;
#pragma unroll
      for (int o = 32; o >= 1; o >>= 1) { mq = fmaxf(mq, __shfl_xor(mq, o)); mk = fmaxf(mk, __shfl_xor(mk, o)); bm = fmaxf(bm, __shfl_xor(bm, o)); }
      shift = mq * mk * 8.0f * LOG2E * 1.02f + bm; }
    LAS float* bt = (LAS float*)(lds + DBT_OFF);
    __syncthreads();
    if (tid < 256) { const int jj = tid - 128; bt[tid] = (jj >= -64 && jj <= 64) ? a.bias[(size_t)h * 4096 + jj * d + 2048] - shift : -1.0e30f; }
#pragma unroll
    for (int i = 0; i < 6; ++i) { const int c = tid + 512 * i, row = c >> 3, cc = c & 7;
        *(LAS u32x4*)(lds + row * DKROWB + cc * 16) = st.kv[i]; *(LAS u32x4*)(lds + DV_OFF + row * VROWB + cc * 16) = st.vv[i]; }
    const int pi0 = 256 * ublk + 32 * wid, rho = pi0 >> (11 - lgd), l0 = pi0 & (nsub - 1);
    const int tq = ((l0 + r) << lgd) + rho;
    bf16x8 qf[4];
    { const bf16_t* qp = a.Q + ((size_t)bh * S + tq) * 64 + 8 * hh;
#pragma unroll
      for (int s = 0; s < 4; ++s) qf[s] = *(const bf16x8*)(qp + 16 * s); }
    __syncthreads();
    if (has_next) dil_fetch(st, a, tid, nb_, nh_, nbr_, nublk_);
    f32x16 o[2]; float l4[4] = {0.f, 0.f, 0.f, 0.f};
#pragma unroll
    for (int m = 0; m < 2; ++m)
#pragma unroll
        for (int i = 0; i < 16; ++i) o[m][i] = 0.f;
    const unsigned ka = (32 * wid + r) * DKROWB + hh * 16;
    const unsigned va = DV_OFF + (32 * wid + 4 * hh + ((lane & 15) >> 2)) * VROWB + (16 * ((lane >> 4) & 1) + 4 * (lane & 3)) * 2;
#pragma unroll
    for (int c = 0; c < 5; ++c) {
        const int lt = l0 + 32 * (c - 2);
        if (lt >= 0 && lt < nsub) {
            f32x16 sa;
            const LAS float* bp = bt + (32 * (c - 2) + 4 * hh - r + 128);
#pragma unroll
            for (int i = 0; i < 16; ++i) sa[i] = bp[(i & 3) + 8 * (i >> 2)];
#pragma unroll
            for (int s = 0; s < 4; ++s) { const bf16x8 kf = *(const LAS bf16x8*)(lds + ka + c * 32 * DKROWB + s * 32); sa = __builtin_amdgcn_mfma_f32_32x32x16_bf16(kf, qf[s], sa, 0, 0, 0); }
#pragma unroll
            for (int i = 0; i < 16; ++i) { sa[i] = __builtin_amdgcn_exp2f(sa[i]); l4[i & 3] += sa[i]; asm volatile("" : "+v"(l4[i & 3])); }
#pragma unroll
            for (int s2 = 0; s2 < 2; ++s2) { const bf16x8 pa = pack8(sa, s2);
#pragma unroll
                for (int m = 0; m < 2; ++m) { const bf16x8 vf = tr_pair(lds + va + c * 32 * VROWB + s2 * 16 * VROWB + m * 64); o[m] = __builtin_amdgcn_mfma_f32_32x32x16_bf16(vf, pa, o[m], 0, 0, 0); } }
        }
    }
    float lt0 = (l4[0] + l4[1]) + (l4[2] + l4[3]); lt0 += __shfl_xor(lt0, 32);
    const float inv = 1.0f / lt0;
    const int t = b * S + tq;
    bf16_t* yp = a.YBP + (size_t)br * T * 256 + (size_t)t * 256 + h * 64 + 4 * hh;
#pragma unroll
    for (int m = 0; m < 2; ++m)
#pragma unroll
        for (int g4 = 0; g4 < 4; ++g4) { uint2 w; w.x = pack2(o[m][4 * g4] * inv, o[m][4 * g4 + 1] * inv); w.y = pack2(o[m][4 * g4 + 2] * inv, o[m][4 * g4 + 3] * inv);
            *(uint2*)(yp + 32 * m + 8 * g4) = w; }
    if (hh == 0) a.LB[(size_t)br * T * 4 + (size_t)t * 4 + h] = lt0;
}
}

typedef const __attribute__((address_space(4))) Params* KParams;
__device__ __forceinline__ KParams kparams() { KParams k = (KParams)__builtin_amdgcn_kernarg_segment_ptr(); asm volatile("" : "+s"(k)); return k; }
constexpr int RSTAB_OFF = 128 * 1024 + 2048, CSTAB_OFF = RSTAB_OFF + 8192;
constexpr int LDS_TOTAL = CSTAB_OFF + 8192;
constexpr int NPHASE_LAYER = 11;
__device__ __forceinline__ Params load_params(KParams k) { Params p; p.x = k->x; p.rel_bias = k->rel_bias; p.norm1_g = k->norm1_g; p.w_in = k->w_in; p.mla_q_norm_g = k->mla_q_norm_g; p.mla_kv_norm_g = k->mla_kv_norm_g; p.mla_w_uq = k->mla_w_uq; p.mla_w_ukv = k->mla_w_ukv; p.mla_qk_g = k->mla_qk_g; p.dil_qk_g = k->dil_qk_g; p.gqa_qk_g = k->gqa_qk_g; p.diff_qk_g = k->diff_qk_g; p.diff_lambda = k->diff_lambda; p.diff_subln_g = k->diff_subln_g; p.mix_beta = k->mix_beta; p.w_out = k->w_out; p.norm2_g = k->norm2_g; p.rg_w = k->rg_w; p.rg_b = k->rg_b; p.re_w = k->re_w; p.re_b = k->re_b; p.w_gate = k->w_gate; p.w_up = k->w_up; p.w_down = k->w_down; p.out = k->out; p.ws = k->ws; return p; }
template <int PH> __device__ __forceinline__ void run_phase(const int layer, LAS unsigned char* lds, const bool dup = false) {
    const Params p = load_params(kparams());
    const int bidx = opaque_s((int)blockIdx.x), gdim = opaque_s((int)gridDim.x); (void)bidx; (void)gdim;
    unsigned char* ws = p.ws;
    const float* xin = layer == 0 ? p.x : p.out;
    if constexpr (PH == 0) {
        ph_prep_tables(p);
        ph_xcast(p);
        ph_prep_layer0(p, (LAS float*)lds);
    } else if constexpr (PH == 2) {
        g8::DenseOrder Sd; Sd.init((const bf16_t*)(ws + OFF_HN), 1024, (const bf16_t*)(ws + OFF_WIN) + (size_t)layer * NPROJ * 1024, 1024, T, NPROJ, gdim, bidx);
        LAS float* rstab = (LAS float*)(lds + RSTAB_OFF); LAS f32x2* cstab = (LAS f32x2*)(lds + CSTAB_OFF);
        { const int tidx = opaque_tid(); const float* ssx = (const float*)(ws + OFF_SSX); const float2* CS = (const float2*)(ws + OFF_CS);
          for (int i = tidx; i < 1024; i += 512) { const float2 c = CS[i]; cstab[i] = (f32x2){c.x, c.y}; }
          { const int half = tidx >> 8, rl = tidx & 255; f32x4 sv[4][4]; int okm = 0;
#pragma unroll
            for (int k = 0; k < 4; ++k) { g8::GUnit u; const bool ok = Sd.next(2 * k + half, u); const int pm = ok ? u.pm : 0; okm |= ok ? (1 << k) : 0;
                const f32x4* sp = (const f32x4*)(ssx + (size_t)(pm * 256 + rl) * 16); sv[k][0] = sp[0]; sv[k][1] = sp[1]; sv[k][2] = sp[2]; sv[k][3] = sp[3]; }
#pragma unroll
            for (int k = 0; k < 4; ++k) if (okm & (1 << k)) { const f32x4 s0 = sv[k][0], s1 = sv[k][1], s2 = sv[k][2], s3 = sv[k][3];
                const float tot = ((s0[0] + s0[1]) + (s0[2] + s0[3])) + ((s1[0] + s1[1]) + (s1[2] + s1[3])) + ((s2[0] + s2[1]) + (s2[2] + s2[3])) + ((s3[0] + s3[1]) + (s3[2] + s3[3]));
                rstab[(2 * k + half) * 256 + rl] = rsqrtf(tot * (1.0f / 1024.0f) + EPS); } }
          __syncthreads(); }
        g8::EpiInProj E; E.rstab = rstab; E.cstab = cstab; E.ssq = (float*)(ws + OFF_SSQ); E.sskv = (float*)(ws + OFF_SSKV); E.AMLA = (bf16_t*)(ws + OFF_AMLA); E.KR = (bf16_t*)(ws + OFF_KR);
        E.qB = (bf16_t*)(ws + OFF_QB); E.kB = (bf16_t*)(ws + OFF_KB); E.vB = (bf16_t*)(ws + OFF_VB); E.qC = (bf16_t*)(ws + OFF_QC); E.kC = (bf16_t*)(ws + OFF_KC); E.vC = (bf16_t*)(ws + OFF_VC);
        E.qD = (bf16_t*)(ws + OFF_QD); E.kD = (bf16_t*)(ws + OFF_KD); E.vD = (bf16_t*)(ws + OFF_VD);
        E.g_dil = p.dil_qk_g + layer * 128; E.g_gqa = p.gqa_qk_g + layer * 128; E.g_diff = p.diff_qk_g + layer * 64;
        g8::gemm_phase<g8::EpiInProj, g8::DenseOrder>(lds, Sd, E, 1024, 16, 1024);
    } else if constexpr (PH == 4) {
        ph_mla_up(p, layer, lds);
    } else if constexpr (PH == 6) {
        const float* bias = (const float*)(ws + OFF_BIAS);
        at::Args aD{}; aD.Q = (const bf16_t*)(ws + OFF_QD); aD.K = (const bf16_t*)(ws + OFF_KD); aD.V = (const bf16_t*)(ws + OFF_VD); aD.Y = (bf16_t*)(ws + OFF_YD);
        aD.gq = p.diff_qk_g + layer * 64; aD.gk = aD.gq + 32; aD.ng = 32; aD.HQ = 4; aD.HKV = 4; aD.bias = bias + 4 * 4096; aD.relb = p.rel_bias;
        aD.lamvec = p.diff_lambda + layer * 128; aD.lam_init = lambda_init_of(layer); aD.subln_g = p.diff_subln_g + layer * 64;
        at::Args aA{}; aA.Q = (const bf16_t*)(ws + OFF_QA); aA.K = (const bf16_t*)(ws + OFF_KA); aA.V = (const bf16_t*)(ws + OFF_VA); aA.Y = (bf16_t*)(ws + OFF_YA);
        aA.gq = p.mla_qk_g + layer * 192; aA.gk = aA.gq + 96; aA.ng = 96; aA.HQ = 4; aA.HKV = 4;
        at::Args aC{}; aC.Q = (const bf16_t*)(ws + OFF_QC); aC.K = (const bf16_t*)(ws + OFF_KC); aC.V = (const bf16_t*)(ws + OFF_VC); aC.Y = (bf16_t*)(ws + OFF_YC);
        aC.gq = p.gqa_qk_g + layer * 128; aC.gk = aC.gq + 64; aC.ng = 64; aC.HQ = 4; aC.HKV = 2;
        at::DilArgs aB{}; aB.Q = (const bf16_t*)(ws + OFF_QB); aB.K = (const bf16_t*)(ws + OFF_KB); aB.V = (const bf16_t*)(ws + OFF_VB); aB.YBP = (bf16_t*)(ws + OFF_YBP); aB.LB = (float*)(ws + OFF_LB);
        aB.bias = bias; aB.gq = p.dil_qk_g + layer * 128; aB.gk = aB.gq + 64; aB.relb = p.rel_bias;
        const int kinds = dup ? ATT_DUP_KINDS : 15;
        auto remap = [&](const int u) { if (gdim != 256) return u; const int i = u >> 8, c = u & 255, x = c & 7, sl = c >> 3; return ((x * 8 + i * 4 + (sl >> 3)) << 3) | (sl & 7); };
        if (kinds & 1) for (int u0 = bidx; u0 < 512; u0 += gdim) { const int u = remap(u0); at::attn_unit<2>(lds, aD, u >> 5, (u >> 3) & 3, u & 7); }
        if (kinds & 2) for (int u0 = bidx; u0 < 512; u0 += gdim) { const int u = remap(u0); at::attn_unit<0>(lds, aA, u >> 5, (u >> 3) & 3, u & 7); }
        if (kinds & 4) for (int u0 = bidx; u0 < 512; u0 += gdim) { const int u = remap(u0); at::attn_unit<1>(lds, aC, u >> 5, (u >> 3) & 3, u & 7); }
        if (kinds & 8) { at::DilStage st; const int tid0 = opaque_tid();
            if (bidx < 1536) at::dil_fetch(st, aB, tid0, bidx / 96, (bidx / 24) & 3, (bidx >> 3) % 3, bidx & 7);
            for (int u = bidx; u < 1536; u += gdim) { const int un = u + gdim; const bool hn = un < 1536;
                at::dil_unit(lds, aB, st, u / 96, (u / 24) & 3, (u >> 3) % 3, u & 7, hn, un / 96, (un / 24) & 3, (un >> 3) % 3, un & 7); } }
    } else if constexpr (PH == 7) {
        ph_mix(p, layer);
    } else if constexpr (PH == 8) {
        g8::EpiResidBf16 E; E.X = (bf16_t*)(ws + OFF_HN); E.ldc = 1024; E.accscale = dup ? 0.f : 1.f;
        g8::DenseOrder Sd; Sd.init((const bf16_t*)(ws + OFF_MIX), 1024, (const bf16_t*)(ws + OFF_WOUT) + (size_t)layer * 1024 * 1024, 1024, T, 1024, gdim, bidx);
        g8::gemm_phase<g8::EpiResidBf16, g8::DenseOrder>(lds, Sd, E, 1024, 16, 1024);
    } else if constexpr (PH == 9) {
        ph_norm2_route(p, layer, (LAS float*)lds, dup);
    } else if constexpr (PH == 10 || PH == 11) {
        constexpr int MODE = PH == 10 ? 1 : 2;
        LAS int* tab = (LAS int*)(lds + g8::STAGE_BYTES);
        g8::moe_build_tab(tab, (const int*)(ws + OFF_CNT) + layer * 32);
        g8::MoeOrder<MODE> Sm; Sm.tab = tab; Sm.recs = (const SortRec*)(ws + OFF_PERM); Sm.G = gdim; Sm.c = bidx; Sm.layer = layer;
        if constexpr (MODE == 1) { Sm.A = (const bf16_t*)(ws + OFF_HN); Sm.W = (const bf16_t*)(ws + OFF_WGU);
            g8::EpiGateUp E; E.HID = (bf16_t*)(ws + OFF_HID); E.recs = Sm.recs;
            g8::gemm_phase<g8::EpiGateUp, g8::MoeOrder<MODE>>(lds, Sm, E, 1024, 16, 1024);
            if (layer == 0 && !dup) {
                int mine = 0, most = 0; { g8::GUnit uu; int n = 0; while (Sm.next(n, uu)) { mine += 2 - uu.half; ++n; } const int MT = tab[24], Gx = gdim >> 3;
                    for (int x = 0; x < 8; ++x) { const int nt_ = (((x + 1) * MT) >> 3) - ((x * MT) >> 3), nf = tab[56 + x] * 8, na = nt_ * 8; const int c2 = (nf + Gx - 1) / Gx + (na + Gx - 1) / Gx; most = c2 > most ? c2 : most; } }
                if (mine < most) prep_queue(p, 7 * (most - mine), (LAS float*)lds, (LAS int*)(lds + 64 * 1024)); }
        } else { Sm.A = (const bf16_t*)(ws + OFF_HID); Sm.W = (const bf16_t*)(ws + OFF_WDT);
            g8::EpiScatterAdd E; E.xs = (bf16_t*)(ws + OFF_HN); E.out = p.out; E.recs = Sm.recs; E.dummy = (bf16_t*)(ws + OFF_DUMMY); E.ssx = (float*)(ws + OFF_SSX); E.emit = layer + 1 < NL ? 1 : 0; E.accscale = dup ? 0.f : 1.f;
            g8::gemm_phase<g8::EpiScatterAdd, g8::MoeOrder<MODE>>(lds, Sm, E, 1024, 8, 512);
            if (layer == 0 && !dup) prep_queue(p, -1, (LAS float*)lds, (LAS int*)(lds + 64 * 1024));
        }
    }
}

#ifndef MK_FUSED
#define MK_FUSED 1
#endif
#ifndef DUP_MASK
#define DUP_MASK 0
#endif
#if MK_FUSED
__device__ __forceinline__ void grid_sync(const XcdBarrier& b0) { XcdBarrier b = b0; asm volatile("" : "+s"(b.bar), "+s"(b.x)); xcd_barrier(b); }
__global__ __launch_bounds__(512, 2) void k_mega(Params p) {
    extern __shared__ __attribute__((aligned(16))) unsigned char shm[];
    LAS unsigned char* lds = (LAS unsigned char*)shm;
    volatile LAS unsigned* xbw = (volatile LAS unsigned*)(lds + 128 * 1024 + 1024);
    if (threadIdx.x == 0) { xbw[0] = 0u; xbw[1] = 0u; }
    __syncthreads();
    XcdBarrier bar = xcd_barrier_post((unsigned*)(kparams()->ws + OFF_BAR), xbw);
    run_phase<0>(0, lds); grid_sync(bar); if constexpr ((DUP_MASK >> 0) & 1) { run_phase<0>(0, lds, true); grid_sync(bar); }
#pragma unroll 1
    for (int layer = 0; layer < NL; ++layer) {
        run_phase<2>(layer, lds); grid_sync(bar); if constexpr ((DUP_MASK >> 2) & 1) { run_phase<2>(layer, lds, true); grid_sync(bar); }
        run_phase<4>(layer, lds); grid_sync(bar); if constexpr ((DUP_MASK >> 4) & 1) { run_phase<4>(layer, lds, true); grid_sync(bar); }
        run_phase<6>(layer, lds); grid_sync(bar); if constexpr ((DUP_MASK >> 6) & 1) { run_phase<6>(layer, lds, true); grid_sync(bar); }
        run_phase<7>(layer, lds); grid_sync(bar); if constexpr ((DUP_MASK >> 7) & 1) { run_phase<7>(layer, lds, true); grid_sync(bar); }
        run_phase<8>(layer, lds); grid_sync(bar); if constexpr ((DUP_MASK >> 8) & 1) { run_phase<8>(layer, lds, true); grid_sync(bar); }
        run_phase<9>(layer, lds); grid_sync(bar); if constexpr ((DUP_MASK >> 9) & 1) { run_phase<9>(layer, lds, true); grid_sync(bar); }
        run_phase<10>(layer, lds); grid_sync(bar); if constexpr ((DUP_MASK >> 10) & 1) { run_phase<10>(layer, lds, true); grid_sync(bar); }
        run_phase<11>(layer, lds); grid_sync(bar); if constexpr ((DUP_MASK >> 11) & 1) { run_phase<11>(layer, lds, true); grid_sync(bar); }
    }
}
#else
template <int PH> __global__ __launch_bounds__(512, 2) void k_phase(Params p, int layer) {
    extern __shared__ __attribute__((aligned(16))) unsigned char shm[];
    run_phase<PH>(layer, (LAS unsigned char*)shm);
}
template <int PH> static void launch_phase(const Params& p, int layer, int grid, hipStream_t st) {
    static bool attr = false; if (!attr) { (void)hipFuncSetAttribute((const void*)k_phase<PH>, hipFuncAttributeMaxDynamicSharedMemorySize, LDS_TOTAL); attr = true; }
    hipLaunchKernelGGL((k_phase<PH>), dim3(grid), dim3(512), LDS_TOTAL, st, p, layer);
}
#endif

extern "C" void kernel_launch(void* const* d_in, const int* in_sizes, int n_in, void* d_out, int out_size, void* d_ws, size_t ws_size, hipStream_t stream) {
    Params p{};
    p.x = (const float*)d_in[0]; p.rel_bias = (const float*)d_in[1]; p.norm1_g = (const float*)d_in[2]; p.w_in = (const float*)d_in[3];
    p.mla_q_norm_g = (const float*)d_in[4]; p.mla_kv_norm_g = (const float*)d_in[5]; p.mla_w_uq = (const float*)d_in[6]; p.mla_w_ukv = (const float*)d_in[7];
    p.mla_qk_g = (const float*)d_in[8]; p.dil_qk_g = (const float*)d_in[9]; p.gqa_qk_g = (const float*)d_in[10]; p.diff_qk_g = (const float*)d_in[11];
    p.diff_lambda = (const float*)d_in[12]; p.diff_subln_g = (const float*)d_in[13]; p.mix_beta = (const float*)d_in[14]; p.w_out = (const float*)d_in[15];
    p.norm2_g = (const float*)d_in[16]; p.rg_w = (const float*)d_in[17]; p.rg_b = (const float*)d_in[18]; p.re_w = (const float*)d_in[19]; p.re_b = (const float*)d_in[20];
    p.w_gate = (const float*)d_in[21]; p.w_up = (const float*)d_in[22]; p.w_down = (const float*)d_in[23];
    p.out = (float*)d_out; p.ws = (unsigned char*)d_ws;
    static int grid = 0;
    if (!grid) {
        int dev = 0, cus = 0, per_cu = 0;
        (void)hipGetDevice(&dev);
        (void)hipDeviceGetAttribute(&cus, hipDeviceAttributeMultiprocessorCount, dev);
#if MK_FUSED
        (void)hipFuncSetAttribute((const void*)k_mega, hipFuncAttributeMaxDynamicSharedMemorySize, LDS_TOTAL);
        (void)hipOccupancyMaxActiveBlocksPerMultiprocessor(&per_cu, k_mega, 512, LDS_TOTAL);
#else
        per_cu = 1;
#endif
        if (cus <= 0) cus = 256;
        grid = per_cu >= 1 ? cus : 0;
        if (grid > 256) grid = 256;
    }
    (void)hipMemsetAsync(p.ws + OFF_BAR, 0, 64 * 1024, stream);
#if MK_FUSED
    if (grid > 0) hipLaunchKernelGGL(k_mega, dim3(grid), dim3(512), LDS_TOTAL, stream, p);
#else
    launch_phase<0>(p, 0, grid, stream);
    for (int l = 0; l < NL; ++l) {
        launch_phase<2>(p, l, grid, stream); launch_phase<4>(p, l, grid, stream);
        launch_phase<6>(p, l, grid, stream); launch_phase<7>(p, l, grid, stream); launch_phase<8>(p, l, grid, stream);
        launch_phase<9>(p, l, grid, stream); launch_phase<10>(p, l, grid, stream); launch_phase<11>(p, l, grid, stream);
    }
#endif
}
```

```cpp
#include <hip/hip_runtime.h>
#include <stdint.h>

typedef unsigned short bf16_t;
#ifndef ATT_DUP_KINDS
#define ATT_DUP_KINDS 15
#endif

constexpr int NB = 16, S = 2048, T = NB * S, DM = 1024, NL = 2;
constexpr int NPROJ = 2560;
constexpr int NIN = 2464;
constexpr float LOG2E = 1.4426950408889634f;
constexpr float EPS = 1e-6f;

constexpr size_t MiB = 1024ull * 1024ull;
constexpr size_t OFF_BAR   = 0;
constexpr size_t OFF_BIAS  = 64 * 1024;
constexpr size_t OFF_CS    = OFF_BIAS + 8 * 4096 * 4;
constexpr size_t OFF_WIN   = 1 * MiB;
constexpr size_t SZ_WIN    = (size_t)NL * NPROJ * 1024 * 2;
constexpr size_t OFF_WUP   = OFF_WIN + SZ_WIN;
constexpr size_t SZ_WUP    = (size_t)NL * 1024 * 384 * 2;
constexpr size_t OFF_WUPKV = OFF_WUP + (size_t)NL * 384 * 256 * 2;
constexpr size_t OFF_WOUT  = OFF_WUP + SZ_WUP;
constexpr size_t SZ_WOUT   = (size_t)NL * 1024 * 1024 * 2;
constexpr size_t OFF_WGU   = OFF_WOUT + SZ_WOUT;
constexpr size_t SZ_WGU    = (size_t)NL * 16 * 1024 * 1024 * 2;
constexpr size_t OFF_WDT   = OFF_WGU + SZ_WGU;
constexpr size_t SZ_WDT    = (size_t)NL * 16 * 1024 * 512 * 2;
constexpr size_t OFF_R1    = OFF_WDT + SZ_WDT;
constexpr size_t SZ_R1     = (size_t)T * 1024 * 2;
constexpr size_t OFF_R2    = OFF_R1 + SZ_R1;
constexpr size_t SZ_R2     = (size_t)T * NPROJ * 2;
constexpr size_t OFF_R5    = OFF_R2 + SZ_R2;
constexpr size_t SZ_H256   = (size_t)T * 256 * 2;
constexpr size_t OFF_QB = OFF_R5, OFF_KB = OFF_QB + SZ_H256, OFF_VB = OFF_KB + SZ_H256;
constexpr size_t OFF_QC = OFF_VB + SZ_H256, OFF_KC = OFF_QC + SZ_H256, OFF_VC = OFF_KC + SZ_H256 / 2;
constexpr size_t OFF_QD = OFF_VC + SZ_H256 / 2, OFF_KD = OFF_QD + SZ_H256, OFF_VD = OFF_KD + SZ_H256;
constexpr size_t OFF_KR    = OFF_VD + SZ_H256;
constexpr size_t OFF_ROUTE = OFF_KR + (size_t)T * 32 * 2;
constexpr size_t OFF_LB    = OFF_ROUTE + (size_t)T * 16;
constexpr size_t OFF_PERM  = OFF_LB + (size_t)3 * T * 4 * 4;
constexpr size_t OFF_SSX   = OFF_PERM + (size_t)24 * T * 16;
constexpr size_t OFF_SSQ   = OFF_SSX + (size_t)T * 16 * 4;
constexpr size_t OFF_SSKV  = OFF_SSQ + (size_t)T * 4 * 4;
constexpr size_t OFF_END   = OFF_SSKV + (size_t)T * 4 * 4;
constexpr size_t OFF_PREPQ = OFF_BAR + 24 * 1024;
constexpr size_t OFF_DUMMY = OFF_BAR + 32 * 1024;
constexpr size_t OFF_CNT   = OFF_BAR + 16 * 1024;
static_assert(OFF_END <= 512 * MiB, "workspace overflow");
constexpr size_t OFF_HN = OFF_R1;
constexpr size_t OFF_YA = OFF_R2 + 48 * MiB, OFF_YC = OFF_YA + SZ_H256, OFF_YD = OFF_YA + 2 * SZ_H256;
constexpr size_t OFF_AMLA = OFF_R2;
constexpr size_t OFF_QA = OFF_R2 + 96 * MiB;
constexpr size_t OFF_KA = OFF_QA + (size_t)T * 4 * 96 * 2;
constexpr size_t OFF_VA = OFF_KA + (size_t)T * 4 * 96 * 2;
constexpr size_t OFF_YBP = OFF_R2;
constexpr size_t OFF_MIX = OFF_R2 + 96 * MiB;
constexpr size_t OFF_HID = OFF_R2;

struct Params {
    const float* x; const float* rel_bias; const float* norm1_g; const float* w_in; const float* mla_q_norm_g; const float* mla_kv_norm_g;
    const float* mla_w_uq; const float* mla_w_ukv; const float* mla_qk_g; const float* dil_qk_g; const float* gqa_qk_g; const float* diff_qk_g;
    const float* diff_lambda; const float* diff_subln_g; const float* mix_beta; const float* w_out; const float* norm2_g;
    const float* rg_w; const float* rg_b; const float* re_w; const float* re_b; const float* w_gate; const float* w_up; const float* w_down;
    float* out; unsigned char* ws;
};

__device__ __forceinline__ float bf2f(bf16_t v) { return __uint_as_float(((unsigned)v) << 16); }
__device__ __forceinline__ bf16_t f2bf(float f) { unsigned u = __float_as_uint(f); u += 0x7fffu + ((u >> 16) & 1u); return (bf16_t)(u >> 16); }
__device__ __forceinline__ unsigned pack2(float lo, float hi) { unsigned r; asm("v_cvt_pk_bf16_f32 %0, %1, %2" : "=v"(r) : "v"(lo), "v"(hi)); return r; }
__device__ __forceinline__ void load8(const bf16_t* p, float (&x)[8]) {
    const uint4 v = *(const uint4*)p;
    x[0] = __uint_as_float(v.x << 16); x[1] = __uint_as_float(v.x & 0xffff0000u);
    x[2] = __uint_as_float(v.y << 16); x[3] = __uint_as_float(v.y & 0xffff0000u);
    x[4] = __uint_as_float(v.z << 16); x[5] = __uint_as_float(v.z & 0xffff0000u);
    x[6] = __uint_as_float(v.w << 16); x[7] = __uint_as_float(v.w & 0xffff0000u);
}
__device__ __forceinline__ void store8(bf16_t* p, const float (&x)[8]) {
    uint4 v; v.x = pack2(x[0], x[1]); v.y = pack2(x[2], x[3]); v.z = pack2(x[4], x[5]); v.w = pack2(x[6], x[7]);
    *(uint4*)p = v;
}
__device__ __forceinline__ float wave_sum(float v) {
#pragma unroll
    for (int o = 32; o >= 1; o >>= 1) v += __shfl_xor(v, o);
    return v;
}
__device__ __forceinline__ int opaque_s(int v) { asm volatile("" : "+s"(v)); return v; }
__device__ __forceinline__ int opaque_tid() { int t = threadIdx.x; asm volatile("" : "+v"(t)); return t; }
__device__ __forceinline__ float lambda_init_of(int layer) { return layer == 0 ? 0.2f : (0.8f - 0.6f * 0.7408182206817179f); }

#define LAS __attribute__((address_space(3)))
typedef short bf16x8 __attribute__((ext_vector_type(8)));
typedef float f32x4 __attribute__((ext_vector_type(4)));
typedef float f32x16 __attribute__((ext_vector_type(16)));
typedef unsigned u32x4 __attribute__((ext_vector_type(4)));
typedef float f32x2 __attribute__((ext_vector_type(2)));

#define XB_TMO      128
#define XB_XCNT(j)  (256  + 64 * (j))
#define XB_XSUB(j)  (1280 + 64 * (j))
#define XB_XGEN(j)  (2304 + 64 * (j))
#define XB_TOP      3328
#define XB_TOPGEN   3392
#define XCD_BAR_WORDS 3456
#define XB_SPIN_CAP (1u << 18)

__device__ __forceinline__ unsigned xb_ld(unsigned* p)              { return __hip_atomic_load(p, __ATOMIC_RELAXED, __HIP_MEMORY_SCOPE_AGENT); }
__device__ __forceinline__ unsigned xb_add(unsigned* p, unsigned v) { return __hip_atomic_fetch_add(p, v, __ATOMIC_RELAXED, __HIP_MEMORY_SCOPE_AGENT); }
__device__ __forceinline__ unsigned xb_xcc_id() { return (unsigned)__builtin_amdgcn_s_getreg((3 << 11) | 20) & 0xFu; }
#define XB_SPIN(cond, bar) do { unsigned _sp = 0; while (cond) { __builtin_amdgcn_s_sleep(1); \
    if ((++_sp & 255u) == 0u) { if (xb_ld(&(bar)[XB_TMO])) break; if (_sp > XB_SPIN_CAP) { atomicAdd(&(bar)[XB_TMO], 1u); break; } } } } while (0)

struct XcdBarrier {
    unsigned* bar; unsigned x;
    volatile LAS unsigned* st;
};

__device__ __forceinline__ XcdBarrier xcd_barrier_post(unsigned* bar, volatile LAS unsigned* st) {
    XcdBarrier b; b.bar = bar; b.x = xb_xcc_id(); b.st = st;
    if (threadIdx.x == 0) (void)xb_add(&bar[XB_XCNT(b.x)], 1u);
    return b;
}
__device__ __forceinline__ void xcd_barrier_complete(unsigned* bar, unsigned x, unsigned& nloc, unsigned& nx) {
    const unsigned G = gridDim.x * gridDim.y * gridDim.z;
    unsigned sum, cnt, mine, sp = 0u;
    for (;;) {
        sum = 0u; cnt = 0u; mine = 0u;
#pragma unroll
        for (unsigned j = 0; j < 16; ++j) { const unsigned c = xb_ld(&bar[XB_XCNT(j)]); sum += c; cnt += (c > 0u) ? 1u : 0u; mine = (j == x) ? c : mine; }
        if (sum == G) break;
        __builtin_amdgcn_s_sleep(1);
        if ((++sp & 255u) == 0u) { if (xb_ld(&bar[XB_TMO])) break; if (sp > XB_SPIN_CAP) { atomicAdd(&bar[XB_TMO], 1u); break; } }
    }
    nloc = mine > 0u ? mine : 1u; nx = cnt > 0u ? cnt : 1u;
}

__device__ __forceinline__ void xcd_barrier(const XcdBarrier& b) {
    asm volatile("s_waitcnt vmcnt(0)" ::: "memory");
    __syncthreads();
    if (threadIdx.x == 0) {
        unsigned* bar = b.bar;
        __builtin_amdgcn_s_waitcnt(0);
        unsigned nloc = b.st[0], nx = b.st[1];
        if (nloc == 0u) { xcd_barrier_complete(bar, b.x, nloc, nx); b.st[0] = nloc; b.st[1] = nx; }
        const unsigned old = xb_add(&bar[XB_XSUB(b.x)], 1u);
        const unsigned gen = old / nloc;
        if (old + 1u == (gen + 1u) * nloc) {
            __builtin_amdgcn_fence(__ATOMIC_RELEASE, "agent");
            asm volatile("s_waitcnt vmcnt(0)" ::: "memory");
            const unsigned og = xb_add(&bar[XB_TOP], 1u);
            const unsigned tg = og / nx;
            if (og + 1u == (tg + 1u) * nx) xb_add(&bar[XB_TOPGEN], 1u);
            else XB_SPIN(xb_ld(&bar[XB_TOPGEN]) == tg, bar);
            __builtin_amdgcn_fence(__ATOMIC_ACQUIRE, "agent");
            xb_add(&bar[XB_XGEN(b.x)], 1u);
            asm volatile("s_waitcnt vmcnt(0)" ::: "memory");
        } else {
            XB_SPIN(xb_ld(&bar[XB_XGEN(b.x)]) == gen, bar);
            __builtin_amdgcn_fence(__ATOMIC_ACQUIRE, "agent");
            asm volatile("s_waitcnt vmcnt(0)" ::: "memory");
        }
    }
    __syncthreads();
}


__device__ __forceinline__ void ph_prep_tables(const Params& p) {
    const int tidx = opaque_tid(); const int bidx = opaque_s((int)blockIdx.x), gdim = opaque_s((int)gridDim.x); (void)bidx; (void)gdim;
    float* bias = (float*)(p.ws + OFF_BIAS);
    float2* cs = (float2*)(p.ws + OFF_CS);
    for (int gid = bidx * blockDim.x + tidx; gid < 8 * 4096; gid += gdim * blockDim.x) {
        const int hh = gid >> 12, rel = (gid & 4095) - 2048;
        const int n = rel < 0 ? -rel : rel;
        int bucket;
        if (n < 8) bucket = n;
        else { const double lr = log((double)n / 8.0) / log(128.0); int large = 8 + (int)(lr * 8.0); bucket = large < 15 ? large : 15; }
        if (rel > 0) bucket += 16;
        bias[gid] = p.rel_bias[bucket * 8 + hh] * LOG2E;
        { const int pos = gid >> 4, i = gid & 15;
          const double inv = pow(10000.0, -(double)i / 16.0), ang = (double)pos * inv;
          cs[gid] = make_float2((float)cos(ang), (float)sin(ang)); }
    }
}

__device__ __forceinline__ int inproj_col(int n) {
    const int pn = n >> 8, phi = n & 255, bj = phi >> 7, wc = (phi >> 5) & 3, fq = (phi >> 3) & 3, nn = (phi >> 2) & 1, jj = phi & 3;
    const int e = 32 * bj + 8 * fq + 4 * nn + jj, L = 32 * bj + 16 * nn + 4 * fq + jj;
    switch (pn) {
        case 0: return phi;
        case 1: return phi < 128 ? 256 + phi : (phi < 160 ? 384 + (phi - 128) : -1);
        case 2: return 416 + 64 * wc + e;
        case 3: return 672 + 64 * wc + e;
        case 4: return 928 + 64 * wc + e;
        case 5: return 1184 + 64 * wc + L;
        case 6: return wc < 2 ? 1440 + 64 * wc + L : 1568 + 64 * (wc - 2) + e;
        case 7: return 1696 + 64 * wc + e;
        case 8: return 1952 + 64 * wc + e;
        default: return 2208 + 64 * wc + e;
    }
}
template <int KIND> __device__ __forceinline__ float prep_src(const Params& p, int batch, int n, int k) {
    if (KIND == 0) {
        const int oc = inproj_col(n);
        return oc < 0 ? 0.f : p.w_in[((size_t)batch * 1024 + k) * NIN + oc] * p.norm1_g[batch * 1024 + k];
    } else if (KIND == 1) {
        return p.mla_w_uq[((size_t)batch * 256 + k) * 384 + n] * p.mla_q_norm_g[batch * 256 + k];
    } else if (KIND == 2) {
        return p.w_out[((size_t)batch * 1024 + k) * 1024 + n];
    } else if (KIND == 3) {
        const int c = n >> 8, r = n & 255;
        return r < 128 ? p.w_gate[((size_t)batch * 1024 + k) * 512 + c * 128 + r] : p.w_up[((size_t)batch * 1024 + k) * 512 + c * 128 + (r - 128)];
    } else {
        return p.w_down[((size_t)batch * 512 + k) * 1024 + n];
    }
}
template <int KIND> __device__ __forceinline__ f32x4 prep_src4(const Params& p, int batch, int n, int k) {
    const f32x4 z = (f32x4){0.f, 0.f, 0.f, 0.f};
    if (KIND == 0) {
        const int oc = inproj_col(n);
        return oc < 0 ? z : *(const f32x4*)(p.w_in + ((size_t)batch * 1024 + k) * NIN + oc) * p.norm1_g[batch * 1024 + k];
    } else if (KIND == 1) {
        return *(const f32x4*)(p.mla_w_uq + ((size_t)batch * 256 + k) * 384 + n) * p.mla_q_norm_g[batch * 256 + k];
    } else if (KIND == 5) {
        return *(const f32x4*)(p.mla_w_ukv + ((size_t)batch * 128 + k) * 512 + n) * p.mla_kv_norm_g[batch * 128 + k];
    } else if (KIND == 2) {
        return *(const f32x4*)(p.w_out + ((size_t)batch * 1024 + k) * 1024 + n);
    } else if (KIND == 3) {
        const int c = n >> 8, r = n & 255;
        const float g2 = p.norm2_g[(batch >> 4) * 1024 + k];
        return (r < 128 ? *(const f32x4*)(p.w_gate + ((size_t)batch * 1024 + k) * 512 + c * 128 + r) : *(const f32x4*)(p.w_up + ((size_t)batch * 1024 + k) * 512 + c * 128 + (r - 128))) * g2;
    } else {
        return *(const f32x4*)(p.w_down + ((size_t)batch * 512 + k) * 1024 + n);
    }
}
template <int KIND> __device__ __forceinline__ void prep_tile(const Params& p, const int tidx, const int N, const int K, const int batch, const int rem, const size_t dst_off, LAS float* tile) {
    const int rn = (tidx & 31) * 4, rk = tidx >> 5;
    const int ntn = N / 128, k0 = (rem / ntn) * 64, n0 = (rem % ntn) * 128;
    f32x4 v[4];
#pragma unroll
    for (int i = 0; i < 4; ++i) v[i] = prep_src4<KIND>(p, batch, n0 + rn, k0 + rk + 16 * i);
    __syncthreads();
#pragma unroll
    for (int i = 0; i < 4; ++i)
#pragma unroll
        for (int e = 0; e < 4; ++e) tile[(rk + 16 * i) * 129 + rn + e] = v[i][e];
    __syncthreads();
    bf16_t* dst = (bf16_t*)(p.ws + dst_off) + (size_t)batch * N * K;
#pragma unroll
    for (int q = 0; q < 2; ++q) { const int c = tidx + 512 * q, wn = c >> 3, wkc = c & 7;
        float o[8];
#pragma unroll
        for (int jx = 0; jx < 8; ++jx) o[jx] = tile[(wkc * 8 + jx) * 129 + wn];
        store8(dst + (size_t)(n0 + wn) * K + k0 + wkc * 8, o); }
}
constexpr int PREP_TILES = 3540;
__device__ __forceinline__ void prep_layer_tile(const Params& p, const int tidx, const int layer, const int q, LAS float* tile) {
    if (q < 320) prep_tile<0>(p, tidx, NPROJ, 1024, layer, q, OFF_WIN, tile);
    else if (q < 332) prep_tile<1>(p, tidx, 384, 256, layer, q - 320, OFF_WUP, tile);
    else if (q < 340) prep_tile<5>(p, tidx, 512, 128, layer, q - 332, OFF_WUPKV, tile);
    else if (q < 468) prep_tile<2>(p, tidx, 1024, 1024, layer, q - 340, OFF_WOUT, tile);
    else if (q < 2516) prep_tile<3>(p, tidx, 1024, 1024, layer * 16 + ((q - 468) >> 7), (q - 468) & 127, OFF_WGU, tile);
    else prep_tile<4>(p, tidx, 1024, 512, layer * 16 + ((q - 2516) >> 6), (q - 2516) & 63, OFF_WDT, tile);
}
__device__ __forceinline__ void ph_prep_layer0(const Params& p, LAS float* tile) {
    const int tidx = opaque_tid(); const int bidx = opaque_s((int)blockIdx.x), gdim = opaque_s((int)gridDim.x);
    for (int q = bidx; q < PREP_TILES; q += gdim) prep_layer_tile(p, tidx, 0, q, tile);
}
__device__ __forceinline__ void prep_queue(const Params& p, const int budget, LAS float* tile, LAS int* slot) {
    const int tidx = opaque_tid();
    int* head = (int*)(p.ws + OFF_PREPQ);
    for (int n = 0; budget < 0 || n < budget; ++n) {
        __syncthreads();
        if (tidx == 0) *slot = atomicAdd(head, 1);
        __syncthreads();
        const int q = *slot;
        if (q >= PREP_TILES) break;
        prep_layer_tile(p, tidx, 1, q, tile);
    }
}

__device__ __forceinline__ void ph_xcast(const Params& p) {
    const int tidx = opaque_tid(); const int bidx = opaque_s((int)blockIdx.x), gdim = opaque_s((int)gridDim.x);
    const int lane = tidx & 63, wv = (bidx * blockDim.x + tidx) >> 6, nw = (gdim * blockDim.x) >> 6;
    bf16_t* xb = (bf16_t*)(p.ws + OFF_HN); float* ssx = (float*)(p.ws + OFF_SSX);
    for (int t0 = wv; t0 < T; t0 += 2 * nw) {
        float4 v[2][4];
#pragma unroll
        for (int k = 0; k < 2; ++k) { const int t = t0 + k * nw < T ? t0 + k * nw : t0;
#pragma unroll
            for (int i = 0; i < 4; ++i) v[k][i] = *(const float4*)(p.x + (size_t)t * 1024 + i * 256 + lane * 4); }
#pragma unroll
        for (int k = 0; k < 2; ++k) { const int t = t0 + k * nw; if (t < T) {
            float ss = 0.f;
#pragma unroll
            for (int i = 0; i < 4; ++i) ss += v[k][i].x * v[k][i].x + v[k][i].y * v[k][i].y + v[k][i].z * v[k][i].z + v[k][i].w * v[k][i].w;
            ss = wave_sum(ss);
#pragma unroll
            for (int i = 0; i < 4; ++i) { uint2 o; o.x = pack2(v[k][i].x, v[k][i].y); o.y = pack2(v[k][i].z, v[k][i].w); *(uint2*)(xb + (size_t)t * 1024 + i * 256 + lane * 4) = o; }
            if (lane < 16) ssx[(size_t)t * 16 + lane] = lane == 0 ? ss : 0.f; } }
    }
}

typedef float f32x4m __attribute__((ext_vector_type(4)));
__device__ __forceinline__ void ph_mla_up(const Params& p, int layer, LAS unsigned char* lds) {
    const int tidx = opaque_tid(); const int bidx = opaque_s((int)blockIdx.x), gdim = opaque_s((int)gridDim.x);
    const int wid = __builtin_amdgcn_readfirstlane(tidx >> 6), lane = tidx & 63, tk = lane & 15, kg = lane >> 4;
    unsigned char* ws = p.ws;
    const bf16_t* AMLA = (const bf16_t*)(ws + OFF_AMLA); const bf16_t* KR = (const bf16_t*)(ws + OFF_KR);
    const float* ssq = (const float*)(ws + OFF_SSQ); const float* sskv = (const float*)(ws + OFF_SSKV);
    const bf16_t* Wq = (const bf16_t*)(ws + OFF_WUP) + (size_t)layer * 384 * 256; const bf16_t* Wkv = (const bf16_t*)(ws + OFF_WUPKV) + (size_t)layer * 512 * 128;
    bf16_t* qA = (bf16_t*)(ws + OFF_QA); bf16_t* kA = (bf16_t*)(ws + OFF_KA); bf16_t* vA = (bf16_t*)(ws + OFF_VA);
    const float2* CS = (const float2*)(ws + OFF_CS);
    const float* gq = p.mla_qk_g + layer * 192; const float* gk = gq + 96;
    constexpr int QPB = 256 * 2 + 16, KPB = 128 * 2 + 16, KV_OFF = 96 * QPB;
    const float qscale = 0.10206207261596577f * LOG2E;
    LAS float* gl = (LAS float*)(lds + 88 * 1024);
    __syncthreads();
    if (tidx < 192) gl[tidx] = gq[tidx];
    __syncthreads();
    for (int grp = bidx; grp < T / 128; grp += gdim) {
        const int t = grp * 128 + wid * 16 + tk, b = t >> 11, sq = t & 2047;
        bf16x8 bq[8], bk[4];
        { const bf16_t* ap = AMLA + (size_t)t * 384 + 8 * kg;
#pragma unroll
          for (int s8 = 0; s8 < 8; ++s8) bq[s8] = *(const bf16x8*)(ap + 32 * s8);
#pragma unroll
          for (int s4 = 0; s4 < 4; ++s4) bk[s4] = *(const bf16x8*)(ap + 256 + 32 * s4); }
        const f32x4m a4 = *(const f32x4m*)(ssq + (size_t)t * 4), c4 = *(const f32x4m*)(sskv + (size_t)t * 4);
        const float rq = rsqrtf(((a4[0] + a4[1]) + (a4[2] + a4[3])) * (1.0f / 256.0f) + EPS), rk = rsqrtf(((c4[0] + c4[1]) + (c4[2] + c4[3])) * (1.0f / 128.0f) + EPS);
        float kr[2][4];
#pragma unroll
        for (int u = 0; u < 2; ++u) { const uint2 w = *(const uint2*)(KR + (size_t)t * 32 + 16 * u + 4 * kg);
            kr[u][0] = __uint_as_float(w.x << 16); kr[u][1] = __uint_as_float(w.x & 0xffff0000u); kr[u][2] = __uint_as_float(w.y << 16); kr[u][3] = __uint_as_float(w.y & 0xffff0000u); }
        float krss = 0.f;
#pragma unroll
        for (int u = 0; u < 2; ++u)
#pragma unroll
            for (int e = 0; e < 4; ++e) krss += kr[u][e] * kr[u][e];
        float2 cs[4];
#pragma unroll
        for (int e = 0; e < 4; ++e) cs[e] = CS[sq * 16 + 4 * kg + e];
        u32x4 wst[10];
#pragma unroll
        for (int i = 0; i < 6; ++i) { const int c = tidx + 512 * i; wst[i] = *(const u32x4*)(Wq + (size_t)(c >> 5) * 256 + (c & 31) * 8); }
#pragma unroll
        for (int i = 0; i < 4; ++i) { const int c = tidx + 512 * i; wst[6 + i] = *(const u32x4*)(Wkv + (size_t)(c >> 4) * 128 + (c & 15) * 8); }
#pragma unroll 1
        for (int h = 0; h < 4; ++h) {
            __syncthreads();
#pragma unroll
            for (int i = 0; i < 6; ++i) { const int c = tidx + 512 * i; *(LAS u32x4*)(lds + (c >> 5) * QPB + (c & 31) * 16) = wst[i]; }
#pragma unroll
            for (int i = 0; i < 4; ++i) { const int c = tidx + 512 * i; *(LAS u32x4*)(lds + KV_OFF + (c >> 4) * KPB + (c & 15) * 16) = wst[6 + i]; }
            __syncthreads();
            if (h < 3) {
#pragma unroll
                for (int i = 0; i < 6; ++i) { const int c = tidx + 512 * i; wst[i] = *(const u32x4*)(Wq + (size_t)(96 * (h + 1) + (c >> 5)) * 256 + (c & 31) * 8); }
#pragma unroll
                for (int i = 0; i < 4; ++i) { const int c = tidx + 512 * i; wst[6 + i] = *(const u32x4*)(Wkv + (size_t)(128 * (h + 1) + (c >> 4)) * 128 + (c & 15) * 8); } }
            const size_t orow = (size_t)(b * 4 + h) * S + sq;
            float qv[6][4]; float ss = 0.f;
#pragma unroll
            for (int mt = 0; mt < 6; ++mt) { f32x4 acc = (f32x4){0.f, 0.f, 0.f, 0.f};
#pragma unroll
                for (int s8 = 0; s8 < 8; ++s8) { const bf16x8 af = *(const LAS bf16x8*)(lds + (16 * mt + tk) * QPB + (32 * s8 + 8 * kg) * 2); acc = __builtin_amdgcn_mfma_f32_16x16x32_bf16(af, bq[s8], acc, 0, 0, 0); }
#pragma unroll
                for (int e = 0; e < 4; ++e) { qv[mt][e] = acc[e] * rq; ss += qv[mt][e] * qv[mt][e]; } }
            ss += __shfl_xor(ss, 16); ss += __shfl_xor(ss, 32);
            { const float rn = rsqrtf(ss * (1.0f / 96.0f) + EPS);
#pragma unroll
              for (int mt = 0; mt < 6; ++mt)
#pragma unroll
                  for (int e = 0; e < 4; ++e) qv[mt][e] *= rn * gl[16 * mt + 4 * kg + e];
#pragma unroll
              for (int e = 0; e < 4; ++e) { const float lo = qv[4][e], hi = qv[5][e]; qv[4][e] = lo * cs[e].x - hi * cs[e].y; qv[5][e] = hi * cs[e].x + lo * cs[e].y; }
#pragma unroll
              for (int mt = 0; mt < 6; ++mt) { uint2 w; w.x = pack2(qv[mt][0] * qscale, qv[mt][1] * qscale); w.y = pack2(qv[mt][2] * qscale, qv[mt][3] * qscale);
                  *(uint2*)(qA + orow * 96 + 16 * mt + 4 * kg) = w; } }
            float kv[8][4]; float sk = krss;
#pragma unroll
            for (int mt = 0; mt < 8; ++mt) { f32x4 acc = (f32x4){0.f, 0.f, 0.f, 0.f};
#pragma unroll
                for (int s4 = 0; s4 < 4; ++s4) { const bf16x8 af = *(const LAS bf16x8*)(lds + KV_OFF + (16 * mt + tk) * KPB + (32 * s4 + 8 * kg) * 2); acc = __builtin_amdgcn_mfma_f32_16x16x32_bf16(af, bk[s4], acc, 0, 0, 0); }
#pragma unroll
                for (int e = 0; e < 4; ++e) { kv[mt][e] = acc[e] * rk; if (mt < 4) sk += kv[mt][e] * kv[mt][e]; } }
            sk += __shfl_xor(sk, 16); sk += __shfl_xor(sk, 32);
            { const float rn = rsqrtf(sk * (1.0f / 96.0f) + EPS);
#pragma unroll
              for (int mt = 0; mt < 4; ++mt) { uint2 w;
                  w.x = pack2(kv[mt][0] * rn * gl[96 + 16 * mt + 4 * kg + 0], kv[mt][1] * rn * gl[96 + 16 * mt + 4 * kg + 1]); w.y = pack2(kv[mt][2] * rn * gl[96 + 16 * mt + 4 * kg + 2], kv[mt][3] * rn * gl[96 + 16 * mt + 4 * kg + 3]);
                  *(uint2*)(kA + orow * 96 + 16 * mt + 4 * kg) = w; }
              float lo[4], hi[4];
#pragma unroll
              for (int e = 0; e < 4; ++e) { const float a = kr[0][e] * rn * gl[96 + 64 + 4 * kg + e], bb = kr[1][e] * rn * gl[96 + 80 + 4 * kg + e]; lo[e] = a * cs[e].x - bb * cs[e].y; hi[e] = bb * cs[e].x + a * cs[e].y; }
              uint2 w; w.x = pack2(lo[0], lo[1]); w.y = pack2(lo[2], lo[3]); *(uint2*)(kA + orow * 96 + 64 + 4 * kg) = w;
              w.x = pack2(hi[0], hi[1]); w.y = pack2(hi[2], hi[3]); *(uint2*)(kA + orow * 96 + 80 + 4 * kg) = w;
#pragma unroll
              for (int mt = 4; mt < 8; ++mt) { uint2 wv; wv.x = pack2(kv[mt][0], kv[mt][1]); wv.y = pack2(kv[mt][2], kv[mt][3]); *(uint2*)(vA + orow * 64 + 16 * (mt - 4) + 4 * kg) = wv; } }
        }
    }
}

__device__ __forceinline__ void ph_mix(const Params& p, int layer) {
    const int tidx = opaque_tid(); const int bidx = opaque_s((int)blockIdx.x), gdim = opaque_s((int)gridDim.x);
    const int lane = tidx & 63, wv = (bidx * blockDim.x + tidx) >> 6, nw = (gdim * blockDim.x) >> 6;
    unsigned char* ws = p.ws;
    const bf16_t* YA = (const bf16_t*)(ws + OFF_YA); const bf16_t* YC = (const bf16_t*)(ws + OFF_YC); const bf16_t* YD = (const bf16_t*)(ws + OFF_YD);
    const bf16_t* YBP = (const bf16_t*)(ws + OFF_YBP); const float* LB = (const float*)(ws + OFF_LB);
    bf16_t* MIX = (bf16_t*)(ws + OFF_MIX);
    const float* beta = p.mix_beta + layer * 1024;
    const bool hiH = lane >= 32; const int cc = (lane & 31) * 8, hB = cc >> 6;
    float bt[2][8];
#pragma unroll
    for (int ps = 0; ps < 2; ++ps)
#pragma unroll
        for (int e = 0; e < 8; ++e) bt[ps][e] = beta[(ps * 64 + lane) * 8 + e];
    for (int t0 = wv; t0 < T; t0 += 2 * nw) {
        u32x4 v[2][2][3]; float lw[2][3];
#pragma unroll
        for (int k = 0; k < 2; ++k) { const int t = t0 + k * nw < T ? t0 + k * nw : t0;
            const bf16_t* p0a = (hiH ? YBP : YA) + (size_t)t * 256 + cc;
            const bf16_t* p0b = hiH ? YBP + (size_t)T * 256 + (size_t)t * 256 + cc : p0a; const bf16_t* p0c = hiH ? YBP + (size_t)2 * T * 256 + (size_t)t * 256 + cc : p0a;
            const bf16_t* p1a = (hiH ? YD : YC) + (size_t)t * 256 + cc;
            v[k][0][0] = *(const u32x4*)p0a; v[k][0][1] = *(const u32x4*)p0b; v[k][0][2] = *(const u32x4*)p0c; v[k][1][0] = *(const u32x4*)p1a;
#pragma unroll
            for (int br = 0; br < 3; ++br) lw[k][br] = LB[(size_t)br * T * 4 + (size_t)t * 4 + hB]; }
#pragma unroll
        for (int k = 0; k < 2; ++k) {
            const int t = t0 + k * nw; const bool ok = t < T;
#pragma unroll
            for (int ps = 0; ps < 2; ++ps) {
                float x[8];
                if (ps == 0) { const float l0 = hiH ? lw[k][0] : 1.0f, l1 = hiH ? lw[k][1] : 0.0f, l2 = hiH ? lw[k][2] : 0.0f; const float inv = 1.0f / (l0 + l1 + l2);
#pragma unroll
                    for (int w2 = 0; w2 < 4; ++w2) { const unsigned a = v[k][0][0][w2], b2 = v[k][0][1][w2], c2 = v[k][0][2][w2];
                        x[2 * w2] = (l0 * __uint_as_float(a << 16) + l1 * __uint_as_float(b2 << 16) + l2 * __uint_as_float(c2 << 16)) * inv;
                        x[2 * w2 + 1] = (l0 * __uint_as_float(a & 0xffff0000u) + l1 * __uint_as_float(b2 & 0xffff0000u) + l2 * __uint_as_float(c2 & 0xffff0000u)) * inv; }
                } else {
#pragma unroll
                    for (int w2 = 0; w2 < 4; ++w2) { const unsigned a = v[k][1][0][w2]; x[2 * w2] = __uint_as_float(a << 16); x[2 * w2 + 1] = __uint_as_float(a & 0xffff0000u); } }
                float ss = 0.f;
#pragma unroll
                for (int e = 0; e < 8; ++e) ss += x[e] * x[e];
#pragma unroll
                for (int off = 1; off <= 16; off <<= 1) ss += __shfl_xor(ss, off);
                const float rs = (ps == 1 && hiH) ? 1.0f : rsqrtf(ss * (1.0f / 256.0f) + EPS);
#pragma unroll
                for (int e = 0; e < 8; ++e) x[e] = x[e] * rs * bt[ps][e];
                if (ok) store8(MIX + (size_t)t * 1024 + (ps * 64 + lane) * 8, x);
            } }
    }
}

struct SortRec { int tok; float wlo, whi, rs; };
__device__ __forceinline__ float reduce20(const float (&v)[20], int lane) {
    float a[16];
#pragma unroll
    for (int i = 0; i < 16; ++i) { const bool up = lane & 32; const float hi = i < 4 ? v[16 + i] : 0.f; const float send = up ? v[i] : hi; const float keep = up ? hi : v[i]; a[i] = keep + __shfl_xor(send, 32); }
#pragma unroll
    for (int i = 0; i < 8; ++i) { const bool up = lane & 16; const float send = up ? a[i] : a[8 + i]; const float keep = up ? a[8 + i] : a[i]; a[i] = keep + __shfl_xor(send, 16); }
#pragma unroll
    for (int i = 0; i < 4; ++i) { const bool up = lane & 8; const float send = up ? a[i] : a[4 + i]; const float keep = up ? a[4 + i] : a[i]; a[i] = keep + __shfl_xor(send, 8); }
#pragma unroll
    for (int i = 0; i < 2; ++i) { const bool up = lane & 4; const float send = up ? a[i] : a[2 + i]; const float keep = up ? a[2 + i] : a[i]; a[i] = keep + __shfl_xor(send, 4); }
    { const bool up = lane & 2; const float send = up ? a[0] : a[1]; const float keep = up ? a[1] : a[0]; a[0] = keep + __shfl_xor(send, 2); }
    return a[0] + __shfl_xor(a[0], 1);
}
__device__ __forceinline__ void route_decide(const float (&lg)[20], const float* bg, const float* be, int& bucket, float& wlo, float& whi) {
    float gl[4]; int gi = 0;
#pragma unroll
    for (int i = 0; i < 4; ++i) gl[i] = lg[i] + bg[i];
    float gm = gl[0];
#pragma unroll
    for (int i = 1; i < 4; ++i) if (gl[i] > gm) { gm = gl[i]; gi = i; }
    float gs = 0.f;
#pragma unroll
    for (int i = 0; i < 4; ++i) gs += expf(gl[i] - gm);
    const float gw = 1.0f / gs;
    float el[4];
#pragma unroll
    for (int i = 0; i < 4; ++i) { const float v0 = lg[4 + i] + be[i], v1 = lg[8 + i] + be[4 + i], v2 = lg[12 + i] + be[8 + i], v3 = lg[16 + i] + be[12 + i];
        el[i] = gi == 0 ? v0 : (gi == 1 ? v1 : (gi == 2 ? v2 : v3)); }
    int i0 = 0; float m0 = el[0];
#pragma unroll
    for (int i = 1; i < 4; ++i) if (el[i] > m0) { m0 = el[i]; i0 = i; }
    int i1 = -1; float m1 = -3.0e38f;
#pragma unroll
    for (int i = 0; i < 4; ++i) if (i != i0 && el[i] > m1) { m1 = el[i]; i1 = i; }
    const float r = expf(m1 - m0); const float w0 = gw / (1.0f + r), w1 = gw * r / (1.0f + r);
    const int a = i0 < i1 ? i0 : i1, bq = i0 < i1 ? i1 : i0; const int pidx = a == 0 ? bq - 1 : (a == 1 ? bq + 1 : 5);
    bucket = gi * 6 + pidx; wlo = i0 < i1 ? w0 : w1; whi = i0 < i1 ? w1 : w0;
}
__device__ __forceinline__ void ph_norm2_route(const Params& p, int layer, LAS float* wl, const bool dup = false) {
    const int tidx = opaque_tid(); const int bidx = opaque_s((int)blockIdx.x), gdim = opaque_s((int)gridDim.x);
    const int wid = __builtin_amdgcn_readfirstlane(tidx >> 6), lane = tidx & 63, tk = lane & 15, kg = lane >> 4;
    const float* g = p.norm2_g + layer * 1024;
    const float* wg = p.rg_w + (size_t)layer * 1024 * 4; const float* we = p.re_w + (size_t)layer * 1024 * 16;
    const float* bg = p.rg_b + layer * 4; const float* be = p.re_b + layer * 16;
    const bf16_t* xs = (const bf16_t*)(p.ws + OFF_HN);
    LAS unsigned char* lb = (LAS unsigned char*)wl;
    constexpr int RP = 1024 * 2 + 16, WL_OFF = 20 * RP, Z_OFF = 40 * RP, AUX_OFF = 96 * 1024;
    __syncthreads();
    { f32x4 wv4[2][5]; float gd[2];
#pragma unroll
      for (int k = 0; k < 2; ++k) { const int d = tidx + 512 * k; gd[k] = g[d]; wv4[k][0] = *(const f32x4*)(wg + d * 4);
#pragma unroll
          for (int q = 0; q < 4; ++q) wv4[k][1 + q] = *(const f32x4*)(we + d * 16 + 4 * q); }
#pragma unroll
      for (int k = 0; k < 2; ++k) { const int d = tidx + 512 * k;
#pragma unroll
          for (int q = 0; q < 5; ++q)
#pragma unroll
              for (int e = 0; e < 4; ++e) { const float w = wv4[k][q][e] * gd[k]; const bf16_t hi = f2bf(w); const bf16_t lo = f2bf(w - bf2f(hi));
                  *(LAS bf16_t*)(lb + (q * 4 + e) * RP + d * 2) = hi; *(LAS bf16_t*)(lb + WL_OFF + (q * 4 + e) * RP + d * 2) = lo; } }
      if (tidx < RP / 16) { unsigned z = 0u; asm volatile("" : "+v"(z)); *(LAS u32x4*)(lb + Z_OFF + tidx * 16) = (u32x4){z, z, z, z}; } }
    __syncthreads();
    const unsigned a0h = tk * RP + kg * 16, a0l = WL_OFF + a0h;
    const unsigned a1h = (tk < 4 ? (16 + tk) * RP : Z_OFF) + kg * 16, a1l = (tk < 4 ? WL_OFF + (16 + tk) * RP : Z_OFF) + kg * 16;
    LAS int* rq = (LAS int*)(lb + AUX_OFF + 256) + wid * (64 * 5);
    int* cnt = (int*)(p.ws + OFF_CNT) + layer * 32 + (dup ? 4096 : 0); SortRec* recs = (SortRec*)(p.ws + OFF_PERM);
    int it = 0;
    for (int grp = bidx; grp < T / 128; grp += gdim, it += 16) {
        const int t = grp * 128 + wid * 16 + tk;
        const bf16_t* xp = xs + (size_t)t * 1024 + 8 * kg;
        f32x4 acc0 = (f32x4){0.f, 0.f, 0.f, 0.f}, acc1 = acc0; float ss = 0.f;
#pragma unroll 1
        for (int c8 = 0; c8 < 4; ++c8) {
            bf16x8 bf[8];
#pragma unroll
            for (int i = 0; i < 8; ++i) bf[i] = *(const bf16x8*)(xp + 32 * (8 * c8 + i));
#pragma unroll
            for (int i = 0; i < 8; ++i) { const int so = (8 * c8 + i) * 64;
                const u32x4 raw = __builtin_bit_cast(u32x4, bf[i]);
#pragma unroll
                for (int w2 = 0; w2 < 4; ++w2) { const float lo = __uint_as_float(raw[w2] << 16), hi = __uint_as_float(raw[w2] & 0xffff0000u); ss += lo * lo + hi * hi; }
                const bf16x8 ah0 = *(const LAS bf16x8*)(lb + a0h + so), al0 = *(const LAS bf16x8*)(lb + a0l + so), ah1 = *(const LAS bf16x8*)(lb + a1h + so), al1 = *(const LAS bf16x8*)(lb + a1l + so);
                acc0 = __builtin_amdgcn_mfma_f32_16x16x32_bf16(ah0, bf[i], acc0, 0, 0, 0); acc0 = __builtin_amdgcn_mfma_f32_16x16x32_bf16(al0, bf[i], acc0, 0, 0, 0);
                acc1 = __builtin_amdgcn_mfma_f32_16x16x32_bf16(ah1, bf[i], acc1, 0, 0, 0); acc1 = __builtin_amdgcn_mfma_f32_16x16x32_bf16(al1, bf[i], acc1, 0, 0, 0); }
        }
        ss += __shfl_xor(ss, 16); ss += __shfl_xor(ss, 32);
        const float rs = rsqrtf(ss * (1.0f / 1024.0f) + EPS);
        float lg[20];
#pragma unroll
        for (int r4 = 0; r4 < 4; ++r4) {
#pragma unroll
            for (int q = 0; q < 4; ++q) lg[4 * q + r4] = __shfl(acc0[r4], tk + 16 * q) * rs;
            lg[16 + r4] = __shfl(acc1[r4], tk) * rs; }
        int bk_; float wlo, whi;
        route_decide(lg, bg, be, bk_, wlo, whi);
        if (kg == 0) { LAS int* r0 = rq + ((it + tk) & 63) * 5; r0[0] = bk_; r0[1] = t; r0[2] = __float_as_int(wlo); r0[3] = __float_as_int(whi); r0[4] = __float_as_int(rs); }
        if (((it + 16) & 63) == 0) {
            const LAS int* rr = rq + lane * 5; const int b2 = rr[0]; const int slot = atomicAdd(cnt + b2, 1);
            SortRec sr; sr.tok = rr[1]; sr.wlo = __int_as_float(rr[2]); sr.whi = __int_as_float(rr[3]); sr.rs = __int_as_float(rr[4]); recs[(size_t)b2 * T + slot] = sr; }
    }
    const int npend = it & 63;
    int my_bucket = -1, my_tok = 0; float my_wlo = 0.f, my_whi = 0.f, my_rs = 0.f;
    if (lane < npend) { const LAS int* rr = rq + lane * 5; my_bucket = rr[0]; my_tok = rr[1]; my_wlo = __int_as_float(rr[2]); my_whi = __int_as_float(rr[3]); my_rs = __int_as_float(rr[4]); }
    { LAS int* hist = (LAS int*)(lb + AUX_OFF); LAS int* base = hist + 32;
      if (tidx < 32) hist[tidx] = 0;
      __syncthreads();
      int rank = 0;
      if (my_bucket >= 0) rank = __hip_atomic_fetch_add(hist + my_bucket, 1, __ATOMIC_RELAXED, __HIP_MEMORY_SCOPE_WORKGROUP);
      __syncthreads();
      if (tidx < 24) { const int c = hist[tidx]; base[tidx] = c > 0 ? atomicAdd(cnt + tidx, c) : 0; }
      __syncthreads();
      if (my_bucket >= 0) { const int slot = base[my_bucket] + rank; SortRec sr; sr.tok = my_tok; sr.wlo = my_wlo; sr.whi = my_whi; sr.rs = my_rs; recs[(size_t)my_bucket * T + slot] = sr; } }
}

namespace g8 {
constexpr int BM = 256, BK = 64, HALF = 128, HTB = HALF * BK * 2, STAGE_BYTES = 8 * HTB, NXCD = 8, WGM = 8;
__device__ __forceinline__ int lds_byte(int r, int c) { const int st = (r >> 4) * 2 + (c >> 5), rr = r & 15, cc = c & 31, ob = rr * 64 + cc * 2; return st * 1024 + (ob ^ (((ob >> 9) & 1) << 5)); }
__device__ __forceinline__ void stage_rc(int b, int& R, int& C) { const int st = b / 1024, sb = b % 1024, swz = sb ^ (((sb >> 9) & 1) << 5); R = (st >> 1) * 16 + swz / 64; C = (st & 1) * 32 + (swz % 64) / 2; }
__device__ __forceinline__ int perm32(int rho) { const int n = rho >> 4, i = rho & 15; return 8 * (i >> 2) + 4 * n + (i & 3); }
__device__ __forceinline__ unsigned cvt_pk_bf16(float lo, float hi) { unsigned r; asm volatile("v_cvt_pk_bf16_f32 %0, %1, %2" : "=v"(r) : "v"(lo), "v"(hi)); return r; }

struct GUnit { const char* A; const char* B; const char* B2; int pm, pn, k, s0, cnt, ord; };

struct DenseOrder {
    const bf16_t* A; const bf16_t* Bt; int lda, ldb, nM, nN, nwg, G, c;
    __device__ void init(const bf16_t* A_, int lda_, const bf16_t* Bt_, int ldb_, int M, int N, int G_, int c_) { A = A_; Bt = Bt_; lda = lda_; ldb = ldb_; nM = M / BM; nN = N / BM; nwg = nM * nN; G = G_; c = c_; }
    __device__ bool next(int i, GUnit& u) const {
        const long L = (long)i * G + c; if (L >= nwg) return false;
        int wgid = (int)L; { const int q = nwg / NXCD, r = nwg % NXCD, xcd = wgid % NXCD, off = wgid / NXCD; wgid = (xcd < r ? xcd * (q + 1) : r * (q + 1) + (xcd - r) * q) + off; }
        const int nig = WGM * nN, gid = wgid / nig, fm = gid * WGM, gsz = (nM - fm) < WGM ? (nM - fm) : WGM;
        u.pm = fm + ((wgid % nig) % gsz); u.pn = (wgid % nig) / gsz;
        u.A = (const char*)(A + (size_t)u.pm * BM * lda); u.B = (const char*)(Bt + (size_t)u.pn * BM * ldb); u.B2 = u.B; u.k = 0; u.s0 = 0; u.cnt = 0; u.ord = i;
        return true;
    }
    __device__ __forceinline__ void aoff(const GUnit&, const int (&R)[2], const int (&C)[2], unsigned (&vo)[2][2]) const {
#pragma unroll
        for (int h = 0; h < 2; ++h)
#pragma unroll
            for (int i = 0; i < 2; ++i) vo[h][i] = (unsigned)((h * HALF + R[i]) * lda + C[i]) * 2u;
    }
};

struct EpiResidBf16 {   static constexpr bool PF = true;
    static constexpr bool PERM = true;
    bf16_t* X; int ldc; float accscale;
    __device__ __forceinline__ void pre(const GUnit&, int, int& a, int& b) const { a = 0; b = 0; }
    __device__ __forceinline__ unsigned pf(const GUnit& u, int tid, int which, int) const {
        const bf16_t* p = X + (size_t)(u.pm * BM + which * HALF + (tid >> 2)) * ldc + u.pn * BM + (tid & 3) * 64; unsigned r;
        asm volatile("global_load_dword %0, %1, off" : "=v"(r) : "v"(p) : "memory"); return r; }
    __device__ __forceinline__ void operator()(const f32x4 (&acc)[2][2][4][2], const GUnit& u, int wr, int wc, int fr, int fq) const {
        const int row0 = u.pm * BM + wr * 64 + fr, col0 = u.pn * BM + wc * 32 + 8 * fq;
#pragma unroll
        for (int ai = 0; ai < 2; ++ai) {
            u32x4 r[4][2];
#pragma unroll
            for (int m = 0; m < 4; ++m)
#pragma unroll
                for (int bj = 0; bj < 2; ++bj) r[m][bj] = *(const u32x4*)(X + (size_t)(row0 + ai * HALF + m * 16) * ldc + col0 + bj * HALF);
#pragma unroll
            for (int m = 0; m < 4; ++m)
#pragma unroll
                for (int bj = 0; bj < 2; ++bj) asm volatile("" : "+v"(r[m][bj]));
#pragma unroll
            for (int m = 0; m < 4; ++m) { bf16_t* xp = X + (size_t)(row0 + ai * HALF + m * 16) * ldc + col0;
#pragma unroll
                for (int bj = 0; bj < 2; ++bj) { const u32x4 rr = r[m][bj];
                    const f32x4 a0 = acc[ai][bj][m][0] * accscale, a1 = acc[ai][bj][m][1] * accscale;
                    u32x4 w;
                    w.x = cvt_pk_bf16(__uint_as_float(rr.x << 16) + a0[0], __uint_as_float(rr.x & 0xffff0000u) + a0[1]);
                    w.y = cvt_pk_bf16(__uint_as_float(rr.y << 16) + a0[2], __uint_as_float(rr.y & 0xffff0000u) + a0[3]);
                    w.z = cvt_pk_bf16(__uint_as_float(rr.z << 16) + a1[0], __uint_as_float(rr.z & 0xffff0000u) + a1[1]);
                    w.w = cvt_pk_bf16(__uint_as_float(rr.w << 16) + a1[2], __uint_as_float(rr.w & 0xffff0000u) + a1[3]);
                    *(u32x4*)(xp + bj * HALF) = w; } } }
    }
};
struct EpiInProj {
    static constexpr bool PERM = true; static constexpr bool PF = false;
    const LAS float* rstab; const LAS f32x2* cstab;
    float* ssq; float* sskv; bf16_t* AMLA; bf16_t* KR;
    bf16_t* qB; bf16_t* kB; bf16_t* vB; bf16_t* qC; bf16_t* kC; bf16_t* vC; bf16_t* qD; bf16_t* kD; bf16_t* vD;
    const float* g_dil; const float* g_gqa; const float* g_diff;
    __device__ __forceinline__ void operator()(const f32x4 (&acc)[2][2][4][2], const GUnit& u, int wr, int wc, int fr, int fq) const {
        const int pn = u.pn;
        int kind = 0, hh = wc, nh = 4; bf16_t* base = vB; const float* g = g_dil; float scale = 1.f;
        if (pn == 0) kind = 4; else if (pn == 1) kind = 5;
        else if (pn == 2) { kind = 1; base = qB; g = g_dil; scale = 0.125f * LOG2E; }
        else if (pn == 3) { kind = 1; base = kB; g = g_dil + 64; }
        else if (pn == 4) { kind = 0; base = vB; }
        else if (pn == 5) { kind = 2; base = qC; g = g_gqa; scale = 0.125f * LOG2E; }
        else if (pn == 6) { nh = 2; if (wc < 2) { kind = 2; base = kC; g = g_gqa + 64; } else { kind = 0; hh = wc - 2; base = vC; } }
        else if (pn == 7) { kind = 3; base = qD; g = g_diff; scale = 0.17677669529663687f * LOG2E; }
        else if (pn == 8) { kind = 3; base = kD; g = g_diff + 32; }
        else { kind = 0; base = vD; }
        float gn[2][8];
#pragma unroll
        for (int bj = 0; bj < 2; ++bj)
#pragma unroll
            for (int e = 0; e < 8; ++e) gn[bj][e] = kind == 1 ? g[32 * bj + 8 * fq + e] : (kind == 2 ? g[32 * bj + 16 * (e >> 2) + 4 * fq + (e & 3)] : (kind == 3 ? g[8 * fq + e] : 1.0f));
        const LAS float* rsp = rstab + u.ord * 256 + wr * 64 + fr;
#pragma unroll
        for (int ai = 0; ai < 2; ++ai)
#pragma unroll
            for (int m = 0; m < 4; ++m) {
                const int lrow = ai * HALF + wr * 64 + m * 16 + fr, row = u.pm * BM + lrow, b = row >> 11, sq = row & 2047;
                const float rs = rsp[ai * HALF + m * 16];
                float v[2][8];
#pragma unroll
                for (int bj = 0; bj < 2; ++bj)
#pragma unroll
                    for (int n = 0; n < 2; ++n)
#pragma unroll
                        for (int jj = 0; jj < 4; ++jj) v[bj][4 * n + jj] = acc[ai][bj][m][n][jj] * rs;
                float q0 = 0.f, q1 = 0.f;
#pragma unroll
                for (int e = 0; e < 8; ++e) { q0 += v[0][e] * v[0][e]; q1 += v[1][e] * v[1][e]; }
                q0 += __shfl_xor(q0, 16); q0 += __shfl_xor(q0, 32); q1 += __shfl_xor(q1, 16); q1 += __shfl_xor(q1, 32);
                if (kind == 4) {
                    store8(AMLA + (size_t)row * 384 + 32 * wc + 8 * fq, v[0]); store8(AMLA + (size_t)row * 384 + 128 + 32 * wc + 8 * fq, v[1]);
                    if (fq == 0) ssq[(size_t)row * 4 + wc] = q0 + q1;
                } else if (kind == 5) {
                    store8(AMLA + (size_t)row * 384 + 256 + 32 * wc + 8 * fq, v[0]);
                    if (fq == 0) sskv[(size_t)row * 4 + wc] = q0;
                    if (wc == 0) store8(KR + (size_t)row * 32 + 8 * fq, v[1]);
                } else {
                    bf16_t* dst = base + ((size_t)(b * nh + hh) * S + sq) * 64;
                    if (kind == 1) { const float r64 = rsqrtf((q0 + q1) * (1.0f / 64.0f) + EPS) * scale;
#pragma unroll
                        for (int bj = 0; bj < 2; ++bj)
#pragma unroll
                            for (int e = 0; e < 8; ++e) v[bj][e] *= r64 * gn[bj][e];
                    } else if (kind == 3) { const float r0 = rsqrtf(q0 * (1.0f / 32.0f) + EPS) * scale, r1 = rsqrtf(q1 * (1.0f / 32.0f) + EPS) * scale;
#pragma unroll
                        for (int e = 0; e < 8; ++e) { v[0][e] *= r0 * gn[0][e]; v[1][e] *= r1 * gn[1][e]; }
                    } else if (kind == 2) { const float r64 = rsqrtf((q0 + q1) * (1.0f / 64.0f) + EPS);
#pragma unroll
                        for (int bj = 0; bj < 2; ++bj) { const int pos = bj == 0 ? (sq >> 6) : (sq & 63);
#pragma unroll
                            for (int jj = 0; jj < 4; ++jj) { const f32x2 c = cstab[pos * 16 + 4 * fq + jj];
                                const float lo = v[bj][jj] * r64 * gn[bj][jj], hi = v[bj][4 + jj] * r64 * gn[bj][4 + jj];
                                v[bj][jj] = (lo * c[0] - hi * c[1]) * scale; v[bj][4 + jj] = (hi * c[0] + lo * c[1]) * scale; } }
                    }
                    store8(dst + 8 * fq, v[0]); store8(dst + 32 + 8 * fq, v[1]);
                }
            }
    }
};
template <class Epi, class Sched>
__device__ __forceinline__ void gemm_phase(LAS unsigned char* lds, const Sched& S, const Epi& E, const int K, const int ks, const int ldb) {
    const int tid = opaque_tid(), wid = __builtin_amdgcn_readfirstlane(tid >> 6), lane = tid & 63, wr = wid >> 2, wc = wid & 3, fr = lane & 15, fq = lane >> 4;
    const int nt = K / BK;
    int Rs[2], Cs[2]; unsigned voffB[2];
#pragma unroll
    for (int i = 0; i < 2; ++i) { int R, C; stage_rc(tid * 16 + i * 8192, R, C); Rs[i] = R; Cs[i] = C; const int Rb = Epi::PERM ? ((R & ~31) + perm32(R & 31)) : R; voffB[i] = (unsigned)(Rb * ldb + C) * 2u; }
    const size_t kstep = (size_t)(BK * 2);
    const size_t hstepB = (size_t)HALF * ldb * 2;
    const unsigned ldsw = (unsigned)wid * 1024u;
    const int aoff = lds_byte(wr * 64 + fr, fq * 8), boff = lds_byte(wc * 32 + fr, fq * 8);
#define G8_SA(b, h) (((b) * 2 + (h)) * HTB)
#define G8_SB(b, h) ((4 + (b) * 2 + (h)) * HTB)
#define G8_STAGEB(bufoff, gbase) do { _Pragma("unroll") for (int _i = 0; _i < 2; ++_i) \
        __builtin_amdgcn_global_load_lds((const unsigned*)((const char*)(gbase) + voffB[_i]), (LAS unsigned*)(lds + (bufoff) + ldsw + _i * 8192), 16, 0, 0); } while (0)
#define G8_STAGEA(bufoff, gbase, v0, v1) do { \
        __builtin_amdgcn_global_load_lds((const unsigned*)((const char*)(gbase) + (v0)), (LAS unsigned*)(lds + (bufoff) + ldsw), 16, 0, 0); \
        __builtin_amdgcn_global_load_lds((const unsigned*)((const char*)(gbase) + (v1)), (LAS unsigned*)(lds + (bufoff) + ldsw + 8192), 16, 0, 0); } while (0)
#define G8_LDA(dst, b, h) do { _Pragma("unroll") for (int m = 0; m < 4; ++m) _Pragma("unroll") for (int k = 0; k < 2; ++k) dst[m][k] = *(const LAS bf16x8*)(lds + G8_SA(b, h) + aoff + m * 2048 + k * 1024); } while (0)
#define G8_LDB(dst, b, h) do { _Pragma("unroll") for (int n = 0; n < 2; ++n) _Pragma("unroll") for (int k = 0; k < 2; ++k) dst[n][k] = *(const LAS bf16x8*)(lds + G8_SB(b, h) + boff + n * 2048 + k * 1024); } while (0)
#define G8_MMA(ai, bj, At, Bt) do { __builtin_amdgcn_s_setprio(1); _Pragma("unroll") for (int m = 0; m < 4; ++m) _Pragma("unroll") for (int n = 0; n < 2; ++n) _Pragma("unroll") for (int k = 0; k < 2; ++k) \
        acc[ai][bj][m][n] = __builtin_amdgcn_mfma_f32_16x16x32_bf16(Bt[n][k], At[m][k], acc[ai][bj][m][n], 0, 0, 0); __builtin_amdgcn_s_setprio(0); } while (0)
#define G8_WAIT_V(n) asm volatile("s_waitcnt vmcnt(" #n ")" ::: "memory")
#define G8_WAIT_L(n) asm volatile("s_waitcnt lgkmcnt(" #n ")" ::: "memory")
#define G8_BAR __builtin_amdgcn_s_barrier()
#define G8_SCHED __builtin_amdgcn_sched_barrier(0)
#define G8_BK(u, t) ((t) < ks ? (u).B + (size_t)(t) * kstep : (u).B2 + (size_t)((t) - ks) * kstep)
    GUnit cur, nxt; int ui = 0;
    if (!S.next(0, cur)) return;
    f32x4 acc[2][2][4][2];
#pragma unroll
    for (int a = 0; a < 2; ++a)
#pragma unroll
        for (int b = 0; b < 2; ++b)
#pragma unroll
            for (int m = 0; m < 4; ++m)
#pragma unroll
                for (int n = 0; n < 2; ++n) acc[a][b][m][n] = (f32x4){0.f, 0.f, 0.f, 0.f};
    bf16x8 At[4][2], B0[2][2], B1[2][2];
    unsigned ca[2][2], na[2][2];
    int pfa = 0, pfb = 0; unsigned pfv0 = 0, pfv1 = 0;
    if constexpr (Epi::PF) { E.pre(cur, tid, pfa, pfb); asm volatile("" : "+v"(pfa), "+v"(pfb)); }
    S.aoff(cur, Rs, Cs, ca);
    { const char* b0 = G8_BK(cur, 0); const char* b1 = G8_BK(cur, 1);
      G8_STAGEB(G8_SB(0, 0), b0); G8_STAGEA(G8_SA(0, 0), cur.A, ca[0][0], ca[0][1]); G8_STAGEB(G8_SB(0, 1), b0 + hstepB); G8_STAGEA(G8_SA(0, 1), cur.A, ca[1][0], ca[1][1]);
      if (wr == 1) G8_BAR;
      G8_WAIT_V(4); G8_BAR;
      G8_STAGEB(G8_SB(1, 0), b1); G8_STAGEA(G8_SA(1, 0), cur.A + kstep, ca[0][0], ca[0][1]); G8_STAGEB(G8_SB(1, 1), b1 + hstepB);
      G8_WAIT_V(6); G8_BAR; }
    for (;;) {
        const bool has_next = S.next(ui + 1, nxt);
        if (has_next) S.aoff(nxt, Rs, Cs, na);
        else {
#pragma unroll
            for (int h = 0; h < 2; ++h)
#pragma unroll
                for (int i = 0; i < 2; ++i) na[h][i] = ca[h][i];
            nxt = cur; }
#pragma unroll 1
        for (int t = 0; t < nt; t += 2) {
            const bool last = (t == nt - 2);
            const char* a1 = cur.A + (size_t)(t + 1) * kstep;
            const char* a2 = last ? nxt.A : cur.A + (size_t)(t + 2) * kstep;
            const char* a3 = a2 + kstep;
            const char* b2 = last ? G8_BK(nxt, 0) : G8_BK(cur, t + 2);
            const char* b3 = last ? G8_BK(nxt, 1) : G8_BK(cur, t + 3);
            const unsigned x00 = last ? na[0][0] : ca[0][0], x01 = last ? na[0][1] : ca[0][1], x10 = last ? na[1][0] : ca[1][0], x11 = last ? na[1][1] : ca[1][1];
            G8_LDB(B0, 0, 0); G8_SCHED; G8_LDA(At, 0, 0); G8_STAGEA(G8_SA(1, 1), a1, ca[1][0], ca[1][1]);
            G8_WAIT_L(8); G8_BAR; G8_WAIT_L(0); G8_MMA(0, 0, At, B0); G8_BAR; G8_SCHED;
            G8_LDB(B1, 0, 1); G8_STAGEB(G8_SB(0, 0), b2);
            G8_BAR; G8_WAIT_L(0); G8_MMA(0, 1, At, B1); G8_BAR;
            G8_LDA(At, 0, 1); G8_STAGEA(G8_SA(0, 0), a2, x00, x01);
            G8_BAR; G8_WAIT_L(0); G8_MMA(1, 0, At, B0); G8_BAR; G8_SCHED;
            G8_STAGEB(G8_SB(0, 1), b2 + hstepB);
            G8_WAIT_V(6); G8_BAR;
            if constexpr (Epi::PF) { if (t == nt - 6) pfv0 = E.pf(cur, tid, 0, pfa); if (t == nt - 4) pfv1 = E.pf(cur, tid, 1, pfb); }
            G8_MMA(1, 1, At, B1); G8_BAR;
            G8_LDB(B0, 1, 0); G8_SCHED; G8_LDA(At, 1, 0); G8_STAGEA(G8_SA(0, 1), a2, x10, x11);
            G8_WAIT_L(8); G8_BAR; G8_WAIT_L(0); G8_MMA(0, 0, At, B0); G8_BAR; G8_SCHED;
            G8_LDB(B1, 1, 1); G8_STAGEB(G8_SB(1, 0), b3);
            G8_BAR; G8_WAIT_L(0); G8_MMA(0, 1, At, B1); G8_BAR;
            G8_LDA(At, 1, 1); G8_STAGEA(G8_SA(1, 0), a3, x00, x01);
            G8_BAR; G8_WAIT_L(0); G8_MMA(1, 0, At, B0); G8_BAR; G8_SCHED;
            G8_STAGEB(G8_SB(1, 1), b3 + hstepB);
            G8_WAIT_V(6); G8_BAR; G8_MMA(1, 1, At, B1); G8_BAR;
        }
        int nfa = 0, nfb = 0;
        if constexpr (Epi::PF) { if (has_next) E.pre(nxt, tid, nfa, nfb); }
        E(acc, cur, wr, wc, fr, fq);
        if constexpr (Epi::PF) { asm volatile("" : "+v"(nfa), "+v"(nfb)); asm volatile("" :: "v"(pfv0), "v"(pfv1)); pfa = nfa; pfb = nfb; }
        if (!has_next) break;
#pragma unroll
        for (int a = 0; a < 2; ++a)
#pragma unroll
            for (int b = 0; b < 2; ++b)
#pragma unroll
                for (int m = 0; m < 4; ++m)
#pragma unroll
                    for (int n = 0; n < 2; ++n) acc[a][b][m][n] = (f32x4){0.f, 0.f, 0.f, 0.f};
        cur = nxt; ++ui;
#pragma unroll
        for (int h = 0; h < 2; ++h)
#pragma unroll
            for (int i = 0; i < 2; ++i) ca[h][i] = na[h][i];
    }
    G8_WAIT_V(0);
    if (wr == 0) G8_BAR;
    G8_BAR;
#undef G8_SA
#undef G8_SB
#undef G8_STAGEA
#undef G8_STAGEB
#undef G8_LDA
#undef G8_LDB
#undef G8_MMA
#undef G8_WAIT_V
#undef G8_WAIT_L
#undef G8_BAR
#undef G8_SCHED
#undef G8_BK
}

template <int MODE> struct MoeOrder {
    static constexpr int NPN = MODE == 1 ? 8 : 4;
    const LAS int* tab; const SortRec* recs; const bf16_t* A; const bf16_t* W; int G, c, layer;
    __device__ bool next(int i, GUnit& u) const {
        const int MT = __builtin_amdgcn_readfirstlane(tab[24]);
        int rt, pn;
        if ((G & 7) == 0) { const int x = c & 7, j = c >> 3, Gx = G >> 3, rt0 = (x * MT) >> 3, rt1 = ((x + 1) * MT) >> 3, q = i * Gx + j;
            rt = rt0 + q / NPN; pn = q % NPN; if (rt >= rt1) return false; }
        else { const int L = i * G + c; rt = L / NPN; pn = L % NPN; if (rt >= MT) return false; }
        int k = 0;
        for (int j = 1; j < 24; ++j) if (rt >= tab[j]) k = j;
        k = __builtin_amdgcn_readfirstlane(k);
        const int g = k / 6, pi = k % 6;
        const int a = pi < 3 ? 0 : (pi < 5 ? 1 : 2), b = pi < 3 ? pi + 1 : (pi < 5 ? pi - 1 : 3);
        const int lo = g * 4 + a, hi = g * 4 + b;
        u.ord = i; u.pm = rt; u.pn = pn; u.k = k; u.s0 = (rt - __builtin_amdgcn_readfirstlane(tab[k])) * BM; u.cnt = __builtin_amdgcn_readfirstlane(tab[32 + k]);
        if (MODE == 1) { u.A = (const char*)A; u.B = (const char*)(W + ((size_t)((layer * 16 + (pn < 4 ? lo : hi)) * 4 + (pn & 3))) * 256 * 1024); u.B2 = u.B; }
        else { u.A = (const char*)(A + (size_t)rt * BM * 1024); u.B = (const char*)(W + ((size_t)(layer * 16 + lo) * 1024 + pn * 256) * 512); u.B2 = (const char*)(W + ((size_t)(layer * 16 + hi) * 1024 + pn * 256) * 512); }
        return true;
    }
    __device__ __forceinline__ void aoff(const GUnit& u, const int (&R)[2], const int (&C)[2], unsigned (&vo)[2][2]) const {
#pragma unroll
        for (int h = 0; h < 2; ++h)
#pragma unroll
            for (int i = 0; i < 2; ++i) {
                if (MODE == 1) { const int slot = u.s0 + h * HALF + R[i]; int tok = recs[(size_t)u.k * T + slot].tok; tok = slot < u.cnt ? tok : 0; vo[h][i] = (unsigned)(tok * 1024 + C[i]) * 2u; }
                else vo[h][i] = (unsigned)((h * HALF + R[i]) * 1024 + C[i]) * 2u; }
    }
};
struct EpiGateUp {   static constexpr bool PF = false;
    static constexpr bool PERM = true;
    bf16_t* HID; const SortRec* recs;
    __device__ __forceinline__ void operator()(const f32x4 (&acc)[2][2][4][2], const GUnit& u, int wr, int wc, int fr, int fq) const {
        const SortRec* rb = recs + (size_t)u.k * T;
        float wq[2][4], rsq[2][4];
#pragma unroll
        for (int ai = 0; ai < 2; ++ai)
#pragma unroll
            for (int m = 0; m < 4; ++m) { const float* rp = (const float*)(rb + (u.s0 + ai * HALF + wr * 64 + m * 16 + fr)); wq[ai][m] = rp[u.pn < 4 ? 1 : 2]; rsq[ai][m] = rp[3]; }
#pragma unroll
        for (int ai = 0; ai < 2; ++ai)
#pragma unroll
            for (int m = 0; m < 4; ++m) asm volatile("" : "+v"(wq[ai][m]), "+v"(rsq[ai][m]));
#pragma unroll
        for (int ai = 0; ai < 2; ++ai) {
#pragma unroll
            for (int m = 0; m < 4; ++m) { const int row = ai * HALF + wr * 64 + m * 16 + fr, slot = u.s0 + row;
                const float msk = slot < u.cnt ? 1.0f : 0.0f;
                const float w = wq[ai][m] * msk, rs = rsq[ai][m] * msk;
                float v[8];
#pragma unroll
                for (int n = 0; n < 2; ++n)
#pragma unroll
                    for (int j = 0; j < 4; ++j) { const float g = acc[ai][0][m][n][j] * rs, up = acc[ai][1][m][n][j] * rs;
                        v[n * 4 + j] = g * __builtin_amdgcn_rcpf(1.0f + __expf(-g)) * up * w; }
                u32x4 o; o.x = cvt_pk_bf16(v[0], v[1]); o.y = cvt_pk_bf16(v[2], v[3]); o.z = cvt_pk_bf16(v[4], v[5]); o.w = cvt_pk_bf16(v[6], v[7]);
                *(u32x4*)(HID + (size_t)(u.pm * BM + row) * 1024 + u.pn * 128 + wc * 32 + 8 * fq) = o; } }
    }
};
struct EpiScatterAdd {   static constexpr bool PF = true;
    static constexpr bool PERM = true;
    bf16_t* xs; float* out; const SortRec* recs; bf16_t* dummy; float* ssx; int emit; float accscale;
    __device__ __forceinline__ void pre(const GUnit& u, int tid, int& a, int& b) const {
        const int s0 = u.s0 + (tid >> 2), s1 = s0 + HALF;
        const int t0 = recs[(size_t)u.k * T + s0].tok, t1 = recs[(size_t)u.k * T + s1].tok; a = s0 < u.cnt ? t0 : -1; b = s1 < u.cnt ? t1 : -1; }
    __device__ __forceinline__ unsigned pf(const GUnit& u, int tid, int, int tok) const {
        const bf16_t* p = tok >= 0 ? xs + (size_t)tok * 1024 + u.pn * BM + (tid & 3) * 64 : dummy; unsigned r;
        asm volatile("global_load_dword %0, %1, off" : "=v"(r) : "v"(p) : "memory"); return r; }
    __device__ __forceinline__ void operator()(const f32x4 (&acc)[2][2][4][2], const GUnit& u, int wr, int wc, int fr, int fq) const {
        const int col0 = u.pn * BM + wc * 32 + 8 * fq;
        int tk[2][4];
#pragma unroll
        for (int ai = 0; ai < 2; ++ai)
#pragma unroll
            for (int m = 0; m < 4; ++m) tk[ai][m] = recs[(size_t)u.k * T + (u.s0 + ai * HALF + wr * 64 + m * 16 + fr)].tok;
#pragma unroll
        for (int ai = 0; ai < 2; ++ai)
#pragma unroll
            for (int m = 0; m < 4; ++m) asm volatile("" : "+v"(tk[ai][m]));
#pragma unroll
        for (int ai = 0; ai < 2; ++ai) {
            u32x4 rr8[4][2];
#pragma unroll
            for (int m = 0; m < 4; ++m) { const int slot = u.s0 + ai * HALF + wr * 64 + m * 16 + fr; const bf16_t* xp = (slot < u.cnt ? xs + (size_t)tk[ai][m] * 1024 : dummy) + col0;
#pragma unroll
                for (int bj = 0; bj < 2; ++bj) rr8[m][bj] = *(const u32x4*)(xp + bj * HALF); }
#pragma unroll
            for (int m = 0; m < 4; ++m)
#pragma unroll
                for (int bj = 0; bj < 2; ++bj) asm volatile("" : "+v"(rr8[m][bj]));
#pragma unroll
            for (int m = 0; m < 4; ++m) { const int row = ai * HALF + wr * 64 + m * 16 + fr, slot = u.s0 + row; const bool real = slot < u.cnt;
                bf16_t* xp = (real ? xs + (size_t)tk[ai][m] * 1024 : dummy) + col0;
                float ss = 0.f;
#pragma unroll
                for (int bj = 0; bj < 2; ++bj) { const u32x4 r = rr8[m][bj];
                    const f32x4 a0 = acc[ai][bj][m][0] * accscale, a1 = acc[ai][bj][m][1] * accscale;
                    const f32x4 x0 = (f32x4){__uint_as_float(r.x << 16) + a0[0], __uint_as_float(r.x & 0xffff0000u) + a0[1], __uint_as_float(r.y << 16) + a0[2], __uint_as_float(r.y & 0xffff0000u) + a0[3]};
                    const f32x4 x1 = (f32x4){__uint_as_float(r.z << 16) + a1[0], __uint_as_float(r.z & 0xffff0000u) + a1[1], __uint_as_float(r.w << 16) + a1[2], __uint_as_float(r.w & 0xffff0000u) + a1[3]};
                    if (emit) {
                        u32x4 w; w.x = cvt_pk_bf16(x0[0], x0[1]); w.y = cvt_pk_bf16(x0[2], x0[3]); w.z = cvt_pk_bf16(x1[0], x1[1]); w.w = cvt_pk_bf16(x1[2], x1[3]);
                        *(u32x4*)(xp + bj * HALF) = w;
                        const float b0 = __uint_as_float(w.x << 16), b1 = __uint_as_float(w.x & 0xffff0000u), b2 = __uint_as_float(w.y << 16), b3 = __uint_as_float(w.y & 0xffff0000u);
                        const float b4 = __uint_as_float(w.z << 16), b5 = __uint_as_float(w.z & 0xffff0000u), b6 = __uint_as_float(w.w << 16), b7 = __uint_as_float(w.w & 0xffff0000u);
                        ss += ((b0 * b0 + b1 * b1) + (b2 * b2 + b3 * b3)) + ((b4 * b4 + b5 * b5) + (b6 * b6 + b7 * b7));
                    } else if (real) { float* o = out + (size_t)tk[ai][m] * 1024 + col0 + bj * HALF; *(f32x4*)o = x0; *(f32x4*)(o + 4) = x1; } }
                if (emit) { ss += __shfl_xor(ss, 16); ss += __shfl_xor(ss, 32); if (real && fq == 0) ssx[(size_t)tk[ai][m] * 16 + u.pn * 4 + wc] = ss; } } }
    }
};
__device__ __forceinline__ void moe_build_tab(LAS int* tab, const int* cnt) {
    const int tidx = opaque_tid(); const int bidx = opaque_s((int)blockIdx.x), gdim = opaque_s((int)gridDim.x); (void)bidx; (void)gdim;
    if (tidx < 24) tab[32 + tidx] = __hip_atomic_load(cnt + tidx, __ATOMIC_RELAXED, __HIP_MEMORY_SCOPE_AGENT);
    __syncthreads();
    if (tidx == 0) { int acc = 0; for (int k = 0; k < 24; ++k) { tab[k] = acc; acc += (tab[32 + k] + BM - 1) / BM; } tab[24] = acc; }
    __syncthreads();
}
}

namespace at {
typedef __bf16 bf16x8b __attribute__((ext_vector_type(8)));
typedef float f32x8 __attribute__((ext_vector_type(8)));
typedef short s16x4 __attribute__((ext_vector_type(4)));
constexpr int VROWB = 192;
template <int DQK> struct Geo { static constexpr int KROWB = DQK * 2 + 16, KTB = 64 * KROWB, VTB = 64 * VROWB, BUF = KTB + VTB; };
constexpr int BIAS_OFF = 3 * (64 * (96 * 2 + 16) + 64 * VROWB);
constexpr int LDS_BYTES = BIAS_OFF + 4096 * 4;

struct Args { const bf16_t* Q; const bf16_t* K; const bf16_t* V; bf16_t* Y; const float* bias; const float* lamvec; const float* subln_g; const float* gq; const float* gk; const float* relb; int HQ, HKV, ng; float lam_init; };

__device__ __forceinline__ bf16x8 pack8(const f32x16& p, int s2) {
    f32x8 v;
    if (s2 == 0) v = __builtin_shufflevector(p, p, 0, 1, 2, 3, 4, 5, 6, 7); else v = __builtin_shufflevector(p, p, 8, 9, 10, 11, 12, 13, 14, 15);
    return __builtin_bit_cast(bf16x8, __builtin_convertvector(v, bf16x8b));
}
__device__ __forceinline__ bf16x8 tr_pair(const LAS unsigned char* p) {
    const s16x4 lo = __builtin_amdgcn_ds_read_tr16_b64_v4i16((LAS s16x4*)p);
    const s16x4 hi = __builtin_amdgcn_ds_read_tr16_b64_v4i16((LAS s16x4*)(p + 8 * VROWB));
    return __builtin_shufflevector(lo, hi, 0, 1, 2, 3, 4, 5, 6, 7);
}

template <int KIND>
__device__ __forceinline__ void attn_unit(LAS unsigned char* lds, const Args& a, const int b, const int h, const int qblk) {
    constexpr int DQK = KIND == 0 ? 96 : 64, NS = DQK / 16, CPR = DQK / 8;
    typedef Geo<DQK> G;
    const int tid = opaque_tid(), wid = __builtin_amdgcn_readfirstlane(tid >> 6), lane = tid & 63, r = lane & 31, hh = lane >> 5;
    const int hk = h / (a.HQ / a.HKV);
    const int q0w = qblk * 256 + wid * 32;
    const bf16_t* Kg = a.K + (size_t)(b * a.HKV + hk) * S * DQK;
    const bf16_t* Vg = a.V + (size_t)(b * a.HKV + hk) * S * 64;
    bf16x8 qf[NS];
    { const bf16_t* qp = a.Q + ((size_t)(b * a.HQ + h) * S + q0w + r) * DQK + 8 * hh;
#pragma unroll
      for (int s = 0; s < NS; ++s) qf[s] = *(const bf16x8*)(qp + 16 * s); }
    const int kkey0 = tid / CPR, kcc0 = tid % CPR, kkey1 = (tid + 512) / CPR, kcc1 = (tid + 512) % CPR;
    const bool k2 = (CPR == 12) && (tid < 256);
    const int vkey = tid >> 3, vcc = tid & 7;
    const unsigned kl0 = kkey0 * G::KROWB + kcc0 * 16, kl1 = kkey1 * G::KROWB + kcc1 * 16, vl = G::KTB + vkey * VROWB + vcc * 16;
    const bf16_t* kg0 = Kg + (size_t)kkey0 * DQK + kcc0 * 8; const bf16_t* kg1 = Kg + (size_t)kkey1 * DQK + kcc1 * 8; const bf16_t* vg = Vg + (size_t)vkey * 64 + vcc * 8;
    const unsigned ka = r * G::KROWB + hh * 16;
    const unsigned va = G::KTB + (4 * hh + ((lane & 15) >> 2)) * VROWB + (16 * ((lane >> 4) & 1) + 4 * (lane & 3)) * 2;
    LAS float* bl = (LAS float*)(lds + BIAS_OFF);
    float shift;
    { float mq = 0.f, mk = 0.f;
      for (int i = lane; i < a.ng; i += 64) { mq = fmaxf(mq, fabsf(a.gq[i])); mk = fmaxf(mk, fabsf(a.gk[i])); }
      float bm = (KIND == 2 && lane < 32) ? a.relb[lane * 8 + 4 + h] * LOG2E : 0.f;
#pragma unroll
      for (int o = 32; o >= 1; o >>= 1) { mq = fmaxf(mq, __shfl_xor(mq, o)); mk = fmaxf(mk, __shfl_xor(mk, o)); bm = fmaxf(bm, __shfl_xor(bm, o)); }
      shift = mq * mk * sqrtf((float)a.ng) * LOG2E * 1.02f + bm; }
    const float ninit = -shift;
    __syncthreads();
    if (KIND == 2) {
#pragma unroll
        for (int i = 0; i < 8; ++i) bl[tid + 512 * i] = a.bias[(size_t)h * 4096 + tid + 512 * i] - shift;
    }
    u32x4 t0, t1 = (u32x4){0u, 0u, 0u, 0u}, t2;
    { t0 = *(const u32x4*)kg0; if (k2) t1 = *(const u32x4*)kg1; t2 = *(const u32x4*)vg;
      *(LAS u32x4*)(lds + kl0) = t0; if (k2) *(LAS u32x4*)(lds + kl1) = t1; *(LAS u32x4*)(lds + vl) = t2; }
    constexpr int NT = S / 64;
    { const size_t go = 64; t0 = *(const u32x4*)(kg0 + go * DQK); if (k2) t1 = *(const u32x4*)(kg1 + go * DQK); t2 = *(const u32x4*)(vg + go * 64); }
    __syncthreads();
    f32x16 o0[2], o1[2]; float l0[4] = {0.f, 0.f, 0.f, 0.f}, l1[4] = {0.f, 0.f, 0.f, 0.f};
#pragma unroll
    for (int m = 0; m < 2; ++m)
#pragma unroll
        for (int i = 0; i < 16; ++i) { o0[m][i] = 0.f; o1[m][i] = 0.f; }
    bf16x8 kfr[NS], vfr[2][2];
    f32x16 sa0, sb0, sa1, sb1;
    auto ld_frags = [&](const bool has_next, const LAS unsigned char* kb, const int key0, f32x16& sa, f32x16& sb, const LAS unsigned char* vb) __attribute__((always_inline)) {
        if (has_next) {
#pragma unroll
            for (int s = 0; s < NS; ++s) kfr[s] = *(const LAS bf16x8*)(kb + ka + s * 32);
            if (KIND == 2) { const LAS float* bp = bl + ((key0 + 4 * hh) - (q0w + r) + 2048);
#pragma unroll
                for (int i = 0; i < 16; ++i) { const float bv = bp[(i & 3) + 8 * (i >> 2)]; sa[i] = bv; sb[i] = bv; } }
        }
#pragma unroll
        for (int s2 = 0; s2 < 2; ++s2)
#pragma unroll
            for (int m = 0; m < 2; ++m) vfr[s2][m] = tr_pair(vb + va + s2 * 16 * VROWB + m * 64);
    };
    auto qk_mma = [&](f32x16& sa, f32x16& sb) __attribute__((always_inline)) {
        if (KIND != 2) {
#pragma unroll
            for (int i = 0; i < 16; ++i) sa[i] = ninit; }
#pragma unroll
        for (int s = 0; s < NS; ++s) {
            if (KIND == 2 && s >= 2) sb = __builtin_amdgcn_mfma_f32_32x32x16_bf16(kfr[s], qf[s], sb, 0, 0, 0);
            else sa = __builtin_amdgcn_mfma_f32_32x32x16_bf16(kfr[s], qf[s], sa, 0, 0, 0);
        }
    };
    bf16x8 pa[2], pb[2];
    auto smx = [&](f32x16& sa, f32x16& sb) __attribute__((always_inline)) {
#pragma unroll
        for (int i = 0; i < 16; ++i) { sa[i] = __builtin_amdgcn_exp2f(sa[i]); l0[i & 3] += sa[i]; asm volatile("" : "+v"(l0[i & 3])); }
        pa[0] = pack8(sa, 0); pa[1] = pack8(sa, 1);
        if (KIND == 2) {
#pragma unroll
            for (int i = 0; i < 16; ++i) { sb[i] = __builtin_amdgcn_exp2f(sb[i]); l1[i & 3] += sb[i]; asm volatile("" : "+v"(l1[i & 3])); }
            pb[0] = pack8(sb, 0); pb[1] = pack8(sb, 1); }
    };
    auto pv_mma = [&]() __attribute__((always_inline)) {
#pragma unroll
        for (int s2 = 0; s2 < 2; ++s2)
#pragma unroll
            for (int m = 0; m < 2; ++m) {
                o0[m] = __builtin_amdgcn_mfma_f32_32x32x16_bf16(vfr[s2][m], pa[s2], o0[m], 0, 0, 0);
                if (KIND == 2) o1[m] = __builtin_amdgcn_mfma_f32_32x32x16_bf16(vfr[s2][m], pb[s2], o1[m], 0, 0, 0);
            }
    };
    {
#pragma unroll
      for (int s = 0; s < NS; ++s) kfr[s] = *(const LAS bf16x8*)(lds + ka + s * 32);
      if (KIND == 2) { const LAS float* bp = bl + ((4 * hh) - (q0w + r) + 2048);
#pragma unroll
          for (int i = 0; i < 16; ++i) { const float bv = bp[(i & 3) + 8 * (i >> 2)]; sa0[i] = bv; sb0[i] = bv; } }
      qk_mma(sa0, sb0); }
    unsigned cbo = 0, nbo = G::BUF;
    const bool stag = wid >= 4;
    auto tile_seam = [&](const int kt, LAS unsigned char* nb) __attribute__((always_inline)) {
        if (kt + 1 < NT) { *(LAS u32x4*)(nb + kl0) = t0; if (k2) *(LAS u32x4*)(nb + kl1) = t1; *(LAS u32x4*)(nb + vl) = t2; }
        __syncthreads();
        if (kt + 2 < NT) { const size_t go = (size_t)(kt + 2) * 64; t0 = *(const u32x4*)(kg0 + go * DQK); if (k2) t1 = *(const u32x4*)(kg1 + go * DQK); t2 = *(const u32x4*)(vg + go * 64); }
    };
#pragma unroll 1
    for (int kt = 0; kt < NT; ++kt) {
        const LAS unsigned char* cb = lds + cbo; LAS unsigned char* nb = lds + nbo;
        const bool more = kt + 1 < NT;
        ld_frags(true, cb + 32 * G::KROWB, kt * 64 + 32, sa1, sb1, cb);
        __builtin_amdgcn_sched_barrier(0);
        smx(sa0, sb0);
        __builtin_amdgcn_sched_barrier(0);
        if (stag) tile_seam(kt, nb);
        __builtin_amdgcn_sched_barrier(0);
        qk_mma(sa1, sb1); pv_mma();
        __builtin_amdgcn_sched_barrier(0);
        if (!stag) tile_seam(kt, nb);
        __builtin_amdgcn_sched_barrier(0);
        ld_frags(true, more ? (const LAS unsigned char*)nb : cb, (more ? kt + 1 : kt) * 64, sa0, sb0, cb + 32 * VROWB);
        __builtin_amdgcn_sched_barrier(0);
        smx(sa1, sb1);
        __builtin_amdgcn_sched_barrier(0);
        qk_mma(sa0, sb0); pv_mma();
        __builtin_amdgcn_sched_barrier(0);
        cbo = nbo; nbo = nbo + G::BUF; if (nbo >= 3 * G::BUF) nbo = 0;
    }
    float lt0 = (l0[0] + l0[1]) + (l0[2] + l0[3]); lt0 += __shfl_xor(lt0, 32);
    bf16_t* yp = a.Y + (size_t)(b * S + q0w + r) * 256 + h * 64 + 4 * hh;
    if (KIND != 2) {
        const float inv = 1.0f / lt0;
#pragma unroll
        for (int m = 0; m < 2; ++m)
#pragma unroll
            for (int g4 = 0; g4 < 4; ++g4) { uint2 w; w.x = pack2(o0[m][4 * g4] * inv, o0[m][4 * g4 + 1] * inv); w.y = pack2(o0[m][4 * g4 + 2] * inv, o0[m][4 * g4 + 3] * inv);
                *(uint2*)(yp + 32 * m + 8 * g4) = w; }
    } else {
        float lt1 = (l1[0] + l1[1]) + (l1[2] + l1[3]); lt1 += __shfl_xor(lt1, 32);
        float d01 = 0.f, d23 = 0.f;
#pragma unroll
        for (int e = 0; e < 32; ++e) { d01 += a.lamvec[e] * a.lamvec[32 + e]; d23 += a.lamvec[64 + e] * a.lamvec[96 + e]; }
        const float lam = expf(d01) - expf(d23) + a.lam_init;
        const float i0 = 1.0f / lt0, i1 = lam / lt1; float ss = 0.f;
#pragma unroll
        for (int m = 0; m < 2; ++m)
#pragma unroll
            for (int i = 0; i < 16; ++i) { const float v = o0[m][i] * i0 - o1[m][i] * i1; o0[m][i] = v; ss += v * v; }
        ss += __shfl_xor(ss, 32);
        const float rs = rsqrtf(ss * (1.0f / 64.0f) + EPS) * (1.0f - a.lam_init);
#pragma unroll
        for (int m = 0; m < 2; ++m)
#pragma unroll
            for (int g4 = 0; g4 < 4; ++g4) { const float4 gg = *(const float4*)(a.subln_g + 32 * m + 8 * g4 + 4 * hh);
                uint2 w; w.x = pack2(o0[m][4 * g4] * rs * gg.x, o0[m][4 * g4 + 1] * rs * gg.y); w.y = pack2(o0[m][4 * g4 + 2] * rs * gg.z, o0[m][4 * g4 + 3] * rs * gg.w);
                *(uint2*)(yp + 32 * m + 8 * g4) = w; }
    }
}
}


namespace at {
struct DilArgs { const bf16_t* Q; const bf16_t* K; const bf16_t* V; bf16_t* YBP; float* LB; const float* bias; const float* gq; const float* gk; const float* relb; };
constexpr int DKROWB = 144, DK_BYTES = 384 * DKROWB, DV_OFF = DK_BYTES, DBT_OFF = DK_BYTES + 384 * VROWB;
static_assert(DBT_OFF + 1024 <= 128 * 1024 + 1024, "dilated LDS layout");
struct DilStage { u32x4 kv[6], vv[6]; };
__device__ __forceinline__ void dil_fetch(DilStage& st, const DilArgs& a, const int tid, const int b, const int h, const int br, const int ublk) {
    const int lgd = br * 2, nsub = S >> lgd, bh = b * 4 + h, pbase = 256 * ublk - 64;
#pragma unroll
    for (int i = 0; i < 6; ++i) { const int c = tid + 512 * i, row = c >> 3, cc = c & 7; int pk = pbase + row; pk = pk < 0 ? 0 : (pk >= S ? S - 1 : pk);
        const int rho = pk >> (11 - lgd), lk = pk & (nsub - 1), t = (lk << lgd) + rho;
        st.kv[i] = *(const u32x4*)(a.K + ((size_t)bh * S + t) * 64 + cc * 8); st.vv[i] = *(const u32x4*)(a.V + ((size_t)bh * S + t) * 64 + cc * 8); }
}
__device__ __forceinline__ void dil_unit(LAS unsigned char* lds, const DilArgs& a, DilStage& st, const int b, const int h, const int br, const int ublk,
                                         const bool has_next, const int nb_, const int nh_, const int nbr_, const int nublk_) {
    const int tid = opaque_tid(), wid = __builtin_amdgcn_readfirstlane(tid >> 6), lane = tid & 63, r = lane & 31, hh = lane >> 5;
    const int lgd = br * 2, d = 1 << lgd, nsub = S >> lgd;
    const int bh = b * 4 + h;
    float shift;
    { float mq = 0.f, mk = 0.f;
      { mq = fabsf(a.gq[lane]); mk = fabsf(a.gk[lane]); }
      float bm = lane < 32 ? a.relb[lane * 8 + h] * LOG2E : 0.f;
#pragma unroll
      for (int o = 32; o >= 1; o >>= 1) { mq = fmaxf(mq, __shfl_xor(mq, o)); mk = fmaxf(mk, __shfl_xor(mk, o)); bm = fmaxf(bm, __shfl_xor(bm, o)); }
      shift = mq * mk * 8.0f * LOG2E * 1.02f + bm; }
    LAS float* bt = (LAS float*)(lds + DBT_OFF);
    __syncthreads();
    if (tid < 256) { const int jj = tid - 128; bt[tid] = (jj >= -64 && jj <= 64) ? a.bias[(size_t)h * 4096 + jj * d + 2048] - shift : -1.0e30f; }
#pragma unroll
    for (int i = 0; i < 6; ++i) { const int c = tid + 512 * i, row = c >> 3, cc = c & 7;
        *(LAS u32x4*)(lds + row * DKROWB + cc * 16) = st.kv[i]; *(LAS u32x4*)(lds + DV_OFF + row * VROWB + cc * 16) = st.vv[i]; }
    const int pi0 = 256 * ublk + 32 * wid, rho = pi0 >> (11 - lgd), l0 = pi0 & (nsub - 1);
    const int tq = ((l0 + r) << lgd) + rho;
    bf16x8 qf[4];
    { const bf16_t* qp = a.Q + ((size_t)bh * S + tq) * 64 + 8 * hh;
#pragma unroll
      for (int s = 0; s < 4; ++s) qf[s] = *(const bf16x8*)(qp + 16 * s); }
    __syncthreads();
    if (has_next) dil_fetch(st, a, tid, nb_, nh_, nbr_, nublk_);
    f32x16 o[2]; float l4[4] = {0.f, 0.f, 0.f, 0.f};
#pragma unroll
    for (int m = 0; m < 2; ++m)
#pragma unroll
        for (int i = 0; i < 16; ++i) o[m][i] = 0.f;
    const unsigned ka = (32 * wid + r) * DKROWB + hh * 16;
    const unsigned va = DV_OFF + (32 * wid + 4 * hh + ((lane & 15) >> 2)) * VROWB + (16 * ((lane >> 4) & 1) + 4 * (lane & 3)) * 2;
#pragma unroll
    for (int c = 0; c < 5; ++c) {
        const int lt = l0 + 32 * (c - 2);
        if (lt >= 0 && lt < nsub) {
            f32x16 sa;
            const LAS float* bp = bt + (32 * (c - 2) + 4 * hh - r + 128);
#pragma unroll
            for (int i = 0; i < 16; ++i) sa[i] = bp[(i & 3) + 8 * (i >> 2)];
#pragma unroll
            for (int s = 0; s < 4; ++s) { const bf16x8 kf = *(const LAS bf16x8*)(lds + ka + c * 32 * DKROWB + s * 32); sa = __builtin_amdgcn_mfma_f32_32x32x16_bf16(kf, qf[s], sa, 0, 0, 0); }
#pragma unroll
            for (int i = 0; i < 16; ++i) { sa[i] = __builtin_amdgcn_exp2f(sa[i]); l4[i & 3] += sa[i]; asm volatile("" : "+v"(l4[i & 3])); }
#pragma unroll
            for (int s2 = 0; s2 < 2; ++s2) { const bf16x8 pa = pack8(sa, s2);
#pragma unroll
                for (int m = 0; m < 2; ++m) { const bf16x8 vf = tr_pair(lds + va + c * 32 * VROWB + s2 * 16 * VROWB + m * 64); o[m] = __builtin_amdgcn_mfma_f32_32x32x16_bf16(vf, pa, o[m], 0, 0, 0); } }
        }
    }
    float lt0 = (l4[0] + l4[1]) + (l4[2] + l4[3]); lt0 += __shfl_xor(lt0, 32);
    const float inv = 1.0f / lt0;
    const int t = b * S + tq;
    bf16_t* yp = a.YBP + (size_t)br * T * 256 + (size_t)t * 256 + h * 64 + 4 * hh;
#pragma unroll
    for (int m = 0; m < 2; ++m)
#pragma unroll
        for (int g4 = 0; g4 < 4; ++g4) { uint2 w; w.x = pack2(o[m][4 * g4] * inv, o[m][4 * g4 + 1] * inv); w.y = pack2(o[m][4 * g4 + 2] * inv, o[m][4 * g4 + 3] * inv);
            *(uint2*)(yp + 32 * m + 8 * g4) = w; }
    if (hh == 0) a.LB[(size_t)br * T * 4 + (size_t)t * 4 + h] = lt0;
}
}

typedef const __attribute__((address_space(4))) Params* KParams;
__device__ __forceinline__ KParams kparams() { KParams k = (KParams)__builtin_amdgcn_kernarg_segment_ptr(); asm volatile("" : "+s"(k)); return k; }
constexpr int RSTAB_OFF = 128 * 1024 + 2048, CSTAB_OFF = RSTAB_OFF + 8192;
constexpr int LDS_TOTAL = CSTAB_OFF + 8192;
constexpr int NPHASE_LAYER = 11;
__device__ __forceinline__ Params load_params(KParams k) { Params p; p.x = k->x; p.rel_bias = k->rel_bias; p.norm1_g = k->norm1_g; p.w_in = k->w_in; p.mla_q_norm_g = k->mla_q_norm_g; p.mla_kv_norm_g = k->mla_kv_norm_g; p.mla_w_uq = k->mla_w_uq; p.mla_w_ukv = k->mla_w_ukv; p.mla_qk_g = k->mla_qk_g; p.dil_qk_g = k->dil_qk_g; p.gqa_qk_g = k->gqa_qk_g; p.diff_qk_g = k->diff_qk_g; p.diff_lambda = k->diff_lambda; p.diff_subln_g = k->diff_subln_g; p.mix_beta = k->mix_beta; p.w_out = k->w_out; p.norm2_g = k->norm2_g; p.rg_w = k->rg_w; p.rg_b = k->rg_b; p.re_w = k->re_w; p.re_b = k->re_b; p.w_gate = k->w_gate; p.w_up = k->w_up; p.w_down = k->w_down; p.out = k->out; p.ws = k->ws; return p; }
template <int PH> __device__ __forceinline__ void run_phase(const int layer, LAS unsigned char* lds, const bool dup = false) {
    const Params p = load_params(kparams());
    const int bidx = opaque_s((int)blockIdx.x), gdim = opaque_s((int)gridDim.x); (void)bidx; (void)gdim;
    unsigned char* ws = p.ws;
    const float* xin = layer == 0 ? p.x : p.out;
    if constexpr (PH == 0) {
        ph_prep_tables(p);
        ph_xcast(p);
        ph_prep_layer0(p, (LAS float*)lds);
    } else if constexpr (PH == 2) {
        g8::DenseOrder Sd; Sd.init((const bf16_t*)(ws + OFF_HN), 1024, (const bf16_t*)(ws + OFF_WIN) + (size_t)layer * NPROJ * 1024, 1024, T, NPROJ, gdim, bidx);
        LAS float* rstab = (LAS float*)(lds + RSTAB_OFF); LAS f32x2* cstab = (LAS f32x2*)(lds + CSTAB_OFF);
        { const int tidx = opaque_tid(); const float* ssx = (const float*)(ws + OFF_SSX); const float2* CS = (const float2*)(ws + OFF_CS);
          for (int i = tidx; i < 1024; i += 512) { const float2 c = CS[i]; cstab[i] = (f32x2){c.x, c.y}; }
          { const int half = tidx >> 8, rl = tidx & 255; f32x4 sv[4][4]; int okm = 0;
#pragma unroll
            for (int k = 0; k < 4; ++k) { g8::GUnit u; const bool ok = Sd.next(2 * k + half, u); const int pm = ok ? u.pm : 0; okm |= ok ? (1 << k) : 0;
                const f32x4* sp = (const f32x4*)(ssx + (size_t)(pm * 256 + rl) * 16); sv[k][0] = sp[0]; sv[k][1] = sp[1]; sv[k][2] = sp[2]; sv[k][3] = sp[3]; }
#pragma unroll
            for (int k = 0; k < 4; ++k) if (okm & (1 << k)) { const f32x4 s0 = sv[k][0], s1 = sv[k][1], s2 = sv[k][2], s3 = sv[k][3];
                const float tot = ((s0[0] + s0[1]) + (s0[2] + s0[3])) + ((s1[0] + s1[1]) + (s1[2] + s1[3])) + ((s2[0] + s2[1]) + (s2[2] + s2[3])) + ((s3[0] + s3[1]) + (s3[2] + s3[3]));
                rstab[(2 * k + half) * 256 + rl] = rsqrtf(tot * (1.0f / 1024.0f) + EPS); } }
          __syncthreads(); }
        g8::EpiInProj E; E.rstab = rstab; E.cstab = cstab; E.ssq = (float*)(ws + OFF_SSQ); E.sskv = (float*)(ws + OFF_SSKV); E.AMLA = (bf16_t*)(ws + OFF_AMLA); E.KR = (bf16_t*)(ws + OFF_KR);
        E.qB = (bf16_t*)(ws + OFF_QB); E.kB = (bf16_t*)(ws + OFF_KB); E.vB = (bf16_t*)(ws + OFF_VB); E.qC = (bf16_t*)(ws + OFF_QC); E.kC = (bf16_t*)(ws + OFF_KC); E.vC = (bf16_t*)(ws + OFF_VC);
        E.qD = (bf16_t*)(ws + OFF_QD); E.kD = (bf16_t*)(ws + OFF_KD); E.vD = (bf16_t*)(ws + OFF_VD);
        E.g_dil = p.dil_qk_g + layer * 128; E.g_gqa = p.gqa_qk_g + layer * 128; E.g_diff = p.diff_qk_g + layer * 64;
        g8::gemm_phase<g8::EpiInProj, g8::DenseOrder>(lds, Sd, E, 1024, 16, 1024);
    } else if constexpr (PH == 4) {
        ph_mla_up(p, layer, lds);
    } else if constexpr (PH == 6) {
        const float* bias = (const float*)(ws + OFF_BIAS);
        at::Args aD{}; aD.Q = (const bf16_t*)(ws + OFF_QD); aD.K = (const bf16_t*)(ws + OFF_KD); aD.V = (const bf16_t*)(ws + OFF_VD); aD.Y = (bf16_t*)(ws + OFF_YD);
        aD.gq = p.diff_qk_g + layer * 64; aD.gk = aD.gq + 32; aD.ng = 32; aD.HQ = 4; aD.HKV = 4; aD.bias = bias + 4 * 4096; aD.relb = p.rel_bias;
        aD.lamvec = p.diff_lambda + layer * 128; aD.lam_init = lambda_init_of(layer); aD.subln_g = p.diff_subln_g + layer * 64;
        at::Args aA{}; aA.Q = (const bf16_t*)(ws + OFF_QA); aA.K = (const bf16_t*)(ws + OFF_KA); aA.V = (const bf16_t*)(ws + OFF_VA); aA.Y = (bf16_t*)(ws + OFF_YA);
        aA.gq = p.mla_qk_g + layer * 192; aA.gk = aA.gq + 96; aA.ng = 96; aA.HQ = 4; aA.HKV = 4;
        at::Args aC{}; aC.Q = (const bf16_t*)(ws + OFF_QC); aC.K = (const bf16_t*)(ws + OFF_KC); aC.V = (const bf16_t*)(ws + OFF_VC); aC.Y = (bf16_t*)(ws + OFF_YC);
        aC.gq = p.gqa_qk_g + layer * 128; aC.gk = aC.gq + 64; aC.ng = 64; aC.HQ = 4; aC.HKV = 2;
        at::DilArgs aB{}; aB.Q = (const bf16_t*)(ws + OFF_QB); aB.K = (const bf16_t*)(ws + OFF_KB); aB.V = (const bf16_t*)(ws + OFF_VB); aB.YBP = (bf16_t*)(ws + OFF_YBP); aB.LB = (float*)(ws + OFF_LB);
        aB.bias = bias; aB.gq = p.dil_qk_g + layer * 128; aB.gk = aB.gq + 64; aB.relb = p.rel_bias;
        const int kinds = dup ? ATT_DUP_KINDS : 15;
        auto remap = [&](const int u) { if (gdim != 256) return u; const int i = u >> 8, c = u & 255, x = c & 7, sl = c >> 3; return ((x * 8 + i * 4 + (sl >> 3)) << 3) | (sl & 7); };
        if (kinds & 1) for (int u0 = bidx; u0 < 512; u0 += gdim) { const int u = remap(u0); at::attn_unit<2>(lds, aD, u >> 5, (u >> 3) & 3, u & 7); }
        if (kinds & 2) for (int u0 = bidx; u0 < 512; u0 += gdim) { const int u = remap(u0); at::attn_unit<0>(lds, aA, u >> 5, (u >> 3) & 3, u & 7); }
        if (kinds & 4) for (int u0 = bidx; u0 < 512; u0 += gdim) { const int u = remap(u0); at::attn_unit<1>(lds, aC, u >> 5, (u >> 3) & 3, u & 7); }
        if (kinds & 8) { at::DilStage st; const int tid0 = opaque_tid();
            if (bidx < 1536) at::dil_fetch(st, aB, tid0, bidx / 96, (bidx / 24) & 3, (bidx >> 3) % 3, bidx & 7);
            for (int u = bidx; u < 1536; u += gdim) { const int un = u + gdim; const bool hn = un < 1536;
                at::dil_unit(lds, aB, st, u / 96, (u / 24) & 3, (u >> 3) % 3, u & 7, hn, un / 96, (un / 24) & 3, (un >> 3) % 3, un & 7); } }
    } else if constexpr (PH == 7) {
        ph_mix(p, layer);
    } else if constexpr (PH == 8) {
        g8::EpiResidBf16 E; E.X = (bf16_t*)(ws + OFF_HN); E.ldc = 1024; E.accscale = dup ? 0.f : 1.f;
        g8::DenseOrder Sd; Sd.init((const bf16_t*)(ws + OFF_MIX), 1024, (const bf16_t*)(ws + OFF_WOUT) + (size_t)layer * 1024 * 1024, 1024, T, 1024, gdim, bidx);
        g8::gemm_phase<g8::EpiResidBf16, g8::DenseOrder>(lds, Sd, E, 1024, 16, 1024);
    } else if constexpr (PH == 9) {
        ph_norm2_route(p, layer, (LAS float*)lds, dup);
    } else if constexpr (PH == 10 || PH == 11) {
        constexpr int MODE = PH == 10 ? 1 : 2;
        LAS int* tab = (LAS int*)(lds + g8::STAGE_BYTES);
        g8::moe_build_tab(tab, (const int*)(ws + OFF_CNT) + layer * 32);
        g8::MoeOrder<MODE> Sm; Sm.tab = tab; Sm.recs = (const SortRec*)(ws + OFF_PERM); Sm.G = gdim; Sm.c = bidx; Sm.layer = layer;
        if constexpr (MODE == 1) { Sm.A = (const bf16_t*)(ws + OFF_HN); Sm.W = (const bf16_t*)(ws + OFF_WGU);
            g8::EpiGateUp E; E.HID = (bf16_t*)(ws + OFF_HID); E.recs = Sm.recs;
            g8::gemm_phase<g8::EpiGateUp, g8::MoeOrder<MODE>>(lds, Sm, E, 1024, 16, 1024);
            if (layer == 0 && !dup) {
                int mine = 0, most = 0; { g8::GUnit uu; while (Sm.next(mine, uu)) ++mine; const int MT = tab[24]; for (int x = 0; x < 8; ++x) { const int nu = ((((x + 1) * MT) >> 3) - ((x * MT) >> 3)) * 8; const int per = (nu + (gdim >> 3) - 1) / (gdim >> 3); most = per > most ? per : most; } }
                if (mine < most) prep_queue(p, 14 * (most - mine), (LAS float*)lds, (LAS int*)(lds + 64 * 1024)); }
        } else { Sm.A = (const bf16_t*)(ws + OFF_HID); Sm.W = (const bf16_t*)(ws + OFF_WDT);
            g8::EpiScatterAdd E; E.xs = (bf16_t*)(ws + OFF_HN); E.out = p.out; E.recs = Sm.recs; E.dummy = (bf16_t*)(ws + OFF_DUMMY); E.ssx = (float*)(ws + OFF_SSX); E.emit = layer + 1 < NL ? 1 : 0; E.accscale = dup ? 0.f : 1.f;
            g8::gemm_phase<g8::EpiScatterAdd, g8::MoeOrder<MODE>>(lds, Sm, E, 1024, 8, 512);
            if (layer == 0 && !dup) prep_queue(p, -1, (LAS float*)lds, (LAS int*)(lds + 64 * 1024));
        }
    }
}

#ifndef MK_FUSED
#define MK_FUSED 1
#endif
#ifndef DUP_MASK
#define DUP_MASK 0
#endif
#if MK_FUSED
__device__ __forceinline__ void grid_sync(const XcdBarrier& b0) { XcdBarrier b = b0; asm volatile("" : "+s"(b.bar), "+s"(b.x)); xcd_barrier(b); }
__global__ __launch_bounds__(512, 2) void k_mega(Params p) {
    extern __shared__ __attribute__((aligned(16))) unsigned char shm[];
    LAS unsigned char* lds = (LAS unsigned char*)shm;
    volatile LAS unsigned* xbw = (volatile LAS unsigned*)(lds + 128 * 1024 + 1024);
    if (threadIdx.x == 0) { xbw[0] = 0u; xbw[1] = 0u; }
    __syncthreads();
    XcdBarrier bar = xcd_barrier_post((unsigned*)(kparams()->ws + OFF_BAR), xbw);
    run_phase<0>(0, lds); grid_sync(bar); if constexpr ((DUP_MASK >> 0) & 1) { run_phase<0>(0, lds, true); grid_sync(bar); }
#pragma unroll 1
    for (int layer = 0; layer < NL; ++layer) {
        run_phase<2>(layer, lds); grid_sync(bar); if constexpr ((DUP_MASK >> 2) & 1) { run_phase<2>(layer, lds, true); grid_sync(bar); }
        run_phase<4>(layer, lds); grid_sync(bar); if constexpr ((DUP_MASK >> 4) & 1) { run_phase<4>(layer, lds, true); grid_sync(bar); }
        run_phase<6>(layer, lds); grid_sync(bar); if constexpr ((DUP_MASK >> 6) & 1) { run_phase<6>(layer, lds, true); grid_sync(bar); }
        run_phase<7>(layer, lds); grid_sync(bar); if constexpr ((DUP_MASK >> 7) & 1) { run_phase<7>(layer, lds, true); grid_sync(bar); }
        run_phase<8>(layer, lds); grid_sync(bar); if constexpr ((DUP_MASK >> 8) & 1) { run_phase<8>(layer, lds, true); grid_sync(bar); }
        run_phase<9>(layer, lds); grid_sync(bar); if constexpr ((DUP_MASK >> 9) & 1) { run_phase<9>(layer, lds, true); grid_sync(bar); }
        run_phase<10>(layer, lds); grid_sync(bar); if constexpr ((DUP_MASK >> 10) & 1) { run_phase<10>(layer, lds, true); grid_sync(bar); }
        run_phase<11>(layer, lds); grid_sync(bar); if constexpr ((DUP_MASK >> 11) & 1) { run_phase<11>(layer, lds, true); grid_sync(bar); }
    }
}
#else
template <int PH> __global__ __launch_bounds__(512, 2) void k_phase(Params p, int layer) {
    extern __shared__ __attribute__((aligned(16))) unsigned char shm[];
    run_phase<PH>(layer, (LAS unsigned char*)shm);
}
template <int PH> static void launch_phase(const Params& p, int layer, int grid, hipStream_t st) {
    static bool attr = false; if (!attr) { (void)hipFuncSetAttribute((const void*)k_phase<PH>, hipFuncAttributeMaxDynamicSharedMemorySize, LDS_TOTAL); attr = true; }
    hipLaunchKernelGGL((k_phase<PH>), dim3(grid), dim3(512), LDS_TOTAL, st, p, layer);
}
#endif

extern "C" void kernel_launch(void* const* d_in, const int* in_sizes, int n_in, void* d_out, int out_size, void* d_ws, size_t ws_size, hipStream_t stream) {
    Params p{};
    p.x = (const float*)d_in[0]; p.rel_bias = (const float*)d_in[1]; p.norm1_g = (const float*)d_in[2]; p.w_in = (const float*)d_in[3];
    p.mla_q_norm_g = (const float*)d_in[4]; p.mla_kv_norm_g = (const float*)d_in[5]; p.mla_w_uq = (const float*)d_in[6]; p.mla_w_ukv = (const float*)d_in[7];
    p.mla_qk_g = (const float*)d_in[8]; p.dil_qk_g = (const float*)d_in[9]; p.gqa_qk_g = (const float*)d_in[10]; p.diff_qk_g = (const float*)d_in[11];
    p.diff_lambda = (const float*)d_in[12]; p.diff_subln_g = (const float*)d_in[13]; p.mix_beta = (const float*)d_in[14]; p.w_out = (const float*)d_in[15];
    p.norm2_g = (const float*)d_in[16]; p.rg_w = (const float*)d_in[17]; p.rg_b = (const float*)d_in[18]; p.re_w = (const float*)d_in[19]; p.re_b = (const float*)d_in[20];
    p.w_gate = (const float*)d_in[21]; p.w_up = (const float*)d_in[22]; p.w_down = (const float*)d_in[23];
    p.out = (float*)d_out; p.ws = (unsigned char*)d_ws;
    static int grid = 0;
    if (!grid) {
        int dev = 0, cus = 0, per_cu = 0;
        (void)hipGetDevice(&dev);
        (void)hipDeviceGetAttribute(&cus, hipDeviceAttributeMultiprocessorCount, dev);
#if MK_FUSED
        (void)hipFuncSetAttribute((const void*)k_mega, hipFuncAttributeMaxDynamicSharedMemorySize, LDS_TOTAL);
        (void)hipOccupancyMaxActiveBlocksPerMultiprocessor(&per_cu, k_mega, 512, LDS_TOTAL);
#else
        per_cu = 1;
#endif
        if (cus <= 0) cus = 256;
        grid = per_cu >= 1 ? cus : 0;
        if (grid > 256) grid = 256;
    }
    (void)hipMemsetAsync(p.ws + OFF_BAR, 0, 64 * 1024, stream);
#if MK_FUSED
    if (grid > 0) hipLaunchKernelGGL(k_mega, dim3(grid), dim3(512), LDS_TOTAL, stream, p);
#else
    launch_phase<0>(p, 0, grid, stream);
    for (int l = 0; l < NL; ++l) {
        launch_phase<2>(p, l, grid, stream); launch_phase<4>(p, l, grid, stream);
        launch_phase<6>(p, l, grid, stream); launch_phase<7>(p, l, grid, stream); launch_phase<8>(p, l, grid, stream);
        launch_phase<9>(p, l, grid, stream); launch_phase<10>(p, l, grid, stream); launch_phase<11>(p, l, grid, stream);
    }
#endif
}
```
